# Optimizing an MI355X kernel written in HIP

```python
import math
import jax, jax.numpy as jnp
from jax import lax
import numpy as np


D_MODEL = 1024
BATCH = 2
SEQ = 16384
DEPTH = 2

HEAD_DIM = 64
D_MIX = D_MODEL
D_ATTN = 3 * D_MIX // 8
D_RET = 3 * D_MIX // 8
D_SSM = D_MIX - D_ATTN - D_RET
N_ATTN_HEADS = D_ATTN // HEAD_DIM
N_RET_HEADS = D_RET // HEAD_DIM
SSM_GROUP = 16
N_SSM_GROUPS = D_SSM // SSM_GROUP
SSM_STATE = 64
MOBA_BLOCK = 256
MOBA_TOPK = 3
Q_BLOCK = 128
RET_CHUNK = 128
N_EXPERTS = 16
N_EXPERT_GROUPS = 4
EXPERTS_PER_GROUP = N_EXPERTS // N_EXPERT_GROUPS
TOP_K = 2
D_FF_EXPERT = D_MODEL // 2
MOE_ROWS = 256
D_IN = 3 * D_ATTN + 4 * D_RET + D_SSM
ALPHA = (2.0 * DEPTH) ** 0.25
BETA = (8.0 * DEPTH) ** -0.25
LN_EPS = 1e-5
GN_EPS = 1e-6

kernel_name = 'hybrid_moba_retnet_s5_grouped_moe'


def _layer_norm(x, g, b):
    xf = x.astype(jnp.float32)
    mu = jnp.mean(xf, -1, keepdims=True)
    var = jnp.mean(jnp.square(xf - mu), -1, keepdims=True)
    return ((xf - mu) * lax.rsqrt(var + LN_EPS) * g + b).astype(x.dtype)


def _head_norm(o):
    of = o.astype(jnp.float32)
    mu = jnp.mean(of, -1, keepdims=True)
    var = jnp.mean(jnp.square(of - mu), -1, keepdims=True)
    return (of - mu) * lax.rsqrt(var + GN_EPS)


def _pad_seq(t, mult):
    L = t.shape[1]
    Lp = -(-L // mult) * mult
    if Lp == L:
        return t
    pad = [(0, 0)] * t.ndim
    pad[1] = (0, Lp - L)
    return jnp.pad(t, pad)


def _alibi_slopes(n_heads):
    return (2.0 ** (-8.0 * (np.arange(n_heads) + 1) / n_heads)).astype(np.float32)


def _moba_attention(q, k, v):
    Bn, L, H, d = q.shape
    q, k, v = _pad_seq(q, MOBA_BLOCK), _pad_seq(k, MOBA_BLOCK), _pad_seq(v, MOBA_BLOCK)
    Lp = q.shape[1]
    nb = Lp // MOBA_BLOCK
    n_qb = Lp // Q_BLOCK
    top_k = min(MOBA_TOPK, nb)
    q, k, v = (jnp.transpose(t, (0, 2, 1, 3)) for t in (q, k, v))
    kb = k.reshape(Bn, H, nb, MOBA_BLOCK, d)
    vb = v.reshape(Bn, H, nb, MOBA_BLOCK, d)
    k_mean = jnp.mean(kb.astype(jnp.float32), axis=3)
    slopes = jnp.asarray(_alibi_slopes(H))[:, None, None]
    scale = d ** -0.5
    bi = jnp.arange(Bn)[:, None, None, None]
    hi = jnp.arange(H)[None, :, None, None]
    blk_off = jnp.arange(MOBA_BLOCK)
    n_sel = top_k * MOBA_BLOCK
    q_blocks = jnp.transpose(q.reshape(Bn, H, n_qb, Q_BLOCK, d), (2, 0, 1, 3, 4))

    def one_block(args):
        qb, qi = args
        t = qi * Q_BLOCK + jnp.arange(Q_BLOCK)
        own = (qi * Q_BLOCK) // MOBA_BLOCK
        gate = jnp.einsum('bhqd,bhnd->bhqn', qb.astype(jnp.float32), k_mean)
        past = jnp.arange(nb) < own
        gate = jnp.where(past, gate, -jnp.inf)
        _, sel = lax.top_k(gate, top_k)
        valid = sel < own
        k_sel = kb[bi, hi, sel].reshape(Bn, H, Q_BLOCK, n_sel, d)
        v_sel = vb[bi, hi, sel].reshape(Bn, H, Q_BLOCK, n_sel, d)
        pos_sel = (sel[..., None] * MOBA_BLOCK + blk_off).reshape(Bn, H, Q_BLOCK, n_sel)
        valid_sel = jnp.broadcast_to(valid[..., None], sel.shape + (MOBA_BLOCK,)).reshape(Bn, H, Q_BLOCK, n_sel)
        k_own = lax.dynamic_slice_in_dim(k, own * MOBA_BLOCK, MOBA_BLOCK, axis=2)
        v_own = lax.dynamic_slice_in_dim(v, own * MOBA_BLOCK, MOBA_BLOCK, axis=2)
        pos_own = own * MOBA_BLOCK + blk_off
        s_sel = jnp.einsum('bhqd,bhqkd->bhqk', qb, k_sel).astype(jnp.float32) * scale
        s_sel = s_sel - slopes * jnp.abs(t[:, None] - pos_sel).astype(jnp.float32)
        s_sel = jnp.where(valid_sel, s_sel, -jnp.inf)
        s_own = jnp.einsum('bhqd,bhkd->bhqk', qb, k_own).astype(jnp.float32) * scale
        s_own = s_own - slopes * jnp.abs(t[:, None] - pos_own[None, :]).astype(jnp.float32)
        s_own = jnp.where(pos_own[None, :] <= t[:, None], s_own, -jnp.inf)
        p = jax.nn.softmax(jnp.concatenate([s_sel, s_own], axis=-1), axis=-1)
        o = jnp.einsum('bhqk,bhqkd->bhqd', p[..., :n_sel].astype(v.dtype), v_sel)
        o = o + jnp.einsum('bhqk,bhkd->bhqd', p[..., n_sel:].astype(v.dtype), v_own)
        return o

    out = lax.map(one_block, (q_blocks, jnp.arange(n_qb)))
    out = jnp.transpose(out, (1, 0, 3, 2, 4)).reshape(Bn, Lp, H, d)
    return out[:, :L]


def _retention(q, k, v):
    Bn, L, H, dk = q.shape
    dv = v.shape[-1]
    q, k, v = _pad_seq(q, RET_CHUNK), _pad_seq(k, RET_CHUNK), _pad_seq(v, RET_CHUNK)
    Lp = q.shape[1]
    nc = Lp // RET_CHUNK
    log_g = jnp.asarray(np.log(1.0 - 2.0 ** (-5.0 - np.arange(H))).astype(np.float32))
    qc = q.reshape(Bn, nc, RET_CHUNK, H, dk)
    kc = (k * dk ** -0.5).reshape(Bn, nc, RET_CHUNK, H, dk)
    vc = v.reshape(Bn, nc, RET_CHUNK, H, dv)
    pos = jnp.arange(RET_CHUNK, dtype=jnp.float32)
    diff = pos[:, None] - pos[None, :]
    decay = jnp.where(diff >= 0, jnp.exp(log_g[:, None, None] * jnp.maximum(diff, 0.0)), 0.0)
    s = jnp.einsum('bnihd,bnjhd->bnhij', qc, kc) * decay
    intra = jnp.einsum('bnhij,bnjhe->bnihe', s, vc)
    zeta = jnp.exp(log_g[None, :] * (RET_CHUNK - 1 - pos)[:, None])
    kv = jnp.einsum('bnjhd,bnjhe->bnhde', kc * zeta[:, :, None], vc)
    chunk_decay = jnp.exp(log_g * RET_CHUNK)[:, None, None]

    def step(state, kv_n):
        return state * chunk_decay + kv_n, state

    _, prev = lax.scan(step, jnp.zeros((Bn, H, dk, dv), kv.dtype), jnp.moveaxis(kv, 1, 0))
    prev = jnp.moveaxis(prev, 0, 1)
    xi = jnp.exp(log_g[None, :] * (pos + 1.0)[:, None])
    cross = jnp.einsum('bnihd,bnhde->bnihe', qc * xi[:, :, None], prev)
    return (intra + cross).reshape(Bn, Lp, H, dv)[:, :L]


def _cplx_scan_op(left, right):
    a1r, a1i, b1r, b1i = left
    a2r, a2i, b2r, b2i = right
    ar = a2r * a1r - a2i * a1i
    ai = a2r * a1i + a2i * a1r
    br = a2r * b1r - a2i * b1i + b2r
    bi = a2r * b1i + a2i * b1r + b2i
    return ar, ai, br, bi


def _s5_ssm(u, lam_re, lam_im, log_step, b_re, b_im, c_re, c_im, d_skip, w_glu, b_glu):
    Bn, L, W = u.shape
    ug = u.reshape(Bn, L, N_SSM_GROUPS, SSM_GROUP)
    lr = jnp.minimum(lam_re.astype(jnp.float32), -1e-4)
    li = lam_im.astype(jnp.float32)
    dt = jnp.exp(log_step.astype(jnp.float32))[:, None]
    mag = jnp.exp(lr * dt)
    ab_re = mag * jnp.cos(li * dt)
    ab_im = mag * jnp.sin(li * dt)
    den = lr * lr + li * li
    zr = ab_re - 1.0
    zi = ab_im
    f_re = (zr * lr + zi * li) / den
    f_im = (zi * lr - zr * li) / den
    bb_re = f_re[..., None] * b_re - f_im[..., None] * b_im
    bb_im = f_re[..., None] * b_im + f_im[..., None] * b_re
    x_re = jnp.einsum('blgc,gnc->blgn', ug, bb_re)
    x_im = jnp.einsum('blgc,gnc->blgn', ug, bb_im)
    a_re = jnp.broadcast_to(ab_re, x_re.shape)
    a_im = jnp.broadcast_to(ab_im, x_im.shape)
    _, _, h_re, h_im = lax.associative_scan(_cplx_scan_op, (a_re, a_im, x_re, x_im), axis=1)
    y = jnp.einsum('blgn,gcn->blgc', h_re, c_re) - jnp.einsum('blgn,gcn->blgc', h_im, c_im)
    y = y.reshape(Bn, L, W) + d_skip * u
    y = jax.nn.gelu(y)
    return y * jax.nn.sigmoid(jnp.dot(y, w_glu) + b_glu)


def _route(h, router_w, router_bias):
    T = h.shape[0]
    aff = jax.nn.sigmoid(jnp.dot(h, router_w).astype(jnp.float32))
    sel = aff + router_bias.astype(jnp.float32)
    grp = sel.reshape(T, N_EXPERT_GROUPS, EXPERTS_PER_GROUP)
    grp_score = jnp.sum(lax.top_k(grp, TOP_K)[0], axis=-1)
    g = jnp.argmax(grp_score, axis=-1)
    rows = jnp.arange(T)
    _, local = lax.top_k(grp[rows, g], TOP_K)
    idx = (g[:, None] * EXPERTS_PER_GROUP + local).astype(jnp.int32)
    w = aff[rows[:, None], idx]
    w = w / jnp.sum(w, axis=-1, keepdims=True)
    return idx, w


def _moe(h, idx, w, w_gate, w_up, w_down):
    T, D = h.shape
    TK = T * TOP_K
    flat_e = idx.reshape(-1)
    flat_tok = jnp.repeat(jnp.arange(T, dtype=jnp.int32), TOP_K)
    order = jnp.argsort(flat_e)
    se = flat_e[order]
    st = flat_tok[order]
    sw = w.reshape(-1)[order]
    counts = jnp.bincount(flat_e, length=N_EXPERTS)
    padded = (counts + MOE_ROWS - 1) // MOE_ROWS * MOE_ROWS
    pend = jnp.cumsum(padded)
    pstart = pend - padded
    start = jnp.cumsum(counts) - counts
    dest = pstart[se] + jnp.arange(TK) - start[se]
    n_blocks = -(-(TK + N_EXPERTS * (MOE_ROWS - 1)) // MOE_ROWS)
    buf_tok = jnp.full((n_blocks * MOE_ROWS,), T, jnp.int32).at[dest].set(st)
    blk_e = jnp.minimum(jnp.searchsorted(pend, jnp.arange(n_blocks) * MOE_ROWS, side='right'), N_EXPERTS - 1)
    h_pad = jnp.concatenate([h, jnp.zeros((1, D), h.dtype)], axis=0)

    def block(args):
        toks, e = args
        xb = h_pad[toks]
        a = jnp.dot(xb, w_gate[e])
        b = jnp.dot(xb, w_up[e])
        return jnp.dot(jax.nn.silu(a) * b, w_down[e])

    out = lax.map(block, (buf_tok.reshape(n_blocks, MOE_ROWS), blk_e)).reshape(-1, D)
    contrib = out[dest] * sw[:, None].astype(out.dtype)
    return jnp.zeros((T, D), out.dtype).at[st].add(contrib)


def setup_inputs(seed: int = 0) -> dict:
    key = jax.random.key(seed)
    ks = jax.random.split(key, 24)
    f32 = jnp.float32

    def nrm(k, shape, std):
        return std * jax.random.normal(k, shape, f32)

    x = nrm(ks[0], (BATCH, SEQ, D_MODEL), 1.0)
    col_scale = np.full((D_IN,), D_MODEL ** -0.5, np.float32)
    col_scale[2 * D_ATTN:3 * D_ATTN] *= BETA
    col_scale[3 * D_ATTN + 2 * D_RET:3 * D_ATTN + 3 * D_RET] *= BETA
    w_in = nrm(ks[1], (DEPTH, D_MODEL, D_IN), 1.0) * jnp.asarray(col_scale)
    w_out = nrm(ks[2], (DEPTH, D_MIX, D_MODEL), BETA * D_MIX ** -0.5)
    gn = (DEPTH, N_SSM_GROUPS, SSM_STATE)
    ssm_lambda_re = -0.5 + nrm(ks[3], gn, 0.01)
    ssm_lambda_im = math.pi * jnp.arange(SSM_STATE, dtype=f32) + nrm(ks[4], gn, 0.01)
    ssm_log_step = jax.random.uniform(ks[5], (DEPTH, N_SSM_GROUPS), f32, math.log(1e-3), math.log(1e-1))
    ssm_b_re = nrm(ks[6], (DEPTH, N_SSM_GROUPS, SSM_STATE, SSM_GROUP), (2 * SSM_GROUP) ** -0.5)
    ssm_b_im = nrm(ks[7], (DEPTH, N_SSM_GROUPS, SSM_STATE, SSM_GROUP), (2 * SSM_GROUP) ** -0.5)
    ssm_c_re = nrm(ks[8], (DEPTH, N_SSM_GROUPS, SSM_GROUP, SSM_STATE), 0.5)
    ssm_c_im = nrm(ks[9], (DEPTH, N_SSM_GROUPS, SSM_GROUP, SSM_STATE), 0.5)
    ssm_d = nrm(ks[10], (DEPTH, D_SSM), 1.0)
    ssm_w_glu = nrm(ks[11], (DEPTH, D_SSM, D_SSM), D_SSM ** -0.5)
    ssm_b_glu = nrm(ks[12], (DEPTH, D_SSM), 0.01)
    ln1_g = 1.0 + nrm(ks[13], (DEPTH, D_MODEL), 0.02)
    ln1_b = nrm(ks[14], (DEPTH, D_MODEL), 0.01)
    ln2_g = 1.0 + nrm(ks[15], (DEPTH, D_MODEL), 0.02)
    ln2_b = nrm(ks[16], (DEPTH, D_MODEL), 0.01)
    router_w = nrm(ks[17], (D_MODEL, N_EXPERTS), D_MODEL ** -0.5)
    router_bias = nrm(ks[18], (N_EXPERTS,), 0.01)
    w_gate = nrm(ks[19], (DEPTH, N_EXPERTS, D_MODEL, D_FF_EXPERT), D_MODEL ** -0.5)
    w_up = nrm(ks[20], (DEPTH, N_EXPERTS, D_MODEL, D_FF_EXPERT), D_MODEL ** -0.5)
    w_down = nrm(ks[21], (DEPTH, N_EXPERTS, D_FF_EXPERT, D_MODEL), BETA * D_FF_EXPERT ** -0.5)
    return {'x': x, 'w_in': w_in, 'w_out': w_out,
            'ssm_lambda_re': ssm_lambda_re, 'ssm_lambda_im': ssm_lambda_im, 'ssm_log_step': ssm_log_step,
            'ssm_b_re': ssm_b_re, 'ssm_b_im': ssm_b_im, 'ssm_c_re': ssm_c_re, 'ssm_c_im': ssm_c_im,
            'ssm_d': ssm_d, 'ssm_w_glu': ssm_w_glu, 'ssm_b_glu': ssm_b_glu,
            'ln1_g': ln1_g, 'ln1_b': ln1_b, 'ln2_g': ln2_g, 'ln2_b': ln2_b,
            'router_w': router_w, 'router_bias': router_bias,
            'w_gate': w_gate, 'w_up': w_up, 'w_down': w_down}


def reference(x, w_in, w_out, ssm_lambda_re, ssm_lambda_im, ssm_log_step, ssm_b_re, ssm_b_im,
              ssm_c_re, ssm_c_im, ssm_d, ssm_w_glu, ssm_b_glu, ln1_g, ln1_b, ln2_g, ln2_b,
              router_w, router_bias, w_gate, w_up, w_down):
    Bn, L, D = x.shape
    splits = [int(s) for s in np.cumsum([D_ATTN] * 3 + [D_RET] * 4)]
    for l in range(DEPTH):
        proj = jnp.einsum('bld,de->ble', x, w_in[l])
        qa, ka, va, qr, kr, vr, gr, us = jnp.split(proj, splits, axis=-1)
        y_attn = _moba_attention(qa.reshape(Bn, L, N_ATTN_HEADS, HEAD_DIM),
                                 ka.reshape(Bn, L, N_ATTN_HEADS, HEAD_DIM),
                                 va.reshape(Bn, L, N_ATTN_HEADS, HEAD_DIM)).reshape(Bn, L, D_ATTN)
        y_ret = _retention(qr.reshape(Bn, L, N_RET_HEADS, HEAD_DIM),
                           kr.reshape(Bn, L, N_RET_HEADS, HEAD_DIM),
                           vr.reshape(Bn, L, N_RET_HEADS, HEAD_DIM))
        y_ret = _head_norm(y_ret).reshape(Bn, L, D_RET) * jax.nn.silu(gr)
        y_ssm = _s5_ssm(us, ssm_lambda_re[l], ssm_lambda_im[l], ssm_log_step[l], ssm_b_re[l], ssm_b_im[l],
                        ssm_c_re[l], ssm_c_im[l], ssm_d[l], ssm_w_glu[l], ssm_b_glu[l])
        mixed = jnp.dot(jnp.concatenate([y_attn, y_ret, y_ssm], axis=-1), w_out[l])
        x = _layer_norm(ALPHA * x + mixed, ln1_g[l], ln1_b[l])
        h = x.reshape(Bn * L, D)
        idx, gw = _route(h, router_w, router_bias)
        y_moe = _moe(h, idx, gw, w_gate[l], w_up[l], w_down[l]).reshape(Bn, L, D)
        x = _layer_norm(ALPHA * x + y_moe, ln2_g[l], ln2_b[l])
    return x
```

```cpp
#include <hip/hip_runtime.h>
#include <hip/hip_cooperative_groups.h>
#include <cstdio>
#include <cstdint>
namespace cg = cooperative_groups;

#ifndef MK_ONE_LAUNCH
#define MK_ONE_LAUNCH 0
#endif

#define DI __device__ __forceinline__
#define GAS __attribute__((address_space(1)))
#define LAS __attribute__((address_space(3)))
typedef unsigned short bf16;
typedef float f32x4 __attribute__((ext_vector_type(4)));
typedef float f32x2 __attribute__((ext_vector_type(2)));
typedef unsigned u32x4 __attribute__((ext_vector_type(4)));
typedef unsigned u32x2 __attribute__((ext_vector_type(2)));
typedef short bf16x8 __attribute__((ext_vector_type(8)));

constexpr int BATCH = 2, SEQ = 16384, DM = 1024, TOK = BATCH * SEQ, DEPTH = 2;
constexpr int DIN = 2944, DINP = 3072;
constexpr int C_QA = 0, C_KA = 384, C_VA = 768, C_QR = 1152, C_KR = 1536, C_VR = 1920, C_GR = 2304, C_US = 2688;
constexpr int NH = 6, HD = 64, NKB = 64, KBLK = 256;
constexpr int NE = 16, DFF = 512, LCAP = TOK;
constexpr int MAXBLK = 288;
constexpr float ALPHA = 1.41421356237309505f;
constexpr float LN_EPS = 1e-5f, GN_EPS = 1e-6f;
constexpr int NWAVES = 8, NTHR = 512;

constexpr size_t MiB = 1u << 20;
constexpr size_t WS_CTL = 0, CTL_ZERO_BYTES = 1 * MiB;
constexpr size_t WS_SMALL = 1 * MiB;
constexpr size_t WS_WIN = 5 * MiB;
constexpr size_t WS_WOUT = 17 * MiB;
constexpr size_t WS_WGU = 21 * MiB;
constexpr size_t WS_WD = 85 * MiB;
constexpr size_t WS_XB = 117 * MiB;
constexpr size_t WS_X1B = 181 * MiB;
constexpr size_t WS_PROJ = 245 * MiB;
constexpr size_t WS_H = WS_PROJ, WS_YM0 = WS_PROJ + 68 * MiB;
constexpr size_t WS_YMIX = 437 * MiB;
constexpr size_t WS_YM1 = WS_YMIX;
constexpr size_t WS_LTOK = 501 * MiB;
constexpr size_t WS_LW = 503 * MiB;
constexpr size_t WS_END = 505 * MiB;
constexpr int SSMP_FLOATS = 36864;
constexpr size_t SM_SSMP = 0;
constexpr size_t SM_KMEAN = 2 * SSMP_FLOATS * 4;
constexpr size_t DO_RETKV = 0;
constexpr size_t DO_S5E = 24 * MiB;
constexpr size_t DO_YG = 26 * MiB;
constexpr int CW_BAR = 4096;
constexpr int CW_ECNT = 1024;
constexpr int RING_BYTES = 131072, LDSCTL_OFF = RING_BYTES, MISC_OFF = LDSCTL_OFF + 320, MOE_TAB_OFF = LDSCTL_OFF + 1024;
constexpr int LDS_BYTES = 147456;

DI float bf2f(unsigned short v) { return __uint_as_float((unsigned)v << 16); }
DI unsigned f2bf(float f) { unsigned u = __float_as_uint(f); return (u + 0x7fffu + ((u >> 16) & 1u)) >> 16; }
DI unsigned pk2(float lo, float hi) { return f2bf(lo) | (f2bf(hi) << 16); }
DI void unpack8(const u32x4 v, float* o) {
    o[0] = __uint_as_float(v.x << 16); o[1] = __uint_as_float(v.x & 0xffff0000u); o[2] = __uint_as_float(v.y << 16); o[3] = __uint_as_float(v.y & 0xffff0000u);
    o[4] = __uint_as_float(v.z << 16); o[5] = __uint_as_float(v.z & 0xffff0000u); o[6] = __uint_as_float(v.w << 16); o[7] = __uint_as_float(v.w & 0xffff0000u);
}
DI void sincos_acc(float a, float& sn, float& cs) {
    const double ad = (double)a; const double kd = rint(ad * 0.63661977236758134308); const int k = (int)kd;
    const float r = (float)(ad - kd * 1.57079632679489661923), z = r * r;
    const float sp = r + r * z * (-1.6666667163e-01f + z * (8.3333337680e-03f + z * (-1.9841270114e-04f + z * (2.7557314297e-06f + z * (-2.5050759689e-08f)))));
    const float cp = 1.0f - 0.5f * z + z * z * (4.1666667908e-02f + z * (-1.3888889225e-03f + z * (2.4801587642e-05f + z * (-2.7557314297e-07f + z * (2.0875723372e-09f)))));
    const int q = k & 3;
    sn = q == 0 ? sp : q == 1 ? cp : q == 2 ? -sp : -cp;
    cs = q == 0 ? cp : q == 1 ? -sp : q == 2 ? -cp : sp;
}
DI float wave_sum(float v) {
#pragma unroll
    for (int o = 1; o < 64; o <<= 1) v += __shfl_xor(v, o);
    return v;
}
DI float ret_log2g(int h) {
    return h == 0 ? -0.04580368961312479f : h == 1 ? -0.02272007650008353f : h == 2 ? -0.011315313227834146f : h == 3 ? -0.005646563141142063f : h == 4 ? -0.0028205190623786626f : -0.0014095702546713536f;
}
DI float alibi_slope(int h) {
    return h == 0 ? 0.3968502629920499f : h == 1 ? 0.15749013123685915f : h == 2 ? 0.0625f : h == 3 ? 0.024803141437003122f : h == 4 ? 0.009843133202303695f : 0.00390625f;
}

namespace pg8 {
#define PG8_LAS __attribute__((address_space(3)))
typedef unsigned short bf16_t;
constexpr int BM = 256, BK = 64, HALF = 128, HTB = HALF * BK * 2, STAGE_BYTES = 8 * HTB, NXCD = 8, WGM = 8;
__host__ __device__ __forceinline__ int lds_byte(int r, int c) { const int st = (r >> 4) * 2 + (c >> 5), rr = r & 15, cc = c & 31, ob = rr * 64 + cc * 2; return st * 1024 + (ob ^ (((ob >> 9) & 1) << 5)); }
__host__ __device__ __forceinline__ void stage_rc(int b, int& R, int& C) { const int st = b / 1024, sb = b % 1024, swz = sb ^ (((sb >> 9) & 1) << 5); R = (st >> 1) * 16 + swz / 64; C = (st & 1) * 32 + (swz % 64) / 2; }
__host__ __device__ __forceinline__ int perm32(int rho) { const int n = rho >> 4, i = rho & 15; return 8 * (i >> 2) + 4 * n + (i & 3); }

struct Unit { int pm, pn, e, jb; };

template <class Epi, class Sched, bool ALIGN_EPI>
__device__ __forceinline__ void gemm_phase(PG8_LAS unsigned char* lds, const int tid, const int K, const Sched& S, const Epi& E) {
    const int wid = __builtin_amdgcn_readfirstlane(tid >> 6), lane = tid & 63, wr = wid >> 2, wc = wid & 3, fr = lane & 15, fq = lane >> 4;
    const int nt = K / BK;
    unsigned voffB[2];
#pragma unroll
    for (int i = 0; i < 2; ++i) { int R, C; stage_rc(tid * 16 + i * 8192, R, C); const int Rb = Epi::PERM ? ((R & ~31) + perm32(R & 31)) : R; voffB[i] = (unsigned)(Rb * K + C) * 2u; }
    const size_t kstep = (size_t)(BK * 2);
    const size_t hstep = (size_t)HALF * K * 2;
    const unsigned ldsw = (unsigned)wid * 1024u;
    const int aoff = lds_byte(wr * 64 + fr, fq * 8), boff = lds_byte(wc * 32 + fr, fq * 8);
#define PG8_SA(b, h) (((b) * 2 + (h)) * HTB)
#define PG8_SB(b, h) ((4 + (b) * 2 + (h)) * HTB)
#define PG8_STAGE(bufoff, gbase, voff) do { _Pragma("unroll") for (int _i = 0; _i < 2; ++_i) \
        __builtin_amdgcn_global_load_lds((const unsigned*)((const char*)(gbase) + (voff)[_i]), (PG8_LAS unsigned*)(lds + (bufoff) + ldsw + _i * 8192), 16, 0, 0); } while (0)
#define PG8_LDA(dst, b, h) do { _Pragma("unroll") for (int m = 0; m < 4; ++m) _Pragma("unroll") for (int k = 0; k < 2; ++k) dst[m][k] = *(const PG8_LAS bf16x8*)(lds + PG8_SA(b, h) + aoff + m * 2048 + k * 1024); } while (0)
#define PG8_LDB(dst, b, h) do { _Pragma("unroll") for (int n = 0; n < 2; ++n) _Pragma("unroll") for (int k = 0; k < 2; ++k) dst[n][k] = *(const PG8_LAS bf16x8*)(lds + PG8_SB(b, h) + boff + n * 2048 + k * 1024); } while (0)
#define PG8_MMA(ai, bj, At, Bt) do { __builtin_amdgcn_s_setprio(1); _Pragma("unroll") for (int m = 0; m < 4; ++m) _Pragma("unroll") for (int n = 0; n < 2; ++n) _Pragma("unroll") for (int k = 0; k < 2; ++k) \
        acc[ai][bj][m][n] = __builtin_amdgcn_mfma_f32_16x16x32_bf16(Bt[n][k], At[m][k], acc[ai][bj][m][n], 0, 0, 0); __builtin_amdgcn_s_setprio(0); } while (0)
#define PG8_WAIT_V(n) asm volatile("s_waitcnt vmcnt(" #n ")" ::: "memory")
#define PG8_WAIT_L(n) asm volatile("s_waitcnt lgkmcnt(" #n ")" ::: "memory")
#define PG8_BAR __builtin_amdgcn_s_barrier()
#define PG8_SCHED __builtin_amdgcn_sched_barrier(0)
    Unit cur, nxt; int ui = 0;
    if (!S.next(0, cur)) return;
    f32x4 acc[2][2][4][2];
#pragma unroll
    for (int a = 0; a < 2; ++a)
#pragma unroll
        for (int b = 0; b < 2; ++b)
#pragma unroll
            for (int m = 0; m < 4; ++m)
#pragma unroll
                for (int n = 0; n < 2; ++n) acc[a][b][m][n] = (f32x4){0.f, 0.f, 0.f, 0.f};
    bf16x8 At[4][2], B0[2][2], B1[2][2];
    const char* cA; const char* cB; unsigned vA[2][2];
    S.addr(cur, tid, cA, vA, cB);
    PG8_STAGE(PG8_SB(0, 0), cB, voffB); PG8_STAGE(PG8_SB(0, 1), cB + hstep, voffB); PG8_STAGE(PG8_SA(0, 0), cA, vA[0]); PG8_STAGE(PG8_SA(0, 1), cA, vA[1]);
    if (wr == 1) PG8_BAR;
    PG8_WAIT_V(2); PG8_BAR;
    PG8_STAGE(PG8_SB(1, 0), cB + kstep, voffB); PG8_STAGE(PG8_SA(1, 0), cA + kstep, vA[0]); PG8_STAGE(PG8_SB(1, 1), cB + hstep + kstep, voffB);
    PG8_WAIT_V(6); PG8_BAR;
    for (;;) {
        const bool has_next = S.next(ui + 1, nxt);
        const char* nA = cA; const char* nB = cB; unsigned nvA[2][2] = {{vA[0][0], vA[0][1]}, {vA[1][0], vA[1][1]}};
        if (has_next) { if constexpr (Sched::A_VARIES) S.addr(nxt, tid, nA, nvA, nB); else { unsigned dummy[2][2]; S.addr(nxt, tid, nA, dummy, nB); } }
        for (int t = 0; t < nt; t += 2) {
            const bool last = (t == nt - 2);
            const char* a1 = cA + (size_t)(t + 1) * kstep;
            const char* a2 = last ? nA : cA + (size_t)(t + 2) * kstep; const char* b2 = last ? nB : cB + (size_t)(t + 2) * kstep;
            const char* a3 = a2 + kstep; const char* b3 = b2 + kstep;
            unsigned xA0[2], xA1[2];
            if constexpr (Sched::A_VARIES) { xA0[0] = last ? nvA[0][0] : vA[0][0]; xA0[1] = last ? nvA[0][1] : vA[0][1]; xA1[0] = last ? nvA[1][0] : vA[1][0]; xA1[1] = last ? nvA[1][1] : vA[1][1]; }
            else { xA0[0] = vA[0][0]; xA0[1] = vA[0][1]; xA1[0] = vA[1][0]; xA1[1] = vA[1][1]; }
            PG8_LDB(B0, 0, 0); PG8_LDB(B1, 0, 1); PG8_SCHED; PG8_LDA(At, 0, 0); PG8_STAGE(PG8_SA(1, 1), a1, vA[1]);
            PG8_WAIT_V(8); PG8_WAIT_L(0); PG8_BAR; PG8_MMA(0, 0, At, B0); PG8_MMA(0, 1, At, B1); PG8_BAR; PG8_SCHED;
            PG8_LDA(At, 0, 1); PG8_STAGE(PG8_SB(0, 0), b2, voffB); PG8_STAGE(PG8_SB(0, 1), b2 + hstep, voffB); PG8_STAGE(PG8_SA(0, 0), a2, xA0);
            PG8_WAIT_V(8); PG8_WAIT_L(0); PG8_BAR; PG8_MMA(1, 0, At, B0); PG8_MMA(1, 1, At, B1); PG8_BAR; PG8_SCHED;
            PG8_LDB(B0, 1, 0); PG8_LDB(B1, 1, 1); PG8_SCHED; PG8_LDA(At, 1, 0); PG8_STAGE(PG8_SA(0, 1), a2, xA1);
            PG8_WAIT_V(8); PG8_WAIT_L(0); PG8_BAR; PG8_MMA(0, 0, At, B0); PG8_MMA(0, 1, At, B1); PG8_BAR; PG8_SCHED;
            PG8_LDA(At, 1, 1); PG8_STAGE(PG8_SB(1, 0), b3, voffB); PG8_STAGE(PG8_SB(1, 1), b3 + hstep, voffB); PG8_STAGE(PG8_SA(1, 0), a3, xA0);
            PG8_WAIT_V(8); PG8_WAIT_L(0); PG8_BAR; PG8_MMA(1, 0, At, B0); PG8_MMA(1, 1, At, B1); PG8_BAR; PG8_SCHED;
        }
        if constexpr (ALIGN_EPI) { if (wr == 0) PG8_BAR; }
        E(acc, cur, wr, wc, fr, fq);
        if (!has_next) break;
#pragma unroll
        for (int a = 0; a < 2; ++a)
#pragma unroll
            for (int b = 0; b < 2; ++b)
#pragma unroll
                for (int m = 0; m < 4; ++m)
#pragma unroll
                    for (int n = 0; n < 2; ++n) acc[a][b][m][n] = (f32x4){0.f, 0.f, 0.f, 0.f};
        cur = nxt; cA = nA; cB = nB; if constexpr (Sched::A_VARIES) { vA[0][0] = nvA[0][0]; vA[0][1] = nvA[0][1]; vA[1][0] = nvA[1][0]; vA[1][1] = nvA[1][1]; } ++ui;
        if constexpr (ALIGN_EPI) { if (wr == 1) PG8_BAR; }
    }
    PG8_WAIT_V(0);
    if constexpr (!ALIGN_EPI) { if (wr == 0) PG8_BAR; }
    PG8_BAR;
#undef PG8_SA
#undef PG8_SB
#undef PG8_STAGE
#undef PG8_LDA
#undef PG8_LDB
#undef PG8_MMA
#undef PG8_WAIT_V
#undef PG8_WAIT_L
#undef PG8_BAR
#undef PG8_SCHED
}

struct DenseSched {
    static constexpr bool A_VARIES = false;
    const bf16_t* A; const bf16_t* Bt; int K; int nM, nN, nwg, G, c;
    __device__ void init(const bf16_t* A_, const bf16_t* Bt_, int M, int N, int K_, int G_, int c_) { A = A_; Bt = Bt_; K = K_; nM = M / BM; nN = N / BM; nwg = nM * nN; G = G_; c = c_; }
    __device__ __forceinline__ bool next(int i, Unit& u) const {
        const long L = (long)i * G + c; if (L >= nwg) return false;
        int wgid = (int)L; { const int q = nwg / NXCD, r = nwg % NXCD, xcd = wgid % NXCD, off = wgid / NXCD; wgid = (xcd < r ? xcd * (q + 1) : r * (q + 1) + (xcd - r) * q) + off; }
        const int nig = WGM * nN, gid = wgid / nig, fm = gid * WGM, gsz = (nM - fm) < WGM ? (nM - fm) : WGM;
        u.pm = __builtin_amdgcn_readfirstlane(fm + ((wgid % nig) % gsz)); u.pn = __builtin_amdgcn_readfirstlane((wgid % nig) / gsz); u.e = 0; u.jb = 0; return true;
    }
    __device__ __forceinline__ void addr(const Unit& u, int tid, const char*& a, unsigned (&vA)[2][2], const char*& b) const {
        asm volatile("" : "+v"(tid));
        a = (const char*)A + (size_t)u.pm * BM * K * 2; b = (const char*)Bt + (size_t)u.pn * BM * K * 2;
#pragma unroll
        for (int i = 0; i < 2; ++i) { int R, C; stage_rc(tid * 16 + i * 8192, R, C);
#pragma unroll
            for (int h = 0; h < 2; ++h) vA[h][i] = (unsigned)((h * HALF + R) * K + C) * 2u; }
    }
};
struct MoeUpSched {
    static constexpr bool A_VARIES = true;
    const bf16_t* X; const bf16_t* W; const unsigned* ltok; const PG8_LAS int* tab; int G, c;
    __device__ __forceinline__ bool next(int i, Unit& u) const {
        const int id = i * G + c; const int nb = __builtin_amdgcn_readfirstlane(tab[32]); if (id >= nb * 4) return false;
        const int blk = id >> 2; u.pm = blk; u.pn = id & 3; u.e = __builtin_amdgcn_readfirstlane(tab[64 + blk]); u.jb = blk - __builtin_amdgcn_readfirstlane(tab[16 + u.e]); return true;
    }
    __device__ __forceinline__ void addr(const Unit& u, int tid, const char*& a, unsigned (&vA)[2][2], const char*& b) const {
        asm volatile("" : "+v"(tid));
        a = (const char*)X; b = (const char*)W + ((size_t)u.e * 1024 + (size_t)u.pn * BM) * 1024 * 2;
        const int cnt = __builtin_amdgcn_readfirstlane(tab[u.e]); const unsigned* lt = ltok + (size_t)u.e * LCAP + u.jb * 256;
#pragma unroll
        for (int i = 0; i < 2; ++i) { int R, C; stage_rc(tid * 16 + i * 8192, R, C);
#pragma unroll
            for (int h = 0; h < 2; ++h) { const int r = h * HALF + R; const bool ok = (u.jb * 256 + r) < cnt; const unsigned tk = ok ? (lt[r] & 0x7fffffffu) : 0u; vA[h][i] = (tk * 1024u + (unsigned)C) * 2u; } }
    }
};
struct MoeDownSched {
    static constexpr bool A_VARIES = false;
    const bf16_t* Hb; const bf16_t* W; const PG8_LAS int* tab; int G, c;
    __device__ __forceinline__ bool next(int i, Unit& u) const {
        const int id = i * G + c; const int nb = __builtin_amdgcn_readfirstlane(tab[32]); if (id >= nb * 4) return false;
        const int blk = id >> 2; u.pm = blk; u.pn = id & 3; u.e = __builtin_amdgcn_readfirstlane(tab[64 + blk]); u.jb = blk - __builtin_amdgcn_readfirstlane(tab[16 + u.e]); return true;
    }
    __device__ __forceinline__ void addr(const Unit& u, int tid, const char*& a, unsigned (&vA)[2][2], const char*& b) const {
        asm volatile("" : "+v"(tid));
        a = (const char*)Hb + (size_t)u.pm * BM * DFF * 2; b = (const char*)W + ((size_t)u.e * 1024 + (size_t)u.pn * BM) * DFF * 2;
#pragma unroll
        for (int i = 0; i < 2; ++i) { int R, C; stage_rc(tid * 16 + i * 8192, R, C);
#pragma unroll
            for (int h = 0; h < 2; ++h) vA[h][i] = (unsigned)((h * HALF + R) * DFF + C) * 2u; }
    }
};

struct EpiBf16 {
    static constexpr bool PERM = true;
    bf16_t* O; int ldc;
    __device__ __forceinline__ void operator()(const f32x4 (&acc)[2][2][4][2], const Unit& u, int wr, int wc, int fr, int fq) const {
        asm volatile("" : "+v"(fr), "+v"(fq));
        const int row0 = u.pm * BM + wr * 64 + fr; const int col0 = u.pn * BM + wc * 32 + 8 * fq;
#pragma unroll
        for (int ai = 0; ai < 2; ++ai)
#pragma unroll
            for (int m = 0; m < 4; ++m) { bf16_t* rowp = O + (size_t)(row0 + ai * HALF + m * 16) * ldc + col0;
#pragma unroll
                for (int bj = 0; bj < 2; ++bj) { const f32x4 v0 = acc[ai][bj][m][0], v1 = acc[ai][bj][m][1];
                    u32x4 w; w.x = pk2(v0[0], v0[1]); w.y = pk2(v0[2], v0[3]); w.z = pk2(v1[0], v1[1]); w.w = pk2(v1[2], v1[3]);
                    *(u32x4*)(rowp + bj * HALF) = w; } }
    }
};
struct EpiResF32 {
    static constexpr bool PERM = false;
    float* V; const bf16_t* XBp;
    __device__ __forceinline__ void operator()(const f32x4 (&acc)[2][2][4][2], const Unit& u, int wr, int wc, int fr, int fq) const {
        asm volatile("" : "+v"(fr), "+v"(fq));
        const int row0 = u.pm * BM + wr * 64 + fr; const int col0 = u.pn * BM + wc * 32 + 4 * fq;
#pragma unroll
        for (int ai = 0; ai < 2; ++ai)
#pragma unroll
            for (int m = 0; m < 4; ++m) { const size_t off = (size_t)(row0 + ai * HALF + m * 16) * DM + col0;
#pragma unroll
                for (int bj = 0; bj < 2; ++bj)
#pragma unroll
                    for (int n = 0; n < 2; ++n) { const u32x2 xb = *(const u32x2*)(XBp + off + bj * HALF + n * 16); const f32x4 a = acc[ai][bj][m][n];
                        f32x4 o; o[0] = ALPHA * __uint_as_float(xb.x << 16) + a[0]; o[1] = ALPHA * __uint_as_float(xb.x & 0xffff0000u) + a[1];
                        o[2] = ALPHA * __uint_as_float(xb.y << 16) + a[2]; o[3] = ALPHA * __uint_as_float(xb.y & 0xffff0000u) + a[3];
                        *(f32x4*)(V + off + bj * HALF + n * 16) = o; } }
    }
};
__device__ __forceinline__ float silu_f(float x) { return x * __builtin_amdgcn_rcpf(1.0f + __builtin_amdgcn_exp2f(-1.4426950408889634f * x)); }
struct EpiSwiGLU {
    static constexpr bool PERM = true;
    bf16_t* Hb;
    __device__ __forceinline__ void operator()(const f32x4 (&acc)[2][2][4][2], const Unit& u, int wr, int wc, int fr, int fq) const {
        asm volatile("" : "+v"(fr), "+v"(fq));
        const int row0 = u.pm * BM + wr * 64 + fr; const int col0 = u.pn * HALF + wc * 32 + 8 * fq;
#pragma unroll
        for (int ai = 0; ai < 2; ++ai)
#pragma unroll
            for (int m = 0; m < 4; ++m) { bf16_t* p = Hb + (size_t)(row0 + ai * HALF + m * 16) * DFF + col0;
                const f32x4 g0 = acc[ai][0][m][0], g1 = acc[ai][0][m][1], u0 = acc[ai][1][m][0], u1 = acc[ai][1][m][1];
                u32x4 w; w.x = pk2(silu_f(g0[0]) * u0[0], silu_f(g0[1]) * u0[1]); w.y = pk2(silu_f(g0[2]) * u0[2], silu_f(g0[3]) * u0[3]);
                w.z = pk2(silu_f(g1[0]) * u1[0], silu_f(g1[1]) * u1[1]); w.w = pk2(silu_f(g1[2]) * u1[2], silu_f(g1[3]) * u1[3]);
                *(u32x4*)p = w; }
    }
};
struct EpiMoeScatter {
    static constexpr bool PERM = true;
    bf16_t* YM0; bf16_t* YM1; const unsigned* ltok; const float* lw; const PG8_LAS int* tab;
    __device__ __forceinline__ void operator()(const f32x4 (&acc)[2][2][4][2], const Unit& u, int wr, int wc, int fr, int fq) const {
        asm volatile("" : "+v"(fr), "+v"(fq));
        const int cnt = __builtin_amdgcn_readfirstlane(tab[u.e]); const int col0 = u.pn * BM + wc * 32 + 8 * fq;
        const size_t lbase = (size_t)u.e * LCAP + (size_t)u.jb * 256;
#pragma unroll
        for (int ai = 0; ai < 2; ++ai)
#pragma unroll
            for (int m = 0; m < 4; ++m) { const int r = ai * HALF + wr * 64 + m * 16 + fr;
                if (u.jb * 256 + r < cnt) {
                    const unsigned tk = ltok[lbase + r]; const float w = lw[lbase + r];
                    bf16_t* p = ((tk >> 31) ? YM1 : YM0) + (size_t)(tk & 0x7fffffffu) * DM + col0;
#pragma unroll
                    for (int bj = 0; bj < 2; ++bj) { const f32x4 v0 = acc[ai][bj][m][0], v1 = acc[ai][bj][m][1];
                        u32x4 o; o.x = pk2(w * v0[0], w * v0[1]); o.y = pk2(w * v0[2], w * v0[3]); o.z = pk2(w * v1[0], w * v1[1]); o.w = pk2(w * v1[2], w * v1[3]);
                        *(u32x4*)(p + bj * HALF) = o; } } }
    }
};
}

#define XB_TMO      128
#define XB_XCNT(j)  (256  + 64 * (j))
#define XB_XSUB(j)  (1280 + 64 * (j))
#define XB_XGEN(j)  (2304 + 64 * (j))
#define XB_TOP      3328
#define XB_TOPGEN   3392
#define XCD_BAR_WORDS 3456
#define XB_SPIN_CAP (1u << 22)
DI unsigned xb_ld(unsigned* p)              { return __hip_atomic_load(p, __ATOMIC_RELAXED, __HIP_MEMORY_SCOPE_AGENT); }
DI unsigned xb_add(unsigned* p, unsigned v) { return __hip_atomic_fetch_add(p, v, __ATOMIC_RELAXED, __HIP_MEMORY_SCOPE_AGENT); }
DI unsigned xb_xcc_id() { return (unsigned)__builtin_amdgcn_s_getreg((3 << 11) | 20) & 0xFu; }
#define XB_SPIN(cond, bar) do { unsigned _sp = 0; while (cond) { __builtin_amdgcn_s_sleep(1); \
    if ((++_sp & 255u) == 0u) { if (xb_ld(&(bar)[XB_TMO])) break; if (_sp > XB_SPIN_CAP) { atomicAdd(&(bar)[XB_TMO], 1u); break; } } } } while (0)
struct XcdBarrier { unsigned* bar; unsigned x; volatile LAS unsigned* st; };
DI XcdBarrier xcd_barrier_post(unsigned* bar, volatile LAS unsigned* st) {
    XcdBarrier b; b.bar = bar; b.x = xb_xcc_id(); b.st = st;
    if (threadIdx.x == 0) (void)xb_add(&bar[XB_XCNT(b.x)], 1u);
    return b;
}
DI void xcd_barrier_complete(unsigned* bar, unsigned x, unsigned& nloc, unsigned& nx) {
    const unsigned G = gridDim.x * gridDim.y * gridDim.z;
    unsigned sum, cnt, mine, sp = 0u;
    for (;;) {
        sum = 0u; cnt = 0u; mine = 0u;
#pragma unroll
        for (unsigned j = 0; j < 16; ++j) { const unsigned c = xb_ld(&bar[XB_XCNT(j)]); sum += c; cnt += (c > 0u) ? 1u : 0u; mine = (j == x) ? c : mine; }
        if (sum == G) break;
        __builtin_amdgcn_s_sleep(1);
        if ((++sp & 255u) == 0u) { if (xb_ld(&bar[XB_TMO])) break; if (sp > XB_SPIN_CAP) { atomicAdd(&bar[XB_TMO], 1u); break; } }
    }
    nloc = mine > 0u ? mine : 1u; nx = cnt > 0u ? cnt : 1u;
}
DI void xcd_barrier(const XcdBarrier& b) {
    asm volatile("s_waitcnt vmcnt(0)" ::: "memory");
    __syncthreads();
    if (threadIdx.x == 0) {
        unsigned* bar = b.bar;
        __builtin_amdgcn_s_waitcnt(0);
        unsigned nloc = b.st[0], nx = b.st[1];
        if (nloc == 0u) { xcd_barrier_complete(bar, b.x, nloc, nx); b.st[0] = nloc; b.st[1] = nx; }
        const unsigned old = xb_add(&bar[XB_XSUB(b.x)], 1u);
        const unsigned gen = old / nloc;
        if (old + 1u == (gen + 1u) * nloc) {
            __builtin_amdgcn_fence(__ATOMIC_RELEASE, "agent");
            asm volatile("s_waitcnt vmcnt(0)" ::: "memory");
            const unsigned og = xb_add(&bar[XB_TOP], 1u);
            const unsigned tg = og / nx;
            if (og + 1u == (tg + 1u) * nx) xb_add(&bar[XB_TOPGEN], 1u);
            else XB_SPIN(xb_ld(&bar[XB_TOPGEN]) == tg, bar);
            __builtin_amdgcn_fence(__ATOMIC_ACQUIRE, "agent");
            xb_add(&bar[XB_XGEN(b.x)], 1u);
            asm volatile("s_waitcnt vmcnt(0)" ::: "memory");
        } else {
            XB_SPIN(xb_ld(&bar[XB_XGEN(b.x)]) == gen, bar);
            __builtin_amdgcn_fence(__ATOMIC_ACQUIRE, "agent");
            asm volatile("s_waitcnt vmcnt(0)" ::: "memory");
        }
    }
    __syncthreads();
}

struct Args { const float* in[22]; float* out; unsigned char* ws; int ph_lo, ph_hi; };
struct Frame {
    LAS unsigned char* lds;
    const Args* ka;
    int tid, lane, wave, wg, G;
};
struct Ptrs {
    const Args* a; unsigned char* ws; float* out;
    DI const float* in(int k) const { return a->in[k]; }
    DI unsigned* ctl() const { return (unsigned*)(ws + WS_CTL); }
    DI bf16* Win_t() const { return (bf16*)(ws + WS_WIN); }
    DI bf16* Wout_t() const { return (bf16*)(ws + WS_WOUT); }
    DI bf16* Wgu_t() const { return (bf16*)(ws + WS_WGU); }
    DI bf16* Wd_t() const { return (bf16*)(ws + WS_WD); }
    DI bf16* XB() const { return (bf16*)(ws + WS_XB); }
    DI bf16* X1B() const { return (bf16*)(ws + WS_X1B); }
    DI bf16* PROJ() const { return (bf16*)(ws + WS_PROJ); }
    DI bf16* YMIX() const { return (bf16*)(ws + WS_YMIX); }
    DI bf16* Hb() const { return (bf16*)(ws + WS_H); }
    DI bf16* YM0() const { return (bf16*)(ws + WS_YM0); }
    DI bf16* YM1() const { return (bf16*)(ws + WS_YM1); }
    DI unsigned* ltok() const { return (unsigned*)(ws + WS_LTOK); }
    DI float* lw() const { return (float*)(ws + WS_LW); }
    DI float* small() const { return (float*)(ws + WS_SMALL); }
    DI float* kmean() const { return (float*)(ws + WS_SMALL + SM_KMEAN); }
    DI float* retkv() const { return (float*)((unsigned char*)out + DO_RETKV); }
    DI float* s5e() const { return (float*)((unsigned char*)out + DO_S5E); }
    DI float* yg() const { return (float*)((unsigned char*)out + DO_YG); }
    DI float* V1() const { return out; }
};
DI Ptrs get_ptrs(const Frame& F) { const Args* a = F.ka; asm volatile("" : "+s"(a)); Ptrs P; P.a = a; P.ws = a->ws; P.out = a->out; return P; }

DI void transpose_item(const float* W, int K, int N, bf16* WT, int dst_row0, LAS float* scr, int k0, int n0, int lane) {
#pragma unroll 8
    for (int i = 0; i < 32; ++i) { const int kk = 2 * i + (lane >> 5); scr[kk * 33 + (lane & 31)] = W[(size_t)(k0 + kk) * N + n0 + (lane & 31)]; }
    asm volatile("s_waitcnt lgkmcnt(0)" ::: "memory");
    const int c = lane & 7;
#pragma unroll
    for (int j = 0; j < 4; ++j) { const int n = (lane >> 3) + 8 * j; const LAS float* s = scr + (8 * c) * 33 + n;
        u32x4 o; o.x = pk2(s[0 * 33], s[1 * 33]); o.y = pk2(s[2 * 33], s[3 * 33]); o.z = pk2(s[4 * 33], s[5 * 33]); o.w = pk2(s[6 * 33], s[7 * 33]);
        *(u32x4*)(WT + (size_t)(dst_row0 + n) * K + k0 + 8 * c) = o; }
    asm volatile("s_waitcnt lgkmcnt(0)" ::: "memory");
}
DI void ph_prologue(Frame& F) {
    const Ptrs Q = get_ptrs(F);
    LAS float* scr = (LAS float*)(F.lds + F.wave * 16384);
    const int gw = F.wg * NWAVES + F.wave, NGW = F.G * NWAVES;
    constexpr int I_IN = 16 * 92;
    constexpr int I_OUT = 16 * 32;
    constexpr int I_G = 16 * 16;
    constexpr int I_D = 8 * 32;
    constexpr int N_IN = 2 * I_IN, N_OUT = 2 * I_OUT, N_G = 2 * 16 * I_G, N_D = 2 * 16 * I_D;
    constexpr int NITEMS = N_IN + N_OUT + 2 * N_G + N_D;
    for (int it = gw; it < NITEMS; it += NGW) {
        int r = it;
        if (r < N_IN) { const int l = r / I_IN, q = r % I_IN, kb = q / 92, nb = q % 92;
            transpose_item(Q.in(1) + (size_t)l * DM * DIN, DM, DIN, Q.Win_t() + (size_t)l * DINP * DM, 32 * nb, scr, 64 * kb, 32 * nb, F.lane); continue; }
        r -= N_IN;
        if (r < N_OUT) { const int l = r / I_OUT, q = r % I_OUT, kb = q / 32, nb = q % 32;
            transpose_item(Q.in(2) + (size_t)l * DM * DM, DM, DM, Q.Wout_t() + (size_t)l * DM * DM, 32 * nb, scr, 64 * kb, 32 * nb, F.lane); continue; }
        r -= N_OUT;
        if (r < 2 * N_G) { const int s = r / N_G; const int rr = r % N_G; const int le = rr / I_G, q = rr % I_G, kb = q / 16, nb = q % 16; const int n0 = 32 * nb;
            const float* W = (s ? Q.in(20) : Q.in(19)) + (size_t)le * DM * DFF;
            transpose_item(W, DM, DFF, Q.Wgu_t() + (size_t)le * 1024 * 1024, 256 * (n0 >> 7) + 128 * s + (n0 & 127), scr, 64 * kb, n0, F.lane); continue; }
        r -= 2 * N_G;
        { const int le = r / I_D, q = r % I_D, kb = q / 32, nb = q % 32;
            transpose_item(Q.in(21) + (size_t)le * DFF * DM, DFF, DM, Q.Wd_t() + (size_t)le * 1024 * DFF, 32 * nb, scr, 64 * kb, 32 * nb, F.lane); }
    }
    const int gt = F.wg * NTHR + F.tid, NGT = F.G * NTHR;
    for (int i = gt; i < 2 * 128 * DM / 8; i += NGT) { const int l = i / (128 * DM / 8), q = i % (128 * DM / 8);
        *(u32x4*)(Q.Win_t() + (size_t)l * DINP * DM + (size_t)DIN * DM + (size_t)q * 8) = (u32x4){0u, 0u, 0u, 0u}; }
    for (int i = gt; i < TOK * DM / 8; i += NGT) { const f32x4 a = *(const f32x4*)(Q.in(0) + (size_t)i * 8), b = *(const f32x4*)(Q.in(0) + (size_t)i * 8 + 4);
        u32x4 o; o.x = pk2(a[0], a[1]); o.y = pk2(a[2], a[3]); o.z = pk2(b[0], b[1]); o.w = pk2(b[2], b[3]); *(u32x4*)(Q.XB() + (size_t)i * 8) = o; }
    for (int i = gt; i < 2 * 1024; i += NGT) { const int l = i >> 10, gn = i & 1023, g = gn >> 6;
        float* P = Q.small() + (size_t)l * SSMP_FLOATS;
        const float lr = fminf(Q.in(3)[l * 1024 + gn], -1e-4f), li = Q.in(4)[l * 1024 + gn], dt = expf(Q.in(5)[l * 16 + g]);
        float sn_, cs_; sincos_acc(li * dt, sn_, cs_);
        const float mag = expf(lr * dt), ar = mag * cs_, ai = mag * sn_;
        const float den = lr * lr + li * li, zr = ar - 1.0f, zi = ai;
        const float fr = (zr * lr + zi * li) / den, fi = (zi * lr - zr * li) / den;
        P[gn * 2] = ar; P[gn * 2 + 1] = ai;
        float pr = ar, pi = ai;
#pragma unroll
        for (int s = 0; s < 7; ++s) { const float nr = pr * pr - pi * pi, ni = 2.0f * pr * pi; pr = nr; pi = ni; }
        P[2048 + gn * 2] = pr; P[2048 + gn * 2 + 1] = pi;
        for (int c = 0; c < 16; ++c) { const float br = Q.in(6)[(size_t)l * 16384 + gn * 16 + c], bi = Q.in(7)[(size_t)l * 16384 + gn * 16 + c];
            P[4096 + (gn * 16 + c) * 2] = fr * br - fi * bi; P[4096 + (gn * 16 + c) * 2 + 1] = fr * bi + fi * br; } }
}

DI void ph_kmean(Frame& F) {
    const Ptrs Q = get_ptrs(F);
    LAS float* red = (LAS float*)F.lds;
    for (int it = F.wg; it < BATCH * NH * NKB; it += F.G) {
        const int b = it / (NH * NKB), h = (it / NKB) % NH, n = it % NKB;
        const bf16* p = Q.PROJ() + (size_t)(b * SEQ + n * KBLK + F.wave * 32) * DINP + C_KA + h * HD + F.lane;
        float s = 0.f;
        for (int r = 0; r < 32; ++r) s += bf2f(p[(size_t)r * DINP]);
        red[F.wave * 64 + F.lane] = s;
        __syncthreads();
        if (F.tid < 64) { float t = 0.f; for (int w = 0; w < 8; ++w) t += red[w * 64 + F.tid]; Q.kmean()[(size_t)((b * NH + h) * NKB + n) * HD + F.tid] = t * (1.0f / 256.0f); }
        __syncthreads();
    }
}
template <int MODE> DI void load_tile128(Frame& F, const bf16* src, LAS float* dst, float log2g) {
    const int row = F.tid >> 2, c0 = (F.tid & 3) * 16;
    const u32x4 a = *(const u32x4*)(src + (size_t)row * DINP + c0), b = *(const u32x4*)(src + (size_t)row * DINP + c0 + 8);
    float v[16]; unpack8(a, v); unpack8(b, v + 8);
    float sc = 1.0f; if (MODE == 1) sc = 0.125f; if (MODE == 2) sc = 0.125f * exp2f(log2g * (float)(127 - row));
#pragma unroll
    for (int k = 0; k < 16; k += 4) *(LAS f32x4*)(dst + row * 64 + c0 + k) = (f32x4){v[k] * sc, v[k + 1] * sc, v[k + 2] * sc, v[k + 3] * sc};
}
DI void ph_ret_kv(Frame& F) {
    const Ptrs Q = get_ptrs(F);
    LAS float* Ks = (LAS float*)F.lds; LAS float* Vs = Ks + 8192;
    for (int it = F.wg; it < BATCH * 128 * NH; it += F.G) {
        const int b = it / (128 * NH), c = (it / NH) % 128, h = it % NH;
        const float lg = ret_log2g(h);
        const bf16* base = Q.PROJ() + (size_t)(b * SEQ + c * 128) * DINP + h * HD;
        load_tile128<2>(F, base + C_KR, Ks, lg); load_tile128<0>(F, base + C_VR, Vs, lg);
        __syncthreads();
        float* o = Q.retkv() + (size_t)((b * 128 + c) * NH + h) * 4096;
        for (int i = 0; i < 8; ++i) { const int idx = F.tid + 512 * i, dk = idx >> 6, dv = idx & 63; float acc = 0.f;
            for (int j = 0; j < 128; ++j) acc += Ks[j * 64 + dk] * Vs[j * 64 + dv];
            o[idx] = acc; }
        __syncthreads();
    }
}
DI void ph_scans(Frame& F, int l) {
    const Ptrs Q = get_ptrs(F);
    const int gt = F.wg * NTHR + F.tid, NGT = F.G * NTHR;
    for (int i = gt; i < BATCH * NH * 4096; i += NGT) { const int e = i & 4095, h = (i >> 12) % NH, b = i / (NH * 4096);
        const float d128 = exp2f(ret_log2g(h) * 128.0f); float st = 0.f;
        float* p = Q.retkv() + (size_t)(b * 128 * NH + h) * 4096 + e;
        for (int c = 0; c < 128; ++c) { const float t = p[(size_t)c * NH * 4096]; p[(size_t)c * NH * 4096] = st; st = st * d128 + t; } }
    const float* P = Q.small() + (size_t)l * SSMP_FLOATS;
    for (int i = gt; i < BATCH * 16 * 64; i += NGT) { const int n = i & 63, g = (i >> 6) & 15, b = i >> 10;
        const float ar = P[2048 + (g * 64 + n) * 2], ai = P[2048 + (g * 64 + n) * 2 + 1]; float sr = 0.f, si = 0.f;
        float* p = Q.s5e() + ((size_t)((b * 16 + g) * 128) * 64 + n) * 2;
        for (int c = 0; c < 128; ++c) { const float tr = p[(size_t)c * 128], ti = p[(size_t)c * 128 + 1]; p[(size_t)c * 128] = sr; p[(size_t)c * 128 + 1] = si;
            const float nr = ar * sr - ai * si + tr, ni = ar * si + ai * sr + ti; sr = nr; si = ni; } }
}
DI void ph_ret_out(Frame& F) {
    const Ptrs Q = get_ptrs(F);
    LAS float* Ks = (LAS float*)F.lds; LAS float* Vs = Ks + 8192; LAS float* Ps = Vs + 8192;
    const int i = F.tid >> 2, dq = F.tid & 3;
    for (int it = F.wg; it < BATCH * 128 * NH; it += F.G) {
        const int b = it / (128 * NH), c = (it / NH) % 128, h = it % NH;
        const float lg = ret_log2g(h);
        const size_t row0 = (size_t)(b * SEQ + c * 128);
        const bf16* base = Q.PROJ() + row0 * DINP + h * HD;
        load_tile128<1>(F, base + C_KR, Ks, lg); load_tile128<0>(F, base + C_VR, Vs, lg);
        const float* pv = Q.retkv() + (size_t)((b * 128 + c) * NH + h) * 4096;
        for (int k = 0; k < 8; ++k) Ps[F.tid + 512 * k] = pv[F.tid + 512 * k];
        float q[64];
        { const bf16* qp = base + (size_t)i * DINP + C_QR;
#pragma unroll
          for (int k = 0; k < 8; ++k) { const u32x4 a = *(const u32x4*)(qp + 8 * k); unpack8(a, q + 8 * k); } }
        __syncthreads();
        float acc[16];
#pragma unroll
        for (int e = 0; e < 16; ++e) acc[e] = 0.f;
        for (int j = 0; j <= i; ++j) {
            float s = 0.f;
#pragma unroll
            for (int d = 0; d < 64; d += 4) { const f32x4 kk = *(const LAS f32x4*)(Ks + j * 64 + d); s += q[d] * kk[0] + q[d + 1] * kk[1] + q[d + 2] * kk[2] + q[d + 3] * kk[3]; }
            s *= exp2f(lg * (float)(i - j));
#pragma unroll
            for (int e = 0; e < 16; e += 4) { const f32x4 vv = *(const LAS f32x4*)(Vs + j * 64 + dq * 16 + e); acc[e] += s * vv[0]; acc[e + 1] += s * vv[1]; acc[e + 2] += s * vv[2]; acc[e + 3] += s * vv[3]; }
        }
        const float xi = exp2f(lg * (float)(i + 1));
#pragma unroll
        for (int dk = 0; dk < 64; ++dk) { const float qd = q[dk] * xi;
#pragma unroll
            for (int e = 0; e < 16; e += 4) { const f32x4 pp = *(const LAS f32x4*)(Ps + dk * 64 + dq * 16 + e); acc[e] += qd * pp[0]; acc[e + 1] += qd * pp[1]; acc[e + 2] += qd * pp[2]; acc[e + 3] += qd * pp[3]; } }
        float s1 = 0.f;
#pragma unroll
        for (int e = 0; e < 16; ++e) s1 += acc[e];
        s1 += __shfl_xor(s1, 1); s1 += __shfl_xor(s1, 2);
        const float mean = s1 * (1.0f / 64.0f); float s2 = 0.f;
#pragma unroll
        for (int e = 0; e < 16; ++e) { acc[e] -= mean; s2 += acc[e] * acc[e]; }
        s2 += __shfl_xor(s2, 1); s2 += __shfl_xor(s2, 2);
        const float rstd = 1.0f / sqrtf(s2 * (1.0f / 64.0f) + GN_EPS);
        const bf16* gp = base + (size_t)i * DINP + C_GR + dq * 16;
        float gv[16]; { const u32x4 a = *(const u32x4*)gp, bb = *(const u32x4*)(gp + 8); unpack8(a, gv); unpack8(bb, gv + 8); }
        float ov[16];
#pragma unroll
        for (int e = 0; e < 16; ++e) { const float g = gv[e]; ov[e] = acc[e] * rstd * (g / (1.0f + expf(-g))); }
        bf16* op = Q.YMIX() + (row0 + i) * DM + 384 + h * HD + dq * 16;
        *(u32x4*)op = (u32x4){pk2(ov[0], ov[1]), pk2(ov[2], ov[3]), pk2(ov[4], ov[5]), pk2(ov[6], ov[7])};
        *(u32x4*)(op + 8) = (u32x4){pk2(ov[8], ov[9]), pk2(ov[10], ov[11]), pk2(ov[12], ov[13]), pk2(ov[14], ov[15])};
        __syncthreads();
    }
}
DI void s5_load_u(const bf16* up, float* u) { const u32x4 a = *(const u32x4*)up, b = *(const u32x4*)(up + 8); unpack8(a, u); unpack8(b, u + 8); }
DI void ph_s5_local(Frame& F, int l) {
    const Ptrs Q = get_ptrs(F);
    const float* P = Q.small() + (size_t)l * SSMP_FLOATS;
    for (int it = F.wg * NWAVES + F.wave; it < BATCH * 16 * 128; it += F.G * NWAVES) {
        const int ch = it & 127, g = (it >> 7) & 15, b = it >> 11; const int n = F.lane;
        const float ar = P[(g * 64 + n) * 2], ai = P[(g * 64 + n) * 2 + 1];
        float bbr[16], bbi[16];
#pragma unroll
        for (int c = 0; c < 16; ++c) { bbr[c] = P[4096 + ((g * 64 + n) * 16 + c) * 2]; bbi[c] = P[4096 + ((g * 64 + n) * 16 + c) * 2 + 1]; }
        float hr = 0.f, hi = 0.f;
        const bf16* up = Q.PROJ() + (size_t)(b * SEQ + ch * 128) * DINP + C_US + g * 16;
        for (int s = 0; s < 128; ++s) { float u[16]; s5_load_u(up + (size_t)s * DINP, u); float xr = 0.f, xi = 0.f;
#pragma unroll
            for (int c = 0; c < 16; ++c) { xr += bbr[c] * u[c]; xi += bbi[c] * u[c]; }
            const float nr = ar * hr - ai * hi + xr, ni = ar * hi + ai * hr + xi; hr = nr; hi = ni; }
        float* e = Q.s5e() + ((size_t)((b * 16 + g) * 128 + ch) * 64 + n) * 2; e[0] = hr; e[1] = hi;
    }
}
DI float gelu_tanh(float v) { const float z = 0.7978845608028654f * (v + 0.044715f * v * v * v); const float t = 1.0f - 2.0f / (expf(2.0f * z) + 1.0f); return 0.5f * v * (1.0f + t); }
DI void ph_s5_out(Frame& F, int l) {
    const Ptrs Q = get_ptrs(F);
    const float* P = Q.small() + (size_t)l * SSMP_FLOATS;
    LAS float* Cre = (LAS float*)F.lds; LAS float* Cim = Cre + 16 * 65;
    LAS float* hre = Cim + 16 * 65 + F.wave * (2 * 16 * 65); LAS float* him = hre + 16 * 65;
    const float* cre_g = Q.in(8) + (size_t)l * 16384; const float* cim_g = Q.in(9) + (size_t)l * 16384; const float* dsk = Q.in(10) + (size_t)l * 256;
    for (int it = F.wg; it < BATCH * 16 * 16; it += F.G) {
        const int cgp = it & 15, g = (it >> 4) & 15, b = it >> 8; const int ch = cgp * 8 + F.wave; const int n = F.lane;
        for (int idx = F.tid; idx < 1024; idx += NTHR) { const int c = idx >> 6, nn = idx & 63; Cre[c * 65 + nn] = cre_g[(g * 16 + c) * 64 + nn]; Cim[c * 65 + nn] = cim_g[(g * 16 + c) * 64 + nn]; }
        __syncthreads();
        const float ar = P[(g * 64 + n) * 2], ai = P[(g * 64 + n) * 2 + 1];
        float bbr[16], bbi[16];
#pragma unroll
        for (int c = 0; c < 16; ++c) { bbr[c] = P[4096 + ((g * 64 + n) * 16 + c) * 2]; bbi[c] = P[4096 + ((g * 64 + n) * 16 + c) * 2 + 1]; }
        const float* e = Q.s5e() + ((size_t)((b * 16 + g) * 128 + ch) * 64 + n) * 2;
        float hr = e[0], hi = e[1];
        const size_t row0 = (size_t)(b * SEQ + ch * 128);
        const bf16* up = Q.PROJ() + row0 * DINP + C_US + g * 16;
        const int tl = F.lane >> 2, cq = F.lane & 3;
        for (int blk = 0; blk < 8; ++blk) {
            for (int s = 0; s < 16; ++s) { float u[16]; s5_load_u(up + (size_t)(blk * 16 + s) * DINP, u); float xr = 0.f, xi = 0.f;
#pragma unroll
                for (int c = 0; c < 16; ++c) { xr += bbr[c] * u[c]; xi += bbi[c] * u[c]; }
                const float nr = ar * hr - ai * hi + xr, ni = ar * hi + ai * hr + xi; hr = nr; hi = ni;
                hre[s * 65 + n] = hr; him[s * 65 + n] = hi; }
            __builtin_amdgcn_wave_barrier();
            float y[4] = {0.f, 0.f, 0.f, 0.f};
            for (int n2 = 0; n2 < 64; ++n2) { const float a = hre[tl * 65 + n2], bq = him[tl * 65 + n2];
#pragma unroll
                for (int k = 0; k < 4; ++k) y[k] += a * Cre[(4 * cq + k) * 65 + n2] - bq * Cim[(4 * cq + k) * 65 + n2]; }
            __builtin_amdgcn_wave_barrier();
            const size_t t = row0 + blk * 16 + tl;
            const u32x2 uu = *(const u32x2*)(Q.PROJ() + t * DINP + C_US + g * 16 + 4 * cq);
            const float u0 = __uint_as_float(uu.x << 16), u1 = __uint_as_float(uu.x & 0xffff0000u), u2 = __uint_as_float(uu.y << 16), u3 = __uint_as_float(uu.y & 0xffff0000u);
            f32x4 o; o[0] = gelu_tanh(y[0] + dsk[g * 16 + 4 * cq] * u0); o[1] = gelu_tanh(y[1] + dsk[g * 16 + 4 * cq + 1] * u1);
            o[2] = gelu_tanh(y[2] + dsk[g * 16 + 4 * cq + 2] * u2); o[3] = gelu_tanh(y[3] + dsk[g * 16 + 4 * cq + 3] * u3);
            *(f32x4*)(Q.yg() + t * 256 + g * 16 + 4 * cq) = o;
        }
        __syncthreads();
    }
}
DI void ph_s5_glu(Frame& F, int l) {
    const Ptrs Q = get_ptrs(F);
    LAS float* ys = (LAS float*)F.lds;
    const float* W = Q.in(11) + (size_t)l * 65536; const float* bg = Q.in(12) + (size_t)l * 256;
    const int j = F.tid & 255, half = F.tid >> 8;
    for (int it = F.wg; it < TOK / 64; it += F.G) {
        const float* src = Q.yg() + (size_t)it * 64 * 256;
        for (int k = 0; k < 8; ++k) { const int idx = (F.tid + 512 * k) * 4; *(LAS f32x4*)(ys + idx) = *(const f32x4*)(src + idx); }
        __syncthreads();
        float acc[32];
        const float b0 = bg[j];
#pragma unroll
        for (int tk = 0; tk < 32; ++tk) acc[tk] = b0;
        for (int i = 0; i < 256; i += 4) { const float w0 = W[(i) * 256 + j], w1 = W[(i + 1) * 256 + j], w2 = W[(i + 2) * 256 + j], w3 = W[(i + 3) * 256 + j];
#pragma unroll
            for (int tk = 0; tk < 32; ++tk) { const f32x4 yv = *(const LAS f32x4*)(ys + (half * 32 + tk) * 256 + i); acc[tk] += yv[0] * w0 + yv[1] * w1 + yv[2] * w2 + yv[3] * w3; } }
#pragma unroll
        for (int tk = 0; tk < 32; ++tk) { const float yv = ys[(half * 32 + tk) * 256 + j]; const float o = yv / (1.0f + expf(-acc[tk]));
            Q.YMIX()[((size_t)it * 64 + half * 32 + tk) * DM + 768 + j] = (bf16)f2bf(o); }
        __syncthreads();
    }
}
DI void ph_moba_simple(Frame& F) {
    const Ptrs Q = get_ptrs(F);
    LAS float* km = (LAS float*)F.lds;
    for (int it = F.wg; it < BATCH * NH * 32; it += F.G) {
        const int qc = it & 31, h = (it >> 5) % NH, b = it / (NH * 32);
        const float* kmg = Q.kmean() + (size_t)(b * NH + h) * 4096;
        for (int k = 0; k < 8; ++k) km[F.tid + 512 * k] = kmg[F.tid + 512 * k];
        __syncthreads();
        const int t = qc * 512 + F.tid; const int own = t >> 8; const size_t row = (size_t)b * SEQ + t;
        float q[64];
        { const bf16* qp = Q.PROJ() + row * DINP + C_QA + h * HD;
#pragma unroll
          for (int k = 0; k < 8; ++k) { const u32x4 a = *(const u32x4*)(qp + 8 * k); unpack8(a, q + 8 * k); } }
        float v0 = -INFINITY, v1 = -INFINITY, v2 = -INFINITY; int i0 = 0, i1 = 0, i2 = 0;
        for (int n = 0; n < own; ++n) { float g = 0.f;
#pragma unroll
            for (int d = 0; d < 64; d += 4) { const f32x4 kk = *(const LAS f32x4*)(km + n * 64 + d); g += q[d] * kk[0] + q[d + 1] * kk[1] + q[d + 2] * kk[2] + q[d + 3] * kk[3]; }
            if (g > v0) { v2 = v1; i2 = i1; v1 = v0; i1 = i0; v0 = g; i0 = n; } else if (g > v1) { v2 = v1; i2 = i1; v1 = g; i1 = n; } else if (g > v2) { v2 = g; i2 = n; } }
        const int nsel = own < 3 ? own : 3;
        const float slope = alibi_slope(h);
        float m = -INFINITY, lsum = 0.f; float o[64];
#pragma unroll
        for (int d = 0; d < 64; ++d) o[d] = 0.f;
        for (int p = 0; p < 4; ++p) {
            if (p < 3 && p >= nsel) continue;
            const int blk = p == 0 ? i0 : p == 1 ? i1 : p == 2 ? i2 : own;
            const int kend = p == 3 ? (t & 255) : 255;
            const bf16* kp = Q.PROJ() + ((size_t)b * SEQ + (size_t)blk * 256) * DINP + h * HD;
            for (int s = 0; s <= kend; ++s) {
                float kv[64];
#pragma unroll
                for (int k = 0; k < 8; ++k) { const u32x4 a = *(const u32x4*)(kp + (size_t)s * DINP + C_KA + 8 * k); unpack8(a, kv + 8 * k); }
                float dot = 0.f;
#pragma unroll
                for (int d = 0; d < 64; ++d) dot += q[d] * kv[d];
                const float sc = dot * 0.125f - slope * (float)(t - (blk * 256 + s));
                if (sc > m) { const float corr = expf(m - sc); lsum *= corr;
#pragma unroll
                    for (int d = 0; d < 64; ++d) o[d] *= corr;
                    m = sc; }
                const float pw = expf(sc - m); lsum += pw;
#pragma unroll
                for (int k = 0; k < 8; ++k) { const u32x4 a = *(const u32x4*)(kp + (size_t)s * DINP + C_VA + 8 * k); unpack8(a, kv + 8 * k); }
#pragma unroll
                for (int d = 0; d < 64; ++d) o[d] += pw * kv[d];
            }
        }
        const float inv = 1.0f / lsum;
        bf16* op = Q.YMIX() + row * DM + h * HD;
#pragma unroll
        for (int k = 0; k < 8; ++k) *(u32x4*)(op + 8 * k) = (u32x4){pk2(o[8 * k] * inv, o[8 * k + 1] * inv), pk2(o[8 * k + 2] * inv, o[8 * k + 3] * inv), pk2(o[8 * k + 4] * inv, o[8 * k + 5] * inv), pk2(o[8 * k + 6] * inv, o[8 * k + 7] * inv)};
        __syncthreads();
    }
}
DI void ph_ln1_router(Frame& F, int l) {
    const Ptrs Q = get_ptrs(F);
    LAS float* rwT = (LAS float*)F.lds;
    for (int idx = F.tid; idx < 16384; idx += NTHR) { const int d = idx >> 4, e = idx & 15; rwT[e * 1024 + d] = Q.in(17)[idx]; }
    __syncthreads();
    const float* gam = Q.in(13) + l * DM; const float* bet = Q.in(14) + l * DM; const float* rb = Q.in(18);
    unsigned* ecnt = Q.ctl() + CW_ECNT + 64 * l;
    for (int r = F.wg * NWAVES + F.wave; r < TOK; r += F.G * NWAVES) {
        f32x4 v[4]; float s = 0.f;
#pragma unroll
        for (int j = 0; j < 4; ++j) { v[j] = *(const f32x4*)(Q.V1() + (size_t)r * DM + j * 256 + F.lane * 4); s += (v[j][0] + v[j][1]) + (v[j][2] + v[j][3]); }
        const float mean = wave_sum(s) * (1.0f / DM); float s2 = 0.f;
#pragma unroll
        for (int j = 0; j < 4; ++j) { v[j] = v[j] - mean; s2 += (v[j][0] * v[j][0] + v[j][1] * v[j][1]) + (v[j][2] * v[j][2] + v[j][3] * v[j][3]); }
        const float rstd = 1.0f / sqrtf(wave_sum(s2) * (1.0f / DM) + LN_EPS);
        float lg[16];
#pragma unroll
        for (int e = 0; e < 16; ++e) lg[e] = 0.f;
#pragma unroll
        for (int j = 0; j < 4; ++j) { const int d0 = j * 256 + F.lane * 4; const f32x4 gg = *(const f32x4*)(gam + d0), bb = *(const f32x4*)(bet + d0);
            v[j] = v[j] * rstd * gg + bb;
            *(u32x2*)(Q.X1B() + (size_t)r * DM + d0) = (u32x2){pk2(v[j][0], v[j][1]), pk2(v[j][2], v[j][3])}; }
#pragma unroll
        for (int e = 0; e < 16; ++e) { float a_ = 0.f;
#pragma unroll
            for (int j = 0; j < 4; ++j) { const f32x4 w = *(const LAS f32x4*)(rwT + e * 1024 + j * 256 + F.lane * 4); a_ += v[j][0] * w[0] + v[j][1] * w[1] + v[j][2] * w[2] + v[j][3] * w[3]; }
            lg[e] = a_; asm volatile("" ::: "memory"); }
        float aff[16], sel[16];
#pragma unroll
        for (int e = 0; e < 16; ++e) { const float z = wave_sum(lg[e]); aff[e] = 1.0f / (1.0f + expf(-z)); sel[e] = aff[e] + rb[e]; }
        float gs[4];
#pragma unroll
        for (int g = 0; g < 4; ++g) { const float a = sel[4 * g], bq = sel[4 * g + 1], c = sel[4 * g + 2], d = sel[4 * g + 3];
            gs[g] = fmaxf(fmaxf(fmaxf(a + bq, a + c), fmaxf(a + d, bq + c)), fmaxf(bq + d, c + d)); }
        int gb = 0; float gbv = gs[0];
#pragma unroll
        for (int g = 1; g < 4; ++g) if (gs[g] > gbv) { gbv = gs[g]; gb = g; }
        float s4[4], a4[4];
#pragma unroll
        for (int k = 0; k < 4; ++k) { s4[k] = gb == 0 ? sel[k] : gb == 1 ? sel[4 + k] : gb == 2 ? sel[8 + k] : sel[12 + k]; a4[k] = gb == 0 ? aff[k] : gb == 1 ? aff[4 + k] : gb == 2 ? aff[8 + k] : aff[12 + k]; }
        int f0 = 0; float fv = s4[0], fa = a4[0];
#pragma unroll
        for (int k = 1; k < 4; ++k) if (s4[k] > fv) { fv = s4[k]; f0 = k; fa = a4[k]; }
        int f1 = -1; float sv = -INFINITY, sa = 0.f;
#pragma unroll
        for (int k = 0; k < 4; ++k) if (k != f0 && s4[k] > sv) { sv = s4[k]; f1 = k; sa = a4[k]; }
        const float wsum = fa + sa;
        if (F.lane == 0) {
            const int e0 = gb * 4 + f0, e1 = gb * 4 + f1;
            const unsigned p0 = atomicAdd(&ecnt[e0], 1u); Q.ltok()[(size_t)e0 * LCAP + p0] = (unsigned)r; Q.lw()[(size_t)e0 * LCAP + p0] = fa / wsum;
            const unsigned p1 = atomicAdd(&ecnt[e1], 1u); Q.ltok()[(size_t)e1 * LCAP + p1] = (unsigned)r | 0x80000000u; Q.lw()[(size_t)e1 * LCAP + p1] = sa / wsum;
        }
    }
}
DI void moe_build_tab(Frame& F, int l) {
    const Ptrs Q = get_ptrs(F);
    LAS int* tab = (LAS int*)(F.lds + MOE_TAB_OFF);
    __syncthreads();
    if (F.tid == 0) {
        const unsigned* ecnt = Q.ctl() + CW_ECNT + 64 * l; int pb = 0;
        for (int e = 0; e < 16; ++e) { const int c = (int)__hip_atomic_load(ecnt + e, __ATOMIC_RELAXED, __HIP_MEMORY_SCOPE_AGENT); tab[e] = c; tab[16 + e] = pb; const int nb = (c + 255) >> 8;
            for (int j = 0; j < nb; ++j) tab[64 + pb + j] = e;
            pb += nb; }
        tab[32] = pb;
    }
    __syncthreads();
}
DI void ph_ln2(Frame& F, int l) {
    const Ptrs Q = get_ptrs(F);
    const float* gam = Q.in(15) + l * DM; const float* bet = Q.in(16) + l * DM;
    for (int r = F.wg * NWAVES + F.wave; r < TOK; r += F.G * NWAVES) {
        float v[16]; float s = 0.f;
#pragma unroll
        for (int j = 0; j < 2; ++j) { const size_t off = (size_t)r * DM + j * 512 + F.lane * 8;
            float a[8], b0[8], b1[8]; unpack8(*(const u32x4*)(Q.X1B() + off), a); unpack8(*(const u32x4*)(Q.YM0() + off), b0); unpack8(*(const u32x4*)(Q.YM1() + off), b1);
#pragma unroll
            for (int k = 0; k < 8; ++k) { v[j * 8 + k] = ALPHA * a[k] + (b0[k] + b1[k]); s += v[j * 8 + k]; } }
        const float mean = wave_sum(s) * (1.0f / DM); float s2 = 0.f;
#pragma unroll
        for (int k = 0; k < 16; ++k) { v[k] -= mean; s2 += v[k] * v[k]; }
        const float rstd = 1.0f / sqrtf(wave_sum(s2) * (1.0f / DM) + LN_EPS);
#pragma unroll
        for (int j = 0; j < 2; ++j) { const int d0 = j * 512 + F.lane * 8; float o[8];
#pragma unroll
            for (int k = 0; k < 8; ++k) o[k] = v[j * 8 + k] * rstd * gam[d0 + k] + bet[d0 + k];
            if (l == DEPTH - 1) { *(f32x4*)(Q.out + (size_t)r * DM + d0) = (f32x4){o[0], o[1], o[2], o[3]}; *(f32x4*)(Q.out + (size_t)r * DM + d0 + 4) = (f32x4){o[4], o[5], o[6], o[7]}; }
            else *(u32x4*)(Q.XB() + (size_t)r * DM + d0) = (u32x4){pk2(o[0], o[1]), pk2(o[2], o[3]), pk2(o[4], o[5]), pk2(o[6], o[7])}; }
    }
}

constexpr int PH_PER_LAYER = 10, NPH = 1 + DEPTH * PH_PER_LAYER;
DI void refresh_ids(Frame& F, int wave0) {
    int w_ = wave0; asm volatile("" : "+s"(w_)); unsigned z_ = 0u; asm volatile("" : "+v"(z_));
    const int ln_ = (int)__builtin_amdgcn_mbcnt_hi(~0u, __builtin_amdgcn_mbcnt_lo(~0u, z_));
    F.wave = w_; F.lane = ln_; F.tid = w_ * 64 + ln_;
}
#if MK_ONE_LAUNCH
#define PHASE_END(k) do { if ((k) + 1 < ph_hi) xcd_barrier(bar); } while (0)
#else
#define PHASE_END(k) do { __syncthreads(); } while (0)
#endif
#define PHASE_IN(k) (ph_lo <= (k) && (k) < ph_hi)
template <int L> DI void run_layer(Frame& F, const int wave0, const int ph_lo, const int ph_hi, const XcdBarrier& bar) {
    constexpr int base = 1 + L * PH_PER_LAYER;
    const LAS int* tab = (const LAS int*)(F.lds + MOE_TAB_OFF);
    if (PHASE_IN(base + 0)) { refresh_ids(F, wave0);
        { const Ptrs Q = get_ptrs(F);
          pg8::DenseSched S; S.init(Q.XB(), Q.Win_t() + (size_t)L * DINP * DM, TOK, DINP, DM, F.G, F.wg);
          pg8::EpiBf16 E{Q.PROJ(), DINP};
          pg8::gemm_phase<pg8::EpiBf16, pg8::DenseSched, true>(F.lds, F.tid, DM, S, E); }
        PHASE_END(base + 0); }
    if (PHASE_IN(base + 1)) { refresh_ids(F, wave0); ph_kmean(F); ph_ret_kv(F); ph_s5_local(F, L); PHASE_END(base + 1); }
    if (PHASE_IN(base + 2)) { refresh_ids(F, wave0); ph_scans(F, L); PHASE_END(base + 2); }
    if (PHASE_IN(base + 3)) { refresh_ids(F, wave0); ph_moba_simple(F); refresh_ids(F, wave0); ph_ret_out(F); refresh_ids(F, wave0); ph_s5_out(F, L); PHASE_END(base + 3); }
    if (PHASE_IN(base + 4)) { refresh_ids(F, wave0); ph_s5_glu(F, L); PHASE_END(base + 4); }
    if (PHASE_IN(base + 5)) { refresh_ids(F, wave0);
        { const Ptrs Q = get_ptrs(F);
          pg8::DenseSched S; S.init(Q.YMIX(), Q.Wout_t() + (size_t)L * DM * DM, TOK, DM, DM, F.G, F.wg);
          pg8::EpiResF32 E{Q.V1(), Q.XB()};
          pg8::gemm_phase<pg8::EpiResF32, pg8::DenseSched, true>(F.lds, F.tid, DM, S, E); }
        PHASE_END(base + 5); }
    if (PHASE_IN(base + 6)) { refresh_ids(F, wave0); ph_ln1_router(F, L); PHASE_END(base + 6); }
    if (PHASE_IN(base + 7)) { refresh_ids(F, wave0);
        moe_build_tab(F, L);
        { const Ptrs Q = get_ptrs(F);
          pg8::MoeUpSched S{Q.X1B(), Q.Wgu_t() + (size_t)L * 16 * 1024 * 1024, Q.ltok(), tab, F.G, F.wg};
          pg8::EpiSwiGLU E{Q.Hb()};
          pg8::gemm_phase<pg8::EpiSwiGLU, pg8::MoeUpSched, true>(F.lds, F.tid, DM, S, E); }
        PHASE_END(base + 7); }
    if (PHASE_IN(base + 8)) { refresh_ids(F, wave0);
        moe_build_tab(F, L);
        { const Ptrs Q = get_ptrs(F);
          pg8::MoeDownSched S{Q.Hb(), Q.Wd_t() + (size_t)L * 16 * 1024 * DFF, tab, F.G, F.wg};
          pg8::EpiMoeScatter E{Q.YM0(), Q.YM1(), Q.ltok(), Q.lw(), tab};
          pg8::gemm_phase<pg8::EpiMoeScatter, pg8::MoeDownSched, true>(F.lds, F.tid, DFF, S, E); }
        PHASE_END(base + 8); }
    if (PHASE_IN(base + 9)) { refresh_ids(F, wave0); ph_ln2(F, L); PHASE_END(base + 9); }
}
__global__ void __launch_bounds__(NTHR, 2) fwd_kernel(Args args_unused) {
    extern __shared__ __attribute__((aligned(16))) unsigned char lds_raw[];
    Frame F;
    F.lds = (LAS unsigned char*)lds_raw;
    F.ka = (const Args*)__builtin_amdgcn_kernarg_segment_ptr();
    F.tid = threadIdx.x; F.lane = F.tid & 63; F.wave = __builtin_amdgcn_readfirstlane(F.tid >> 6);
    F.G = gridDim.x; F.wg = blockIdx.x;
    for (int u = F.tid; u < (LDS_BYTES - LDSCTL_OFF) / 4; u += NTHR) ((LAS unsigned*)(F.lds + LDSCTL_OFF))[u] = 0u;
    __syncthreads();
    const int ph_lo = F.ka->ph_lo, ph_hi = F.ka->ph_hi;
    const int wave0 = F.wave;
    XcdBarrier bar; bar.bar = nullptr; bar.x = 0; bar.st = nullptr;
#if MK_ONE_LAUNCH
    { const Ptrs Q = get_ptrs(F); bar = xcd_barrier_post(Q.ctl() + CW_BAR, (volatile LAS unsigned*)(F.lds + MISC_OFF) + 8); }
#endif
    if (PHASE_IN(0)) { refresh_ids(F, wave0); ph_prologue(F); PHASE_END(0); }
    run_layer<0>(F, wave0, ph_lo, ph_hi, bar);
    run_layer<1>(F, wave0, ph_lo, ph_hi, bar);
}

extern "C" void kernel_launch(void* const* d_in, const int* in_sizes, int n_in, void* d_out, int out_size, void* d_ws, size_t ws_size, hipStream_t stream) {
    static int grid = 0;
    if (grid == 0) {
        if (n_in != 22 || in_sizes[0] != TOK * DM || out_size != TOK * DM || ws_size < WS_END) {
            fprintf(stderr, "kernel_launch: unexpected shapes (n_in %d, in0 %d, out %d, ws %zu); nothing launched\n", n_in, n_in > 0 ? in_sizes[0] : -1, out_size, ws_size); grid = -1; return; }
        int dev = 0, cus = 0, per_cu = 0;
        if (hipGetDevice(&dev) != hipSuccess || hipDeviceGetAttribute(&cus, hipDeviceAttributeMultiprocessorCount, dev) != hipSuccess) { grid = -1; return; }
        if (hipFuncSetAttribute((const void*)fwd_kernel, hipFuncAttributeMaxDynamicSharedMemorySize, LDS_BYTES) != hipSuccess) { fprintf(stderr, "kernel_launch: hipFuncSetAttribute failed\n"); grid = -1; return; }
        if (hipOccupancyMaxActiveBlocksPerMultiprocessor(&per_cu, (const void*)fwd_kernel, NTHR, LDS_BYTES) != hipSuccess || per_cu < 1) { fprintf(stderr, "kernel_launch: occupancy query says %d blocks per CU\n", per_cu); (void)hipGetLastError(); grid = -1; return; }
        grid = cus;
    }
    if (grid < 0) return;
    (void)hipMemsetAsync((char*)d_ws + WS_CTL, 0, CTL_ZERO_BYTES, stream);
    Args a{};
    for (int i = 0; i < 22; ++i) a.in[i] = (const float*)d_in[i];
    a.out = (float*)d_out; a.ws = (unsigned char*)d_ws;
#if MK_ONE_LAUNCH
    a.ph_lo = 0; a.ph_hi = NPH;
    void* kargs[] = {&a};
    hipError_t e = hipLaunchCooperativeKernel((const void*)fwd_kernel, dim3(grid), dim3(NTHR), kargs, LDS_BYTES, stream);
    if (e != hipSuccess) fprintf(stderr, "cooperative launch failed: %s (grid %d)\n", hipGetErrorString(e), grid);
#else
    for (int ph = 0; ph < NPH; ++ph) { a.ph_lo = ph; a.ph_hi = ph + 1; hipLaunchKernelGGL(fwd_kernel, dim3(grid), dim3(NTHR), LDS_BYTES, stream, a); }
#endif
}
```

```cpp
#include <hip/hip_runtime.h>
#include <hip/hip_cooperative_groups.h>
#include <cstdio>
#include <cstdint>
namespace cg = cooperative_groups;

#ifndef MK_ONE_LAUNCH
#define MK_ONE_LAUNCH 1
#endif

#define DI __device__ __forceinline__
#define GAS __attribute__((address_space(1)))
#define LAS __attribute__((address_space(3)))
typedef unsigned short bf16;
typedef float f32x4 __attribute__((ext_vector_type(4)));
typedef float f32x2 __attribute__((ext_vector_type(2)));
typedef unsigned u32x4 __attribute__((ext_vector_type(4)));
typedef unsigned u32x2 __attribute__((ext_vector_type(2)));
typedef short bf16x8 __attribute__((ext_vector_type(8)));

constexpr int BATCH = 2, SEQ = 16384, DM = 1024, TOK = BATCH * SEQ, DEPTH = 2;
constexpr int DIN = 2944, DINP = 3072;
constexpr int C_QA = 0, C_KA = 384, C_VA = 768, C_QR = 1152, C_KR = 1536, C_VR = 1920, C_GR = 2304, C_US = 2688;
constexpr int NH = 6, HD = 64, NKB = 64, KBLK = 256;
constexpr int NE = 16, DFF = 512, LCAP = TOK;
constexpr int MAXBLK = 288;
constexpr float ALPHA = 1.41421356237309505f;
constexpr float LN_EPS = 1e-5f, GN_EPS = 1e-6f;
constexpr int NWAVES = 8, NTHR = 512;

constexpr size_t MiB = 1u << 20;
constexpr size_t WS_CTL = 0, CTL_ZERO_BYTES = 1 * MiB;
constexpr size_t WS_SMALL = 1 * MiB;
constexpr size_t WS_WIN = 5 * MiB;
constexpr size_t WS_WOUT = 17 * MiB;
constexpr size_t WS_WGU = 21 * MiB;
constexpr size_t WS_WD = 85 * MiB;
constexpr size_t WS_XB = 117 * MiB;
constexpr size_t WS_X1B = 181 * MiB;
constexpr size_t WS_PROJ = 245 * MiB;
constexpr size_t WS_H = WS_PROJ, WS_YM0 = WS_PROJ + 68 * MiB;
constexpr size_t WS_YMIX = 437 * MiB;
constexpr size_t WS_YM1 = WS_YMIX;
constexpr size_t WS_LTOK = 501 * MiB;
constexpr size_t WS_LW = 503 * MiB;
constexpr size_t WS_END = 505 * MiB;
constexpr int SSMP_FLOATS = 36864;
constexpr size_t SM_SSMP = 0;
constexpr size_t SM_KMEAN = 2 * SSMP_FLOATS * 4;
constexpr size_t DO_RETKV = 0;
constexpr size_t DO_S5E = 24 * MiB;
constexpr size_t DO_YG = 26 * MiB;
constexpr int CW_BAR = 4096;
constexpr int CW_ECNT = 1024;
constexpr int RING_BYTES = 131072, LDSCTL_OFF = RING_BYTES, MISC_OFF = LDSCTL_OFF + 320, MOE_TAB_OFF = LDSCTL_OFF + 1024;
constexpr int LDS_BYTES = 147456;

DI float bf2f(unsigned short v) { return __uint_as_float((unsigned)v << 16); }
DI unsigned f2bf(float f) { unsigned u = __float_as_uint(f); return (u + 0x7fffu + ((u >> 16) & 1u)) >> 16; }
DI unsigned pk2(float lo, float hi) { return f2bf(lo) | (f2bf(hi) << 16); }
DI void unpack8(const u32x4 v, float* o) {
    o[0] = __uint_as_float(v.x << 16); o[1] = __uint_as_float(v.x & 0xffff0000u); o[2] = __uint_as_float(v.y << 16); o[3] = __uint_as_float(v.y & 0xffff0000u);
    o[4] = __uint_as_float(v.z << 16); o[5] = __uint_as_float(v.z & 0xffff0000u); o[6] = __uint_as_float(v.w << 16); o[7] = __uint_as_float(v.w & 0xffff0000u);
}
DI void sincos_acc(float a, float& sn, float& cs) {
    const double ad = (double)a; const double kd = rint(ad * 0.63661977236758134308); const int k = (int)kd;
    const float r = (float)(ad - kd * 1.57079632679489661923), z = r * r;
    const float sp = r + r * z * (-1.6666667163e-01f + z * (8.3333337680e-03f + z * (-1.9841270114e-04f + z * (2.7557314297e-06f + z * (-2.5050759689e-08f)))));
    const float cp = 1.0f - 0.5f * z + z * z * (4.1666667908e-02f + z * (-1.3888889225e-03f + z * (2.4801587642e-05f + z * (-2.7557314297e-07f + z * (2.0875723372e-09f)))));
    const int q = k & 3;
    sn = q == 0 ? sp : q == 1 ? cp : q == 2 ? -sp : -cp;
    cs = q == 0 ? cp : q == 1 ? -sp : q == 2 ? -cp : sp;
}
DI float wave_sum(float v) {
#pragma unroll
    for (int o = 1; o < 64; o <<= 1) v += __shfl_xor(v, o);
    return v;
}
DI float ret_log2g(int h) {
    return h == 0 ? -0.04580368961312479f : h == 1 ? -0.02272007650008353f : h == 2 ? -0.011315313227834146f : h == 3 ? -0.005646563141142063f : h == 4 ? -0.0028205190623786626f : -0.0014095702546713536f;
}
DI float alibi_slope(int h) {
    return h == 0 ? 0.3968502629920499f : h == 1 ? 0.15749013123685915f : h == 2 ? 0.0625f : h == 3 ? 0.024803141437003122f : h == 4 ? 0.009843133202303695f : 0.00390625f;
}

namespace pg8 {
#define PG8_LAS __attribute__((address_space(3)))
typedef unsigned short bf16_t;
constexpr int BM = 256, BK = 64, HALF = 128, HTB = HALF * BK * 2, STAGE_BYTES = 8 * HTB, NXCD = 8, WGM = 8;
__host__ __device__ __forceinline__ int lds_byte(int r, int c) { const int st = (r >> 4) * 2 + (c >> 5), rr = r & 15, cc = c & 31, ob = rr * 64 + cc * 2; return st * 1024 + (ob ^ (((ob >> 9) & 1) << 5)); }
__host__ __device__ __forceinline__ void stage_rc(int b, int& R, int& C) { const int st = b / 1024, sb = b % 1024, swz = sb ^ (((sb >> 9) & 1) << 5); R = (st >> 1) * 16 + swz / 64; C = (st & 1) * 32 + (swz % 64) / 2; }
__host__ __device__ __forceinline__ int perm32(int rho) { const int n = rho >> 4, i = rho & 15; return 8 * (i >> 2) + 4 * n + (i & 3); }

struct Unit { int pm, pn, e, jb; };

template <class Epi, class Sched, bool ALIGN_EPI>
__device__ __forceinline__ void gemm_phase(PG8_LAS unsigned char* lds, const int tid, const int K, const Sched& S, const Epi& E) {
    const int wid = __builtin_amdgcn_readfirstlane(tid >> 6), lane = tid & 63, wr = wid >> 2, wc = wid & 3, fr = lane & 15, fq = lane >> 4;
    const int nt = K / BK;
    unsigned voffB[2];
#pragma unroll
    for (int i = 0; i < 2; ++i) { int R, C; stage_rc(tid * 16 + i * 8192, R, C); const int Rb = Epi::PERM ? ((R & ~31) + perm32(R & 31)) : R; voffB[i] = (unsigned)(Rb * K + C) * 2u; }
    const size_t kstep = (size_t)(BK * 2);
    const size_t hstep = (size_t)HALF * K * 2;
    const unsigned ldsw = (unsigned)wid * 1024u;
    const int aoff = lds_byte(wr * 64 + fr, fq * 8), boff = lds_byte(wc * 32 + fr, fq * 8);
#define PG8_SA(b, h) (((b) * 2 + (h)) * HTB)
#define PG8_SB(b, h) ((4 + (b) * 2 + (h)) * HTB)
#define PG8_STAGE(bufoff, gbase, voff) do { _Pragma("unroll") for (int _i = 0; _i < 2; ++_i) \
        __builtin_amdgcn_global_load_lds((const unsigned*)((const char*)(gbase) + (voff)[_i]), (PG8_LAS unsigned*)(lds + (bufoff) + ldsw + _i * 8192), 16, 0, 0); } while (0)
#define PG8_LDA(dst, b, h) do { _Pragma("unroll") for (int m = 0; m < 4; ++m) _Pragma("unroll") for (int k = 0; k < 2; ++k) dst[m][k] = *(const PG8_LAS bf16x8*)(lds + PG8_SA(b, h) + aoff + m * 2048 + k * 1024); } while (0)
#define PG8_LDB(dst, b, h) do { _Pragma("unroll") for (int n = 0; n < 2; ++n) _Pragma("unroll") for (int k = 0; k < 2; ++k) dst[n][k] = *(const PG8_LAS bf16x8*)(lds + PG8_SB(b, h) + boff + n * 2048 + k * 1024); } while (0)
#define PG8_MMA(ai, bj, At, Bt) do { __builtin_amdgcn_s_setprio(1); _Pragma("unroll") for (int m = 0; m < 4; ++m) _Pragma("unroll") for (int n = 0; n < 2; ++n) _Pragma("unroll") for (int k = 0; k < 2; ++k) \
        acc[ai][bj][m][n] = __builtin_amdgcn_mfma_f32_16x16x32_bf16(Bt[n][k], At[m][k], acc[ai][bj][m][n], 0, 0, 0); __builtin_amdgcn_s_setprio(0); } while (0)
#define PG8_WAIT_V(n) asm volatile("s_waitcnt vmcnt(" #n ")" ::: "memory")
#define PG8_WAIT_L(n) asm volatile("s_waitcnt lgkmcnt(" #n ")" ::: "memory")
#define PG8_BAR __builtin_amdgcn_s_barrier()
#define PG8_SCHED __builtin_amdgcn_sched_barrier(0)
    Unit cur, nxt; int ui = 0;
    if (!S.next(0, cur)) return;
    f32x4 acc[2][2][4][2];
#pragma unroll
    for (int a = 0; a < 2; ++a)
#pragma unroll
        for (int b = 0; b < 2; ++b)
#pragma unroll
            for (int m = 0; m < 4; ++m)
#pragma unroll
                for (int n = 0; n < 2; ++n) acc[a][b][m][n] = (f32x4){0.f, 0.f, 0.f, 0.f};
    bf16x8 At[4][2], B0[2][2], B1[2][2];
    const char* cA; const char* cB; unsigned vA[2][2];
    S.addr(cur, tid, cA, vA, cB);
    PG8_STAGE(PG8_SB(0, 0), cB, voffB); PG8_STAGE(PG8_SB(0, 1), cB + hstep, voffB); PG8_STAGE(PG8_SA(0, 0), cA, vA[0]); PG8_STAGE(PG8_SA(0, 1), cA, vA[1]);
    if (wr == 1) PG8_BAR;
    PG8_WAIT_V(2); PG8_BAR;
    PG8_STAGE(PG8_SB(1, 0), cB + kstep, voffB); PG8_STAGE(PG8_SA(1, 0), cA + kstep, vA[0]); PG8_STAGE(PG8_SB(1, 1), cB + hstep + kstep, voffB);
    PG8_WAIT_V(6); PG8_BAR;
    for (;;) {
        const bool has_next = S.next(ui + 1, nxt);
        const char* nA = cA; const char* nB = cB; unsigned nvA[2][2] = {{vA[0][0], vA[0][1]}, {vA[1][0], vA[1][1]}};
        if (has_next) { if constexpr (Sched::A_VARIES) S.addr(nxt, tid, nA, nvA, nB); else { unsigned dummy[2][2]; S.addr(nxt, tid, nA, dummy, nB); } }
        for (int t = 0; t < nt; t += 2) {
            const bool last = (t == nt - 2);
            const char* a1 = cA + (size_t)(t + 1) * kstep;
            const char* a2 = last ? nA : cA + (size_t)(t + 2) * kstep; const char* b2 = last ? nB : cB + (size_t)(t + 2) * kstep;
            const char* a3 = a2 + kstep; const char* b3 = b2 + kstep;
            unsigned xA0[2], xA1[2];
            if constexpr (Sched::A_VARIES) { xA0[0] = last ? nvA[0][0] : vA[0][0]; xA0[1] = last ? nvA[0][1] : vA[0][1]; xA1[0] = last ? nvA[1][0] : vA[1][0]; xA1[1] = last ? nvA[1][1] : vA[1][1]; }
            else { xA0[0] = vA[0][0]; xA0[1] = vA[0][1]; xA1[0] = vA[1][0]; xA1[1] = vA[1][1]; }
            PG8_LDB(B0, 0, 0); PG8_LDB(B1, 0, 1); PG8_SCHED; PG8_LDA(At, 0, 0); PG8_STAGE(PG8_SA(1, 1), a1, vA[1]);
            PG8_WAIT_V(8); PG8_WAIT_L(0); PG8_BAR; PG8_MMA(0, 0, At, B0); PG8_MMA(0, 1, At, B1); PG8_BAR; PG8_SCHED;
            PG8_LDA(At, 0, 1); PG8_STAGE(PG8_SB(0, 0), b2, voffB); PG8_STAGE(PG8_SB(0, 1), b2 + hstep, voffB); PG8_STAGE(PG8_SA(0, 0), a2, xA0);
            PG8_WAIT_V(8); PG8_WAIT_L(0); PG8_BAR; PG8_MMA(1, 0, At, B0); PG8_MMA(1, 1, At, B1); PG8_BAR; PG8_SCHED;
            PG8_LDB(B0, 1, 0); PG8_LDB(B1, 1, 1); PG8_SCHED; PG8_LDA(At, 1, 0); PG8_STAGE(PG8_SA(0, 1), a2, xA1);
            PG8_WAIT_V(8); PG8_WAIT_L(0); PG8_BAR; PG8_MMA(0, 0, At, B0); PG8_MMA(0, 1, At, B1); PG8_BAR; PG8_SCHED;
            PG8_LDA(At, 1, 1); PG8_STAGE(PG8_SB(1, 0), b3, voffB); PG8_STAGE(PG8_SB(1, 1), b3 + hstep, voffB); PG8_STAGE(PG8_SA(1, 0), a3, xA0);
            PG8_WAIT_V(8); PG8_WAIT_L(0); PG8_BAR; PG8_MMA(1, 0, At, B0); PG8_MMA(1, 1, At, B1); PG8_BAR; PG8_SCHED;
        }
        if constexpr (ALIGN_EPI) { if (wr == 0) PG8_BAR; }
        E(acc, cur, wr, wc, fr, fq);
        if (!has_next) break;
#pragma unroll
        for (int a = 0; a < 2; ++a)
#pragma unroll
            for (int b = 0; b < 2; ++b)
#pragma unroll
                for (int m = 0; m < 4; ++m)
#pragma unroll
                    for (int n = 0; n < 2; ++n) acc[a][b][m][n] = (f32x4){0.f, 0.f, 0.f, 0.f};
        cur = nxt; cA = nA; cB = nB; if constexpr (Sched::A_VARIES) { vA[0][0] = nvA[0][0]; vA[0][1] = nvA[0][1]; vA[1][0] = nvA[1][0]; vA[1][1] = nvA[1][1]; } ++ui;
        if constexpr (ALIGN_EPI) { if (wr == 1) PG8_BAR; }
    }
    PG8_WAIT_V(0);
    if constexpr (!ALIGN_EPI) { if (wr == 0) PG8_BAR; }
    PG8_BAR;
#undef PG8_SA
#undef PG8_SB
#undef PG8_STAGE
#undef PG8_LDA
#undef PG8_LDB
#undef PG8_MMA
#undef PG8_WAIT_V
#undef PG8_WAIT_L
#undef PG8_BAR
#undef PG8_SCHED
}

struct DenseSched {
    static constexpr bool A_VARIES = false;
    const bf16_t* A; const bf16_t* Bt; int K; int nM, nN, nwg, G, c;
    __device__ void init(const bf16_t* A_, const bf16_t* Bt_, int M, int N, int K_, int G_, int c_) { A = A_; Bt = Bt_; K = K_; nM = M / BM; nN = N / BM; nwg = nM * nN; G = G_; c = c_; }
    __device__ __forceinline__ bool next(int i, Unit& u) const {
        const long L = (long)i * G + c; if (L >= nwg) return false;
        int wgid = (int)L; { const int q = nwg / NXCD, r = nwg % NXCD, xcd = wgid % NXCD, off = wgid / NXCD; wgid = (xcd < r ? xcd * (q + 1) : r * (q + 1) + (xcd - r) * q) + off; }
        const int nig = WGM * nN, gid = wgid / nig, fm = gid * WGM, gsz = (nM - fm) < WGM ? (nM - fm) : WGM;
        u.pm = __builtin_amdgcn_readfirstlane(fm + ((wgid % nig) % gsz)); u.pn = __builtin_amdgcn_readfirstlane((wgid % nig) / gsz); u.e = 0; u.jb = 0; return true;
    }
    __device__ __forceinline__ void addr(const Unit& u, int tid, const char*& a, unsigned (&vA)[2][2], const char*& b) const {
        asm volatile("" : "+v"(tid));
        a = (const char*)A + (size_t)u.pm * BM * K * 2; b = (const char*)Bt + (size_t)u.pn * BM * K * 2;
#pragma unroll
        for (int i = 0; i < 2; ++i) { int R, C; stage_rc(tid * 16 + i * 8192, R, C);
#pragma unroll
            for (int h = 0; h < 2; ++h) vA[h][i] = (unsigned)((h * HALF + R) * K + C) * 2u; }
    }
};
struct MoeUpSched {
    static constexpr bool A_VARIES = true;
    const bf16_t* X; const bf16_t* W; const unsigned* ltok; const PG8_LAS int* tab; int G, c;
    __device__ __forceinline__ bool next(int i, Unit& u) const {
        const int id = i * G + c; const int nb = __builtin_amdgcn_readfirstlane(tab[32]); if (id >= nb * 4) return false;
        const int blk = id >> 2; u.pm = blk; u.pn = id & 3; u.e = __builtin_amdgcn_readfirstlane(tab[64 + blk]); u.jb = blk - __builtin_amdgcn_readfirstlane(tab[16 + u.e]); return true;
    }
    __device__ __forceinline__ void addr(const Unit& u, int tid, const char*& a, unsigned (&vA)[2][2], const char*& b) const {
        asm volatile("" : "+v"(tid));
        a = (const char*)X; b = (const char*)W + ((size_t)u.e * 1024 + (size_t)u.pn * BM) * 1024 * 2;
        const int cnt = __builtin_amdgcn_readfirstlane(tab[u.e]); const unsigned* lt = ltok + (size_t)u.e * LCAP + u.jb * 256;
#pragma unroll
        for (int i = 0; i < 2; ++i) { int R, C; stage_rc(tid * 16 + i * 8192, R, C);
#pragma unroll
            for (int h = 0; h < 2; ++h) { const int r = h * HALF + R; const bool ok = (u.jb * 256 + r) < cnt; const unsigned tk = ok ? (lt[r] & 0x7fffffffu) : 0u; vA[h][i] = (tk * 1024u + (unsigned)C) * 2u; } }
    }
};
struct MoeDownSched {
    static constexpr bool A_VARIES = false;
    const bf16_t* Hb; const bf16_t* W; const PG8_LAS int* tab; int G, c;
    __device__ __forceinline__ bool next(int i, Unit& u) const {
        const int id = i * G + c; const int nb = __builtin_amdgcn_readfirstlane(tab[32]); if (id >= nb * 4) return false;
        const int blk = id >> 2; u.pm = blk; u.pn = id & 3; u.e = __builtin_amdgcn_readfirstlane(tab[64 + blk]); u.jb = blk - __builtin_amdgcn_readfirstlane(tab[16 + u.e]); return true;
    }
    __device__ __forceinline__ void addr(const Unit& u, int tid, const char*& a, unsigned (&vA)[2][2], const char*& b) const {
        asm volatile("" : "+v"(tid));
        a = (const char*)Hb + (size_t)u.pm * BM * DFF * 2; b = (const char*)W + ((size_t)u.e * 1024 + (size_t)u.pn * BM) * DFF * 2;
#pragma unroll
        for (int i = 0; i < 2; ++i) { int R, C; stage_rc(tid * 16 + i * 8192, R, C);
#pragma unroll
            for (int h = 0; h < 2; ++h) vA[h][i] = (unsigned)((h * HALF + R) * DFF + C) * 2u; }
    }
};

struct EpiBf16 {
    static constexpr bool PERM = true;
    bf16_t* O; int ldc;
    __device__ __forceinline__ void operator()(const f32x4 (&acc)[2][2][4][2], const Unit& u, int wr, int wc, int fr, int fq) const {
        asm volatile("" : "+v"(fr), "+v"(fq));
        const int row0 = u.pm * BM + wr * 64 + fr; const int col0 = u.pn * BM + wc * 32 + 8 * fq;
#pragma unroll
        for (int ai = 0; ai < 2; ++ai)
#pragma unroll
            for (int m = 0; m < 4; ++m) { bf16_t* rowp = O + (size_t)(row0 + ai * HALF + m * 16) * ldc + col0;
#pragma unroll
                for (int bj = 0; bj < 2; ++bj) { const f32x4 v0 = acc[ai][bj][m][0], v1 = acc[ai][bj][m][1];
                    u32x4 w; w.x = pk2(v0[0], v0[1]); w.y = pk2(v0[2], v0[3]); w.z = pk2(v1[0], v1[1]); w.w = pk2(v1[2], v1[3]);
                    *(u32x4*)(rowp + bj * HALF) = w; } }
    }
};
struct EpiResF32 {
    static constexpr bool PERM = false;
    float* V; const bf16_t* XBp;
    __device__ __forceinline__ void operator()(const f32x4 (&acc)[2][2][4][2], const Unit& u, int wr, int wc, int fr, int fq) const {
        asm volatile("" : "+v"(fr), "+v"(fq));
        const int row0 = u.pm * BM + wr * 64 + fr; const int col0 = u.pn * BM + wc * 32 + 4 * fq;
#pragma unroll
        for (int ai = 0; ai < 2; ++ai)
#pragma unroll
            for (int m = 0; m < 4; ++m) { const size_t off = (size_t)(row0 + ai * HALF + m * 16) * DM + col0;
#pragma unroll
                for (int bj = 0; bj < 2; ++bj)
#pragma unroll
                    for (int n = 0; n < 2; ++n) { const u32x2 xb = *(const u32x2*)(XBp + off + bj * HALF + n * 16); const f32x4 a = acc[ai][bj][m][n];
                        f32x4 o; o[0] = ALPHA * __uint_as_float(xb.x << 16) + a[0]; o[1] = ALPHA * __uint_as_float(xb.x & 0xffff0000u) + a[1];
                        o[2] = ALPHA * __uint_as_float(xb.y << 16) + a[2]; o[3] = ALPHA * __uint_as_float(xb.y & 0xffff0000u) + a[3];
                        *(f32x4*)(V + off + bj * HALF + n * 16) = o; } }
    }
};
__device__ __forceinline__ float silu_f(float x) { return x * __builtin_amdgcn_rcpf(1.0f + __builtin_amdgcn_exp2f(-1.4426950408889634f * x)); }
struct EpiSwiGLU {
    static constexpr bool PERM = true;
    bf16_t* Hb;
    __device__ __forceinline__ void operator()(const f32x4 (&acc)[2][2][4][2], const Unit& u, int wr, int wc, int fr, int fq) const {
        asm volatile("" : "+v"(fr), "+v"(fq));
        const int row0 = u.pm * BM + wr * 64 + fr; const int col0 = u.pn * HALF + wc * 32 + 8 * fq;
#pragma unroll
        for (int ai = 0; ai < 2; ++ai)
#pragma unroll
            for (int m = 0; m < 4; ++m) { bf16_t* p = Hb + (size_t)(row0 + ai * HALF + m * 16) * DFF + col0;
                const f32x4 g0 = acc[ai][0][m][0], g1 = acc[ai][0][m][1], u0 = acc[ai][1][m][0], u1 = acc[ai][1][m][1];
                u32x4 w; w.x = pk2(silu_f(g0[0]) * u0[0], silu_f(g0[1]) * u0[1]); w.y = pk2(silu_f(g0[2]) * u0[2], silu_f(g0[3]) * u0[3]);
                w.z = pk2(silu_f(g1[0]) * u1[0], silu_f(g1[1]) * u1[1]); w.w = pk2(silu_f(g1[2]) * u1[2], silu_f(g1[3]) * u1[3]);
                *(u32x4*)p = w; }
    }
};
struct EpiMoeScatter {
    static constexpr bool PERM = true;
    bf16_t* YM0; bf16_t* YM1; const unsigned* ltok; const float* lw; const PG8_LAS int* tab;
    __device__ __forceinline__ void operator()(const f32x4 (&acc)[2][2][4][2], const Unit& u, int wr, int wc, int fr, int fq) const {
        asm volatile("" : "+v"(fr), "+v"(fq));
        const int cnt = __builtin_amdgcn_readfirstlane(tab[u.e]); const int col0 = u.pn * BM + wc * 32 + 8 * fq;
        const size_t lbase = (size_t)u.e * LCAP + (size_t)u.jb * 256;
#pragma unroll
        for (int ai = 0; ai < 2; ++ai)
#pragma unroll
            for (int m = 0; m < 4; ++m) { const int r = ai * HALF + wr * 64 + m * 16 + fr;
                if (u.jb * 256 + r < cnt) {
                    const unsigned tk = ltok[lbase + r]; const float w = lw[lbase + r];
                    bf16_t* p = ((tk >> 31) ? YM1 : YM0) + (size_t)(tk & 0x7fffffffu) * DM + col0;
#pragma unroll
                    for (int bj = 0; bj < 2; ++bj) { const f32x4 v0 = acc[ai][bj][m][0], v1 = acc[ai][bj][m][1];
                        u32x4 o; o.x = pk2(w * v0[0], w * v0[1]); o.y = pk2(w * v0[2], w * v0[3]); o.z = pk2(w * v1[0], w * v1[1]); o.w = pk2(w * v1[2], w * v1[3]);
                        *(u32x4*)(p + bj * HALF) = o; } } }
    }
};
}

#define XB_TMO      128
#define XB_XCNT(j)  (256  + 64 * (j))
#define XB_XSUB(j)  (1280 + 64 * (j))
#define XB_XGEN(j)  (2304 + 64 * (j))
#define XB_TOP      3328
#define XB_TOPGEN   3392
#define XCD_BAR_WORDS 3456
#define XB_SPIN_CAP (1u << 22)
DI unsigned xb_ld(unsigned* p)              { return __hip_atomic_load(p, __ATOMIC_RELAXED, __HIP_MEMORY_SCOPE_AGENT); }
DI unsigned xb_add(unsigned* p, unsigned v) { return __hip_atomic_fetch_add(p, v, __ATOMIC_RELAXED, __HIP_MEMORY_SCOPE_AGENT); }
DI unsigned xb_xcc_id() { return (unsigned)__builtin_amdgcn_s_getreg((3 << 11) | 20) & 0xFu; }
#define XB_SPIN(cond, bar) do { unsigned _sp = 0; while (cond) { __builtin_amdgcn_s_sleep(1); \
    if ((++_sp & 255u) == 0u) { if (xb_ld(&(bar)[XB_TMO])) break; if (_sp > XB_SPIN_CAP) { atomicAdd(&(bar)[XB_TMO], 1u); break; } } } } while (0)
struct XcdBarrier { unsigned* bar; unsigned x; volatile LAS unsigned* st; };
DI XcdBarrier xcd_barrier_post(unsigned* bar, volatile LAS unsigned* st) {
    XcdBarrier b; b.bar = bar; b.x = xb_xcc_id(); b.st = st;
    if (threadIdx.x == 0) (void)xb_add(&bar[XB_XCNT(b.x)], 1u);
    return b;
}
DI void xcd_barrier_complete(unsigned* bar, unsigned x, unsigned& nloc, unsigned& nx) {
    const unsigned G = gridDim.x * gridDim.y * gridDim.z;
    unsigned sum, cnt, mine, sp = 0u;
    for (;;) {
        sum = 0u; cnt = 0u; mine = 0u;
#pragma unroll
        for (unsigned j = 0; j < 16; ++j) { const unsigned c = xb_ld(&bar[XB_XCNT(j)]); sum += c; cnt += (c > 0u) ? 1u : 0u; mine = (j == x) ? c : mine; }
        if (sum == G) break;
        __builtin_amdgcn_s_sleep(1);
        if ((++sp & 255u) == 0u) { if (xb_ld(&bar[XB_TMO])) break; if (sp > XB_SPIN_CAP) { atomicAdd(&bar[XB_TMO], 1u); break; } }
    }
    nloc = mine > 0u ? mine : 1u; nx = cnt > 0u ? cnt : 1u;
}
DI void xcd_barrier(const XcdBarrier& b) {
    asm volatile("s_waitcnt vmcnt(0)" ::: "memory");
    __syncthreads();
    if (threadIdx.x == 0) {
        unsigned* bar = b.bar;
        __builtin_amdgcn_s_waitcnt(0);
        unsigned nloc = b.st[0], nx = b.st[1];
        if (nloc == 0u) { xcd_barrier_complete(bar, b.x, nloc, nx); b.st[0] = nloc; b.st[1] = nx; }
        const unsigned old = xb_add(&bar[XB_XSUB(b.x)], 1u);
        const unsigned gen = old / nloc;
        if (old + 1u == (gen + 1u) * nloc) {
            __builtin_amdgcn_fence(__ATOMIC_RELEASE, "agent");
            asm volatile("s_waitcnt vmcnt(0)" ::: "memory");
            const unsigned og = xb_add(&bar[XB_TOP], 1u);
            const unsigned tg = og / nx;
            if (og + 1u == (tg + 1u) * nx) xb_add(&bar[XB_TOPGEN], 1u);
            else XB_SPIN(xb_ld(&bar[XB_TOPGEN]) == tg, bar);
            __builtin_amdgcn_fence(__ATOMIC_ACQUIRE, "agent");
            xb_add(&bar[XB_XGEN(b.x)], 1u);
            asm volatile("s_waitcnt vmcnt(0)" ::: "memory");
        } else {
            XB_SPIN(xb_ld(&bar[XB_XGEN(b.x)]) == gen, bar);
            __builtin_amdgcn_fence(__ATOMIC_ACQUIRE, "agent");
            asm volatile("s_waitcnt vmcnt(0)" ::: "memory");
        }
    }
    __syncthreads();
}

struct Args { const float* in[22]; float* out; unsigned char* ws; int ph_lo, ph_hi; };
struct Frame {
    LAS unsigned char* lds;
    const Args* ka;
    int tid, lane, wave, wg, G;
};
struct Ptrs {
    const Args* a; unsigned char* ws; float* out;
    DI const float* in(int k) const { return a->in[k]; }
    DI unsigned* ctl() const { return (unsigned*)(ws + WS_CTL); }
    DI bf16* Win_t() const { return (bf16*)(ws + WS_WIN); }
    DI bf16* Wout_t() const { return (bf16*)(ws + WS_WOUT); }
    DI bf16* Wgu_t() const { return (bf16*)(ws + WS_WGU); }
    DI bf16* Wd_t() const { return (bf16*)(ws + WS_WD); }
    DI bf16* XB() const { return (bf16*)(ws + WS_XB); }
    DI bf16* X1B() const { return (bf16*)(ws + WS_X1B); }
    DI bf16* PROJ() const { return (bf16*)(ws + WS_PROJ); }
    DI bf16* YMIX() const { return (bf16*)(ws + WS_YMIX); }
    DI bf16* Hb() const { return (bf16*)(ws + WS_H); }
    DI bf16* YM0() const { return (bf16*)(ws + WS_YM0); }
    DI bf16* YM1() const { return (bf16*)(ws + WS_YM1); }
    DI unsigned* ltok() const { return (unsigned*)(ws + WS_LTOK); }
    DI float* lw() const { return (float*)(ws + WS_LW); }
    DI float* small() const { return (float*)(ws + WS_SMALL); }
    DI float* kmean() const { return (float*)(ws + WS_SMALL + SM_KMEAN); }
    DI float* retkv() const { return (float*)((unsigned char*)out + DO_RETKV); }
    DI float* s5e() const { return (float*)((unsigned char*)out + DO_S5E); }
    DI float* yg() const { return (float*)((unsigned char*)out + DO_YG); }
    DI float* V1() const { return out; }
};
DI Ptrs get_ptrs(const Frame& F) { const Args* a = F.ka; asm volatile("" : "+s"(a)); Ptrs P; P.a = a; P.ws = a->ws; P.out = a->out; return P; }

DI void transpose_item(const float* W, int K, int N, bf16* WT, int dst_row0, LAS float* scr, int k0, int n0, int lane) {
#pragma unroll 8
    for (int i = 0; i < 32; ++i) { const int kk = 2 * i + (lane >> 5); scr[kk * 33 + (lane & 31)] = W[(size_t)(k0 + kk) * N + n0 + (lane & 31)]; }
    asm volatile("s_waitcnt lgkmcnt(0)" ::: "memory");
    const int c = lane & 7;
#pragma unroll
    for (int j = 0; j < 4; ++j) { const int n = (lane >> 3) + 8 * j; const LAS float* s = scr + (8 * c) * 33 + n;
        u32x4 o; o.x = pk2(s[0 * 33], s[1 * 33]); o.y = pk2(s[2 * 33], s[3 * 33]); o.z = pk2(s[4 * 33], s[5 * 33]); o.w = pk2(s[6 * 33], s[7 * 33]);
        *(u32x4*)(WT + (size_t)(dst_row0 + n) * K + k0 + 8 * c) = o; }
    asm volatile("s_waitcnt lgkmcnt(0)" ::: "memory");
}
DI void ph_prologue(Frame& F) {
    const Ptrs Q = get_ptrs(F);
    LAS float* scr = (LAS float*)(F.lds + F.wave * 16384);
    const int gw = F.wg * NWAVES + F.wave, NGW = F.G * NWAVES;
    constexpr int I_IN = 16 * 92;
    constexpr int I_OUT = 16 * 32;
    constexpr int I_G = 16 * 16;
    constexpr int I_D = 8 * 32;
    constexpr int N_IN = 2 * I_IN, N_OUT = 2 * I_OUT, N_G = 2 * 16 * I_G, N_D = 2 * 16 * I_D;
    constexpr int NITEMS = N_IN + N_OUT + 2 * N_G + N_D;
    for (int it = gw; it < NITEMS; it += NGW) {
        int r = it;
        if (r < N_IN) { const int l = r / I_IN, q = r % I_IN, kb = q / 92, nb = q % 92;
            transpose_item(Q.in(1) + (size_t)l * DM * DIN, DM, DIN, Q.Win_t() + (size_t)l * DINP * DM, 32 * nb, scr, 64 * kb, 32 * nb, F.lane); continue; }
        r -= N_IN;
        if (r < N_OUT) { const int l = r / I_OUT, q = r % I_OUT, kb = q / 32, nb = q % 32;
            transpose_item(Q.in(2) + (size_t)l * DM * DM, DM, DM, Q.Wout_t() + (size_t)l * DM * DM, 32 * nb, scr, 64 * kb, 32 * nb, F.lane); continue; }
        r -= N_OUT;
        if (r < 2 * N_G) { const int s = r / N_G; const int rr = r % N_G; const int le = rr / I_G, q = rr % I_G, kb = q / 16, nb = q % 16; const int n0 = 32 * nb;
            const float* W = (s ? Q.in(20) : Q.in(19)) + (size_t)le * DM * DFF;
            transpose_item(W, DM, DFF, Q.Wgu_t() + (size_t)le * 1024 * 1024, 256 * (n0 >> 7) + 128 * s + (n0 & 127), scr, 64 * kb, n0, F.lane); continue; }
        r -= 2 * N_G;
        { const int le = r / I_D, q = r % I_D, kb = q / 32, nb = q % 32;
            transpose_item(Q.in(21) + (size_t)le * DFF * DM, DFF, DM, Q.Wd_t() + (size_t)le * 1024 * DFF, 32 * nb, scr, 64 * kb, 32 * nb, F.lane); }
    }
    const int gt = F.wg * NTHR + F.tid, NGT = F.G * NTHR;
    for (int i = gt; i < 2 * 128 * DM / 8; i += NGT) { const int l = i / (128 * DM / 8), q = i % (128 * DM / 8);
        *(u32x4*)(Q.Win_t() + (size_t)l * DINP * DM + (size_t)DIN * DM + (size_t)q * 8) = (u32x4){0u, 0u, 0u, 0u}; }
    for (int i = gt; i < TOK * DM / 8; i += NGT) { const f32x4 a = *(const f32x4*)(Q.in(0) + (size_t)i * 8), b = *(const f32x4*)(Q.in(0) + (size_t)i * 8 + 4);
        u32x4 o; o.x = pk2(a[0], a[1]); o.y = pk2(a[2], a[3]); o.z = pk2(b[0], b[1]); o.w = pk2(b[2], b[3]); *(u32x4*)(Q.XB() + (size_t)i * 8) = o; }
    for (int i = gt; i < 2 * 1024; i += NGT) { const int l = i >> 10, gn = i & 1023, g = gn >> 6;
        float* P = Q.small() + (size_t)l * SSMP_FLOATS;
        const float lr = fminf(Q.in(3)[l * 1024 + gn], -1e-4f), li = Q.in(4)[l * 1024 + gn], dt = expf(Q.in(5)[l * 16 + g]);
        float sn_, cs_; sincos_acc(li * dt, sn_, cs_);
        const float mag = expf(lr * dt), ar = mag * cs_, ai = mag * sn_;
        const float den = lr * lr + li * li, zr = ar - 1.0f, zi = ai;
        const float fr = (zr * lr + zi * li) / den, fi = (zi * lr - zr * li) / den;
        P[gn * 2] = ar; P[gn * 2 + 1] = ai;
        float pr = ar, pi = ai;
#pragma unroll
        for (int s = 0; s < 7; ++s) { const float nr = pr * pr - pi * pi, ni = 2.0f * pr * pi; pr = nr; pi = ni; }
        P[2048 + gn * 2] = pr; P[2048 + gn * 2 + 1] = pi;
        for (int c = 0; c < 16; ++c) { const float br = Q.in(6)[(size_t)l * 16384 + gn * 16 + c], bi = Q.in(7)[(size_t)l * 16384 + gn * 16 + c];
            P[4096 + (gn * 16 + c) * 2] = fr * br - fi * bi; P[4096 + (gn * 16 + c) * 2 + 1] = fr * bi + fi * br; } }
}

DI void ph_kmean(Frame& F) {
    const Ptrs Q = get_ptrs(F);
    LAS float* red = (LAS float*)F.lds;
    for (int it = F.wg; it < BATCH * NH * NKB; it += F.G) {
        const int b = it / (NH * NKB), h = (it / NKB) % NH, n = it % NKB;
        const bf16* p = Q.PROJ() + (size_t)(b * SEQ + n * KBLK + F.wave * 32) * DINP + C_KA + h * HD + F.lane;
        float s = 0.f;
        for (int r = 0; r < 32; ++r) s += bf2f(p[(size_t)r * DINP]);
        red[F.wave * 64 + F.lane] = s;
        __syncthreads();
        if (F.tid < 64) { float t = 0.f; for (int w = 0; w < 8; ++w) t += red[w * 64 + F.tid]; Q.kmean()[(size_t)((b * NH + h) * NKB + n) * HD + F.tid] = t * (1.0f / 256.0f); }
        __syncthreads();
    }
}
template <int MODE> DI void load_tile128(Frame& F, const bf16* src, LAS float* dst, float log2g) {
    const int row = F.tid >> 2, c0 = (F.tid & 3) * 16;
    const u32x4 a = *(const u32x4*)(src + (size_t)row * DINP + c0), b = *(const u32x4*)(src + (size_t)row * DINP + c0 + 8);
    float v[16]; unpack8(a, v); unpack8(b, v + 8);
    float sc = 1.0f; if (MODE == 1) sc = 0.125f; if (MODE == 2) sc = 0.125f * exp2f(log2g * (float)(127 - row));
#pragma unroll
    for (int k = 0; k < 16; k += 4) *(LAS f32x4*)(dst + row * 64 + c0 + k) = (f32x4){v[k] * sc, v[k + 1] * sc, v[k + 2] * sc, v[k + 3] * sc};
}
DI void ph_ret_kv(Frame& F) {
    const Ptrs Q = get_ptrs(F);
    LAS float* Ks = (LAS float*)F.lds; LAS float* Vs = Ks + 8192;
    for (int it = F.wg; it < BATCH * 128 * NH; it += F.G) {
        const int b = it / (128 * NH), c = (it / NH) % 128, h = it % NH;
        const float lg = ret_log2g(h);
        const bf16* base = Q.PROJ() + (size_t)(b * SEQ + c * 128) * DINP + h * HD;
        load_tile128<2>(F, base + C_KR, Ks, lg); load_tile128<0>(F, base + C_VR, Vs, lg);
        __syncthreads();
        float* o = Q.retkv() + (size_t)((b * 128 + c) * NH + h) * 4096;
        for (int i = 0; i < 8; ++i) { const int idx = F.tid + 512 * i, dk = idx >> 6, dv = idx & 63; float acc = 0.f;
            for (int j = 0; j < 128; ++j) acc += Ks[j * 64 + dk] * Vs[j * 64 + dv];
            o[idx] = acc; }
        __syncthreads();
    }
}
DI void ph_scans(Frame& F, int l) {
    const Ptrs Q = get_ptrs(F);
    const int gt = F.wg * NTHR + F.tid, NGT = F.G * NTHR;
    for (int i = gt; i < BATCH * NH * 4096; i += NGT) { const int e = i & 4095, h = (i >> 12) % NH, b = i / (NH * 4096);
        const float d128 = exp2f(ret_log2g(h) * 128.0f); float st = 0.f;
        float* p = Q.retkv() + (size_t)(b * 128 * NH + h) * 4096 + e;
        for (int c = 0; c < 128; ++c) { const float t = p[(size_t)c * NH * 4096]; p[(size_t)c * NH * 4096] = st; st = st * d128 + t; } }
    const float* P = Q.small() + (size_t)l * SSMP_FLOATS;
    for (int i = gt; i < BATCH * 16 * 64; i += NGT) { const int n = i & 63, g = (i >> 6) & 15, b = i >> 10;
        const float ar = P[2048 + (g * 64 + n) * 2], ai = P[2048 + (g * 64 + n) * 2 + 1]; float sr = 0.f, si = 0.f;
        float* p = Q.s5e() + ((size_t)((b * 16 + g) * 128) * 64 + n) * 2;
        for (int c = 0; c < 128; ++c) { const float tr = p[(size_t)c * 128], ti = p[(size_t)c * 128 + 1]; p[(size_t)c * 128] = sr; p[(size_t)c * 128 + 1] = si;
            const float nr = ar * sr - ai * si + tr, ni = ar * si + ai * sr + ti; sr = nr; si = ni; } }
}
DI void ph_ret_out(Frame& F) {
    const Ptrs Q = get_ptrs(F);
    LAS float* Ks = (LAS float*)F.lds; LAS float* Vs = Ks + 8192; LAS float* Ps = Vs + 8192;
    const int i = F.tid >> 2, dq = F.tid & 3;
    for (int it = F.wg; it < BATCH * 128 * NH; it += F.G) {
        const int b = it / (128 * NH), c = (it / NH) % 128, h = it % NH;
        const float lg = ret_log2g(h);
        const size_t row0 = (size_t)(b * SEQ + c * 128);
        const bf16* base = Q.PROJ() + row0 * DINP + h * HD;
        load_tile128<1>(F, base + C_KR, Ks, lg); load_tile128<0>(F, base + C_VR, Vs, lg);
        const float* pv = Q.retkv() + (size_t)((b * 128 + c) * NH + h) * 4096;
        for (int k = 0; k < 8; ++k) Ps[F.tid + 512 * k] = pv[F.tid + 512 * k];
        float q[64];
        { const bf16* qp = base + (size_t)i * DINP + C_QR;
#pragma unroll
          for (int k = 0; k < 8; ++k) { const u32x4 a = *(const u32x4*)(qp + 8 * k); unpack8(a, q + 8 * k); } }
        __syncthreads();
        float acc[16];
#pragma unroll
        for (int e = 0; e < 16; ++e) acc[e] = 0.f;
        for (int j = 0; j <= i; ++j) {
            float s = 0.f;
#pragma unroll
            for (int d = 0; d < 64; d += 4) { const f32x4 kk = *(const LAS f32x4*)(Ks + j * 64 + d); s += q[d] * kk[0] + q[d + 1] * kk[1] + q[d + 2] * kk[2] + q[d + 3] * kk[3]; }
            s *= exp2f(lg * (float)(i - j));
#pragma unroll
            for (int e = 0; e < 16; e += 4) { const f32x4 vv = *(const LAS f32x4*)(Vs + j * 64 + dq * 16 + e); acc[e] += s * vv[0]; acc[e + 1] += s * vv[1]; acc[e + 2] += s * vv[2]; acc[e + 3] += s * vv[3]; }
        }
        const float xi = exp2f(lg * (float)(i + 1));
#pragma unroll
        for (int dk = 0; dk < 64; ++dk) { const float qd = q[dk] * xi;
#pragma unroll
            for (int e = 0; e < 16; e += 4) { const f32x4 pp = *(const LAS f32x4*)(Ps + dk * 64 + dq * 16 + e); acc[e] += qd * pp[0]; acc[e + 1] += qd * pp[1]; acc[e + 2] += qd * pp[2]; acc[e + 3] += qd * pp[3]; } }
        float s1 = 0.f;
#pragma unroll
        for (int e = 0; e < 16; ++e) s1 += acc[e];
        s1 += __shfl_xor(s1, 1); s1 += __shfl_xor(s1, 2);
        const float mean = s1 * (1.0f / 64.0f); float s2 = 0.f;
#pragma unroll
        for (int e = 0; e < 16; ++e) { acc[e] -= mean; s2 += acc[e] * acc[e]; }
        s2 += __shfl_xor(s2, 1); s2 += __shfl_xor(s2, 2);
        const float rstd = 1.0f / sqrtf(s2 * (1.0f / 64.0f) + GN_EPS);
        const bf16* gp = base + (size_t)i * DINP + C_GR + dq * 16;
        float gv[16]; { const u32x4 a = *(const u32x4*)gp, bb = *(const u32x4*)(gp + 8); unpack8(a, gv); unpack8(bb, gv + 8); }
        float ov[16];
#pragma unroll
        for (int e = 0; e < 16; ++e) { const float g = gv[e]; ov[e] = acc[e] * rstd * (g / (1.0f + expf(-g))); }
        bf16* op = Q.YMIX() + (row0 + i) * DM + 384 + h * HD + dq * 16;
        *(u32x4*)op = (u32x4){pk2(ov[0], ov[1]), pk2(ov[2], ov[3]), pk2(ov[4], ov[5]), pk2(ov[6], ov[7])};
        *(u32x4*)(op + 8) = (u32x4){pk2(ov[8], ov[9]), pk2(ov[10], ov[11]), pk2(ov[12], ov[13]), pk2(ov[14], ov[15])};
        __syncthreads();
    }
}
DI void s5_load_u(const bf16* up, float* u) { const u32x4 a = *(const u32x4*)up, b = *(const u32x4*)(up + 8); unpack8(a, u); unpack8(b, u + 8); }
DI void ph_s5_local(Frame& F, int l) {
    const Ptrs Q = get_ptrs(F);
    const float* P = Q.small() + (size_t)l * SSMP_FLOATS;
    for (int it = F.wg * NWAVES + F.wave; it < BATCH * 16 * 128; it += F.G * NWAVES) {
        const int ch = it & 127, g = (it >> 7) & 15, b = it >> 11; const int n = F.lane;
        const float ar = P[(g * 64 + n) * 2], ai = P[(g * 64 + n) * 2 + 1];
        float bbr[16], bbi[16];
#pragma unroll
        for (int c = 0; c < 16; ++c) { bbr[c] = P[4096 + ((g * 64 + n) * 16 + c) * 2]; bbi[c] = P[4096 + ((g * 64 + n) * 16 + c) * 2 + 1]; }
        float hr = 0.f, hi = 0.f;
        const bf16* up = Q.PROJ() + (size_t)(b * SEQ + ch * 128) * DINP + C_US + g * 16;
        for (int s = 0; s < 128; ++s) { float u[16]; s5_load_u(up + (size_t)s * DINP, u); float xr = 0.f, xi = 0.f;
#pragma unroll
            for (int c = 0; c < 16; ++c) { xr += bbr[c] * u[c]; xi += bbi[c] * u[c]; }
            const float nr = ar * hr - ai * hi + xr, ni = ar * hi + ai * hr + xi; hr = nr; hi = ni; }
        float* e = Q.s5e() + ((size_t)((b * 16 + g) * 128 + ch) * 64 + n) * 2; e[0] = hr; e[1] = hi;
    }
}
DI float gelu_tanh(float v) { const float z = 0.7978845608028654f * (v + 0.044715f * v * v * v); const float t = 1.0f - 2.0f / (expf(2.0f * z) + 1.0f); return 0.5f * v * (1.0f + t); }
DI void ph_s5_out(Frame& F, int l) {
    const Ptrs Q = get_ptrs(F);
    const float* P = Q.small() + (size_t)l * SSMP_FLOATS;
    LAS float* Cre = (LAS float*)F.lds; LAS float* Cim = Cre + 16 * 65;
    LAS float* hre = Cim + 16 * 65 + F.wave * (2 * 16 * 65); LAS float* him = hre + 16 * 65;
    const float* cre_g = Q.in(8) + (size_t)l * 16384; const float* cim_g = Q.in(9) + (size_t)l * 16384; const float* dsk = Q.in(10) + (size_t)l * 256;
    for (int it = F.wg; it < BATCH * 16 * 16; it += F.G) {
        const int cgp = it & 15, g = (it >> 4) & 15, b = it >> 8; const int ch = cgp * 8 + F.wave; const int n = F.lane;
        for (int idx = F.tid; idx < 1024; idx += NTHR) { const int c = idx >> 6, nn = idx & 63; Cre[c * 65 + nn] = cre_g[(g * 16 + c) * 64 + nn]; Cim[c * 65 + nn] = cim_g[(g * 16 + c) * 64 + nn]; }
        __syncthreads();
        const float ar = P[(g * 64 + n) * 2], ai = P[(g * 64 + n) * 2 + 1];
        float bbr[16], bbi[16];
#pragma unroll
        for (int c = 0; c < 16; ++c) { bbr[c] = P[4096 + ((g * 64 + n) * 16 + c) * 2]; bbi[c] = P[4096 + ((g * 64 + n) * 16 + c) * 2 + 1]; }
        const float* e = Q.s5e() + ((size_t)((b * 16 + g) * 128 + ch) * 64 + n) * 2;
        float hr = e[0], hi = e[1];
        const size_t row0 = (size_t)(b * SEQ + ch * 128);
        const bf16* up = Q.PROJ() + row0 * DINP + C_US + g * 16;
        const int tl = F.lane >> 2, cq = F.lane & 3;
        for (int blk = 0; blk < 8; ++blk) {
            for (int s = 0; s < 16; ++s) { float u[16]; s5_load_u(up + (size_t)(blk * 16 + s) * DINP, u); float xr = 0.f, xi = 0.f;
#pragma unroll
                for (int c = 0; c < 16; ++c) { xr += bbr[c] * u[c]; xi += bbi[c] * u[c]; }
                const float nr = ar * hr - ai * hi + xr, ni = ar * hi + ai * hr + xi; hr = nr; hi = ni;
                hre[s * 65 + n] = hr; him[s * 65 + n] = hi; }
            __builtin_amdgcn_wave_barrier();
            float y[4] = {0.f, 0.f, 0.f, 0.f};
            for (int n2 = 0; n2 < 64; ++n2) { const float a = hre[tl * 65 + n2], bq = him[tl * 65 + n2];
#pragma unroll
                for (int k = 0; k < 4; ++k) y[k] += a * Cre[(4 * cq + k) * 65 + n2] - bq * Cim[(4 * cq + k) * 65 + n2]; }
            __builtin_amdgcn_wave_barrier();
            const size_t t = row0 + blk * 16 + tl;
            const u32x2 uu = *(const u32x2*)(Q.PROJ() + t * DINP + C_US + g * 16 + 4 * cq);
            const float u0 = __uint_as_float(uu.x << 16), u1 = __uint_as_float(uu.x & 0xffff0000u), u2 = __uint_as_float(uu.y << 16), u3 = __uint_as_float(uu.y & 0xffff0000u);
            f32x4 o; o[0] = gelu_tanh(y[0] + dsk[g * 16 + 4 * cq] * u0); o[1] = gelu_tanh(y[1] + dsk[g * 16 + 4 * cq + 1] * u1);
            o[2] = gelu_tanh(y[2] + dsk[g * 16 + 4 * cq + 2] * u2); o[3] = gelu_tanh(y[3] + dsk[g * 16 + 4 * cq + 3] * u3);
            *(f32x4*)(Q.yg() + t * 256 + g * 16 + 4 * cq) = o;
        }
        __syncthreads();
    }
}
DI void ph_s5_glu(Frame& F, int l) {
    const Ptrs Q = get_ptrs(F);
    LAS float* ys = (LAS float*)F.lds;
    const float* W = Q.in(11) + (size_t)l * 65536; const float* bg = Q.in(12) + (size_t)l * 256;
    const int j = F.tid & 255, half = F.tid >> 8;
    for (int it = F.wg; it < TOK / 64; it += F.G) {
        const float* src = Q.yg() + (size_t)it * 64 * 256;
        for (int k = 0; k < 8; ++k) { const int idx = (F.tid + 512 * k) * 4; *(LAS f32x4*)(ys + idx) = *(const f32x4*)(src + idx); }
        __syncthreads();
        float acc[32];
        const float b0 = bg[j];
#pragma unroll
        for (int tk = 0; tk < 32; ++tk) acc[tk] = b0;
        for (int i = 0; i < 256; i += 4) { const float w0 = W[(i) * 256 + j], w1 = W[(i + 1) * 256 + j], w2 = W[(i + 2) * 256 + j], w3 = W[(i + 3) * 256 + j];
#pragma unroll
            for (int tk = 0; tk < 32; ++tk) { const f32x4 yv = *(const LAS f32x4*)(ys + (half * 32 + tk) * 256 + i); acc[tk] += yv[0] * w0 + yv[1] * w1 + yv[2] * w2 + yv[3] * w3; } }
#pragma unroll
        for (int tk = 0; tk < 32; ++tk) { const float yv = ys[(half * 32 + tk) * 256 + j]; const float o = yv / (1.0f + expf(-acc[tk]));
            Q.YMIX()[((size_t)it * 64 + half * 32 + tk) * DM + 768 + j] = (bf16)f2bf(o); }
        __syncthreads();
    }
}
DI void ph_moba_simple(Frame& F) {
    const Ptrs Q = get_ptrs(F);
    LAS float* km = (LAS float*)F.lds;
    for (int it = F.wg; it < BATCH * NH * 32; it += F.G) {
        const int qc = it & 31, h = (it >> 5) % NH, b = it / (NH * 32);
        const float* kmg = Q.kmean() + (size_t)(b * NH + h) * 4096;
        for (int k = 0; k < 8; ++k) km[F.tid + 512 * k] = kmg[F.tid + 512 * k];
        __syncthreads();
        const int t = qc * 512 + F.tid; const int own = t >> 8; const size_t row = (size_t)b * SEQ + t;
        float q[64];
        { const bf16* qp = Q.PROJ() + row * DINP + C_QA + h * HD;
#pragma unroll
          for (int k = 0; k < 8; ++k) { const u32x4 a = *(const u32x4*)(qp + 8 * k); unpack8(a, q + 8 * k); } }
        float v0 = -INFINITY, v1 = -INFINITY, v2 = -INFINITY; int i0 = 0, i1 = 0, i2 = 0;
        for (int n = 0; n < own; ++n) { float g = 0.f;
#pragma unroll
            for (int d = 0; d < 64; d += 4) { const f32x4 kk = *(const LAS f32x4*)(km + n * 64 + d); g += q[d] * kk[0] + q[d + 1] * kk[1] + q[d + 2] * kk[2] + q[d + 3] * kk[3]; }
            if (g > v0) { v2 = v1; i2 = i1; v1 = v0; i1 = i0; v0 = g; i0 = n; } else if (g > v1) { v2 = v1; i2 = i1; v1 = g; i1 = n; } else if (g > v2) { v2 = g; i2 = n; } }
        const int nsel = own < 3 ? own : 3;
        const float slope = alibi_slope(h);
        float m = -INFINITY, lsum = 0.f; float o[64];
#pragma unroll
        for (int d = 0; d < 64; ++d) o[d] = 0.f;
        for (int p = 0; p < 4; ++p) {
            if (p < 3 && p >= nsel) continue;
            const int blk = p == 0 ? i0 : p == 1 ? i1 : p == 2 ? i2 : own;
            const int kend = p == 3 ? (t & 255) : 255;
            const bf16* kp = Q.PROJ() + ((size_t)b * SEQ + (size_t)blk * 256) * DINP + h * HD;
            for (int s = 0; s <= kend; ++s) {
                float kv[64];
#pragma unroll
                for (int k = 0; k < 8; ++k) { const u32x4 a = *(const u32x4*)(kp + (size_t)s * DINP + C_KA + 8 * k); unpack8(a, kv + 8 * k); }
                float dot = 0.f;
#pragma unroll
                for (int d = 0; d < 64; ++d) dot += q[d] * kv[d];
                const float sc = dot * 0.125f - slope * (float)(t - (blk * 256 + s));
                if (sc > m) { const float corr = expf(m - sc); lsum *= corr;
#pragma unroll
                    for (int d = 0; d < 64; ++d) o[d] *= corr;
                    m = sc; }
                const float pw = expf(sc - m); lsum += pw;
#pragma unroll
                for (int k = 0; k < 8; ++k) { const u32x4 a = *(const u32x4*)(kp + (size_t)s * DINP + C_VA + 8 * k); unpack8(a, kv + 8 * k); }
#pragma unroll
                for (int d = 0; d < 64; ++d) o[d] += pw * kv[d];
            }
        }
        const float inv = 1.0f / lsum;
        bf16* op = Q.YMIX() + row * DM + h * HD;
#pragma unroll
        for (int k = 0; k < 8; ++k) *(u32x4*)(op + 8 * k) = (u32x4){pk2(o[8 * k] * inv, o[8 * k + 1] * inv), pk2(o[8 * k + 2] * inv, o[8 * k + 3] * inv), pk2(o[8 * k + 4] * inv, o[8 * k + 5] * inv), pk2(o[8 * k + 6] * inv, o[8 * k + 7] * inv)};
        __syncthreads();
    }
}
DI void ph_ln1_router(Frame& F, int l) {
    const Ptrs Q = get_ptrs(F);
    LAS float* rwT = (LAS float*)F.lds;
    for (int idx = F.tid; idx < 16384; idx += NTHR) { const int d = idx >> 4, e = idx & 15; rwT[e * 1024 + d] = Q.in(17)[idx]; }
    __syncthreads();
    const float* gam = Q.in(13) + l * DM; const float* bet = Q.in(14) + l * DM; const float* rb = Q.in(18);
    unsigned* ecnt = Q.ctl() + CW_ECNT + 64 * l;
    for (int r = F.wg * NWAVES + F.wave; r < TOK; r += F.G * NWAVES) {
        f32x4 v[4]; float s = 0.f;
#pragma unroll
        for (int j = 0; j < 4; ++j) { v[j] = *(const f32x4*)(Q.V1() + (size_t)r * DM + j * 256 + F.lane * 4); s += (v[j][0] + v[j][1]) + (v[j][2] + v[j][3]); }
        const float mean = wave_sum(s) * (1.0f / DM); float s2 = 0.f;
#pragma unroll
        for (int j = 0; j < 4; ++j) { v[j] = v[j] - mean; s2 += (v[j][0] * v[j][0] + v[j][1] * v[j][1]) + (v[j][2] * v[j][2] + v[j][3] * v[j][3]); }
        const float rstd = 1.0f / sqrtf(wave_sum(s2) * (1.0f / DM) + LN_EPS);
        float lg[16];
#pragma unroll
        for (int e = 0; e < 16; ++e) lg[e] = 0.f;
#pragma unroll
        for (int j = 0; j < 4; ++j) { const int d0 = j * 256 + F.lane * 4; const f32x4 gg = *(const f32x4*)(gam + d0), bb = *(const f32x4*)(bet + d0);
            v[j] = v[j] * rstd * gg + bb;
            *(u32x2*)(Q.X1B() + (size_t)r * DM + d0) = (u32x2){pk2(v[j][0], v[j][1]), pk2(v[j][2], v[j][3])}; }
#pragma unroll
        for (int e = 0; e < 16; ++e) { float a_ = 0.f;
#pragma unroll
            for (int j = 0; j < 4; ++j) { const f32x4 w = *(const LAS f32x4*)(rwT + e * 1024 + j * 256 + F.lane * 4); a_ += v[j][0] * w[0] + v[j][1] * w[1] + v[j][2] * w[2] + v[j][3] * w[3]; }
            lg[e] = a_; asm volatile("" ::: "memory"); }
        float aff[16], sel[16];
#pragma unroll
        for (int e = 0; e < 16; ++e) { const float z = wave_sum(lg[e]); aff[e] = 1.0f / (1.0f + expf(-z)); sel[e] = aff[e] + rb[e]; }
        float gs[4];
#pragma unroll
        for (int g = 0; g < 4; ++g) { const float a = sel[4 * g], bq = sel[4 * g + 1], c = sel[4 * g + 2], d = sel[4 * g + 3];
            gs[g] = fmaxf(fmaxf(fmaxf(a + bq, a + c), fmaxf(a + d, bq + c)), fmaxf(bq + d, c + d)); }
        int gb = 0; float gbv = gs[0];
#pragma unroll
        for (int g = 1; g < 4; ++g) if (gs[g] > gbv) { gbv = gs[g]; gb = g; }
        float s4[4], a4[4];
#pragma unroll
        for (int k = 0; k < 4; ++k) { s4[k] = gb == 0 ? sel[k] : gb == 1 ? sel[4 + k] : gb == 2 ? sel[8 + k] : sel[12 + k]; a4[k] = gb == 0 ? aff[k] : gb == 1 ? aff[4 + k] : gb == 2 ? aff[8 + k] : aff[12 + k]; }
        int f0 = 0; float fv = s4[0], fa = a4[0];
#pragma unroll
        for (int k = 1; k < 4; ++k) if (s4[k] > fv) { fv = s4[k]; f0 = k; fa = a4[k]; }
        int f1 = -1; float sv = -INFINITY, sa = 0.f;
#pragma unroll
        for (int k = 0; k < 4; ++k) if (k != f0 && s4[k] > sv) { sv = s4[k]; f1 = k; sa = a4[k]; }
        const float wsum = fa + sa;
        if (F.lane == 0) {
            const int e0 = gb * 4 + f0, e1 = gb * 4 + f1;
            const unsigned p0 = atomicAdd(&ecnt[e0], 1u); Q.ltok()[(size_t)e0 * LCAP + p0] = (unsigned)r; Q.lw()[(size_t)e0 * LCAP + p0] = fa / wsum;
            const unsigned p1 = atomicAdd(&ecnt[e1], 1u); Q.ltok()[(size_t)e1 * LCAP + p1] = (unsigned)r | 0x80000000u; Q.lw()[(size_t)e1 * LCAP + p1] = sa / wsum;
        }
    }
}
DI void moe_build_tab(Frame& F, int l) {
    const Ptrs Q = get_ptrs(F);
    LAS int* tab = (LAS int*)(F.lds + MOE_TAB_OFF);
    __syncthreads();
    if (F.tid == 0) {
        const unsigned* ecnt = Q.ctl() + CW_ECNT + 64 * l; int pb = 0;
        for (int e = 0; e < 16; ++e) { const int c = (int)__hip_atomic_load(ecnt + e, __ATOMIC_RELAXED, __HIP_MEMORY_SCOPE_AGENT); tab[e] = c; tab[16 + e] = pb; const int nb = (c + 255) >> 8;
            for (int j = 0; j < nb; ++j) tab[64 + pb + j] = e;
            pb += nb; }
        tab[32] = pb;
    }
    __syncthreads();
}
DI void ph_ln2(Frame& F, int l) {
    const Ptrs Q = get_ptrs(F);
    const float* gam = Q.in(15) + l * DM; const float* bet = Q.in(16) + l * DM;
    for (int r = F.wg * NWAVES + F.wave; r < TOK; r += F.G * NWAVES) {
        float v[16]; float s = 0.f;
#pragma unroll
        for (int j = 0; j < 2; ++j) { const size_t off = (size_t)r * DM + j * 512 + F.lane * 8;
            float a[8], b0[8], b1[8]; unpack8(*(const u32x4*)(Q.X1B() + off), a); unpack8(*(const u32x4*)(Q.YM0() + off), b0); unpack8(*(const u32x4*)(Q.YM1() + off), b1);
#pragma unroll
            for (int k = 0; k < 8; ++k) { v[j * 8 + k] = ALPHA * a[k] + (b0[k] + b1[k]); s += v[j * 8 + k]; } }
        const float mean = wave_sum(s) * (1.0f / DM); float s2 = 0.f;
#pragma unroll
        for (int k = 0; k < 16; ++k) { v[k] -= mean; s2 += v[k] * v[k]; }
        const float rstd = 1.0f / sqrtf(wave_sum(s2) * (1.0f / DM) + LN_EPS);
#pragma unroll
        for (int j = 0; j < 2; ++j) { const int d0 = j * 512 + F.lane * 8; float o[8];
#pragma unroll
            for (int k = 0; k < 8; ++k) o[k] = v[j * 8 + k] * rstd * gam[d0 + k] + bet[d0 + k];
            if (l == DEPTH - 1) { *(f32x4*)(Q.out + (size_t)r * DM + d0) = (f32x4){o[0], o[1], o[2], o[3]}; *(f32x4*)(Q.out + (size_t)r * DM + d0 + 4) = (f32x4){o[4], o[5], o[6], o[7]}; }
            else *(u32x4*)(Q.XB() + (size_t)r * DM + d0) = (u32x4){pk2(o[0], o[1]), pk2(o[2], o[3]), pk2(o[4], o[5]), pk2(o[6], o[7])}; }
    }
}

constexpr int PH_PER_LAYER = 10, NPH = 1 + DEPTH * PH_PER_LAYER;
DI void grid_barrier(const Frame& F) {
    const Ptrs Q = get_ptrs(F);
    XcdBarrier b; b.bar = Q.ctl() + CW_BAR; b.x = xb_xcc_id(); b.st = (volatile LAS unsigned*)(F.lds + MISC_OFF) + 8;
    xcd_barrier(b);
}
DI void refresh_ids(Frame& F, int wave0) {
    int w_ = wave0; asm volatile("" : "+s"(w_)); unsigned z_ = 0u; asm volatile("" : "+v"(z_));
    const int ln_ = (int)__builtin_amdgcn_mbcnt_hi(~0u, __builtin_amdgcn_mbcnt_lo(~0u, z_));
    F.wave = w_; F.lane = ln_; F.tid = w_ * 64 + ln_;
}
#if MK_ONE_LAUNCH
#define PHASE_END(k) do { if ((k) + 1 < ph_hi) grid_barrier(F); } while (0)
#else
#define PHASE_END(k) do { __syncthreads(); } while (0)
#endif
#define PHASE_IN(k) (ph_lo <= (k) && (k) < ph_hi)
template <int L> DI void run_layer(Frame& F, const int wave0, const int ph_lo, const int ph_hi) {
    constexpr int base = 1 + L * PH_PER_LAYER;
    const LAS int* tab = (const LAS int*)(F.lds + MOE_TAB_OFF);
    if (PHASE_IN(base + 0)) { refresh_ids(F, wave0);
        { const Ptrs Q = get_ptrs(F);
          pg8::DenseSched S; S.init(Q.XB(), Q.Win_t() + (size_t)L * DINP * DM, TOK, DINP, DM, F.G, F.wg);
          pg8::EpiBf16 E{Q.PROJ(), DINP};
          pg8::gemm_phase<pg8::EpiBf16, pg8::DenseSched, true>(F.lds, F.tid, DM, S, E); }
        PHASE_END(base + 0); }
    if (PHASE_IN(base + 1)) { refresh_ids(F, wave0); ph_kmean(F); ph_ret_kv(F); ph_s5_local(F, L); PHASE_END(base + 1); }
    if (PHASE_IN(base + 2)) { refresh_ids(F, wave0); ph_scans(F, L); PHASE_END(base + 2); }
    if (PHASE_IN(base + 3)) { refresh_ids(F, wave0); ph_moba_simple(F); refresh_ids(F, wave0); ph_ret_out(F); refresh_ids(F, wave0); ph_s5_out(F, L); PHASE_END(base + 3); }
    if (PHASE_IN(base + 4)) { refresh_ids(F, wave0); ph_s5_glu(F, L); PHASE_END(base + 4); }
    if (PHASE_IN(base + 5)) { refresh_ids(F, wave0);
        { const Ptrs Q = get_ptrs(F);
          pg8::DenseSched S; S.init(Q.YMIX(), Q.Wout_t() + (size_t)L * DM * DM, TOK, DM, DM, F.G, F.wg);
          pg8::EpiResF32 E{Q.V1(), Q.XB()};
          pg8::gemm_phase<pg8::EpiResF32, pg8::DenseSched, true>(F.lds, F.tid, DM, S, E); }
        PHASE_END(base + 5); }
    if (PHASE_IN(base + 6)) { refresh_ids(F, wave0); ph_ln1_router(F, L); PHASE_END(base + 6); }
    if (PHASE_IN(base + 7)) { refresh_ids(F, wave0);
        moe_build_tab(F, L);
        { const Ptrs Q = get_ptrs(F);
          pg8::MoeUpSched S{Q.X1B(), Q.Wgu_t() + (size_t)L * 16 * 1024 * 1024, Q.ltok(), tab, F.G, F.wg};
          pg8::EpiSwiGLU E{Q.Hb()};
          pg8::gemm_phase<pg8::EpiSwiGLU, pg8::MoeUpSched, true>(F.lds, F.tid, DM, S, E); }
        PHASE_END(base + 7); }
    if (PHASE_IN(base + 8)) { refresh_ids(F, wave0);
        moe_build_tab(F, L);
        { const Ptrs Q = get_ptrs(F);
          pg8::MoeDownSched S{Q.Hb(), Q.Wd_t() + (size_t)L * 16 * 1024 * DFF, tab, F.G, F.wg};
          pg8::EpiMoeScatter E{Q.YM0(), Q.YM1(), Q.ltok(), Q.lw(), tab};
          pg8::gemm_phase<pg8::EpiMoeScatter, pg8::MoeDownSched, true>(F.lds, F.tid, DFF, S, E); }
        PHASE_END(base + 8); }
    if (PHASE_IN(base + 9)) { refresh_ids(F, wave0); ph_ln2(F, L); PHASE_END(base + 9); }
}
__global__ void __launch_bounds__(NTHR, 2) fwd_kernel(Args args_unused) {
    extern __shared__ __attribute__((aligned(16))) unsigned char lds_raw[];
    Frame F;
    F.lds = (LAS unsigned char*)lds_raw;
    F.ka = (const Args*)__builtin_amdgcn_kernarg_segment_ptr();
    F.tid = threadIdx.x; F.lane = F.tid & 63; F.wave = __builtin_amdgcn_readfirstlane(F.tid >> 6);
    F.G = gridDim.x; F.wg = blockIdx.x;
    for (int u = F.tid; u < (LDS_BYTES - LDSCTL_OFF) / 4; u += NTHR) ((LAS unsigned*)(F.lds + LDSCTL_OFF))[u] = 0u;
    __syncthreads();
    const int ph_lo = F.ka->ph_lo, ph_hi = F.ka->ph_hi;
    const int wave0 = F.wave;
#if MK_ONE_LAUNCH
    { const Ptrs Q = get_ptrs(F); (void)xcd_barrier_post(Q.ctl() + CW_BAR, (volatile LAS unsigned*)(F.lds + MISC_OFF) + 8); }
#endif
    if (PHASE_IN(0)) { refresh_ids(F, wave0); ph_prologue(F);
#if MK_ONE_LAUNCH
        if (1 < ph_hi) { __threadfence(); cg::this_grid().sync(); __builtin_amdgcn_fence(__ATOMIC_ACQUIRE, "agent"); asm volatile("s_waitcnt vmcnt(0)" ::: "memory"); __syncthreads(); }
#else
        PHASE_END(0);
#endif
    }
    run_layer<0>(F, wave0, ph_lo, ph_hi);
    run_layer<1>(F, wave0, ph_lo, ph_hi);
}

extern "C" void kernel_launch(void* const* d_in, const int* in_sizes, int n_in, void* d_out, int out_size, void* d_ws, size_t ws_size, hipStream_t stream) {
    static int grid = 0;
    if (grid == 0) {
        if (n_in != 22 || in_sizes[0] != TOK * DM || out_size != TOK * DM || ws_size < WS_END) {
            fprintf(stderr, "kernel_launch: unexpected shapes (n_in %d, in0 %d, out %d, ws %zu); nothing launched\n", n_in, n_in > 0 ? in_sizes[0] : -1, out_size, ws_size); grid = -1; return; }
        int dev = 0, cus = 0, per_cu = 0;
        if (hipGetDevice(&dev) != hipSuccess || hipDeviceGetAttribute(&cus, hipDeviceAttributeMultiprocessorCount, dev) != hipSuccess) { grid = -1; return; }
        if (hipFuncSetAttribute((const void*)fwd_kernel, hipFuncAttributeMaxDynamicSharedMemorySize, LDS_BYTES) != hipSuccess) { fprintf(stderr, "kernel_launch: hipFuncSetAttribute failed\n"); grid = -1; return; }
        if (hipOccupancyMaxActiveBlocksPerMultiprocessor(&per_cu, (const void*)fwd_kernel, NTHR, LDS_BYTES) != hipSuccess || per_cu < 1) { fprintf(stderr, "kernel_launch: occupancy query says %d blocks per CU\n", per_cu); (void)hipGetLastError(); grid = -1; return; }
        grid = cus;
    }
    if (grid < 0) return;
    (void)hipMemsetAsync((char*)d_ws + WS_CTL, 0, CTL_ZERO_BYTES, stream);
    Args a{};
    for (int i = 0; i < 22; ++i) a.in[i] = (const float*)d_in[i];
    a.out = (float*)d_out; a.ws = (unsigned char*)d_ws;
#if MK_ONE_LAUNCH
    a.ph_lo = 0; a.ph_hi = NPH;
    void* kargs[] = {&a};
    hipError_t e = hipLaunchCooperativeKernel((const void*)fwd_kernel, dim3(grid), dim3(NTHR), kargs, LDS_BYTES, stream);
    if (e != hipSuccess) fprintf(stderr, "cooperative launch failed: %s (grid %d)\n", hipGetErrorString(e), grid);
#else
    for (int ph = 0; ph < NPH; ++ph) { a.ph_lo = ph; a.ph_hi = ph + 1; hipLaunchKernelGGL(fwd_kernel, dim3(grid), dim3(NTHR), LDS_BYTES, stream, a); }
#endif
}
```

```cpp
#include <hip/hip_runtime.h>
#include <hip/hip_cooperative_groups.h>
#include <cstdio>
#include <cstdint>
namespace cg = cooperative_groups;

#ifndef MK_ONE_LAUNCH
#define MK_ONE_LAUNCH 1
#endif

#define DI __device__ __forceinline__
#define GAS __attribute__((address_space(1)))
#define LAS __attribute__((address_space(3)))
typedef unsigned short bf16;
typedef float f32x4 __attribute__((ext_vector_type(4)));
typedef float f32x2 __attribute__((ext_vector_type(2)));
typedef unsigned u32x4 __attribute__((ext_vector_type(4)));
typedef unsigned u32x2 __attribute__((ext_vector_type(2)));
typedef short bf16x8 __attribute__((ext_vector_type(8)));

constexpr int BATCH = 2, SEQ = 16384, DM = 1024, TOK = BATCH * SEQ, DEPTH = 2;
constexpr int DIN = 2944, DINP = 3072;
constexpr int C_QA = 0, C_KA = 384, C_VA = 768, C_QR = 1152, C_KR = 1536, C_VR = 1920, C_GR = 2304, C_US = 2688;
constexpr int NH = 6, HD = 64, NKB = 64, KBLK = 256;
constexpr int NE = 16, DFF = 512, LCAP = TOK;
constexpr int MAXBLK = 288;
constexpr float ALPHA = 1.41421356237309505f;
constexpr float LN_EPS = 1e-5f, GN_EPS = 1e-6f;
constexpr int NWAVES = 8, NTHR = 512;

constexpr size_t MiB = 1u << 20;
constexpr size_t WS_CTL = 0, CTL_ZERO_BYTES = 1 * MiB;
constexpr size_t WS_SMALL = 1 * MiB;
constexpr size_t WS_WIN = 5 * MiB;
constexpr size_t WS_WOUT = 17 * MiB;
constexpr size_t WS_WGU = 21 * MiB;
constexpr size_t WS_WD = 85 * MiB;
constexpr size_t WS_XB = 117 * MiB;
constexpr size_t WS_X1B = 181 * MiB;
constexpr size_t WS_PROJ = 245 * MiB;
constexpr size_t WS_H = WS_PROJ, WS_YM0 = WS_PROJ + 68 * MiB;
constexpr size_t WS_YMIX = 437 * MiB;
constexpr size_t WS_YM1 = WS_YMIX;
constexpr size_t WS_LTOK = 501 * MiB;
constexpr size_t WS_LW = 503 * MiB;
constexpr size_t WS_END = 505 * MiB;
constexpr int SSMP_FLOATS = 36864;
constexpr size_t SM_SSMP = 0;
constexpr size_t SM_KMEAN = 2 * SSMP_FLOATS * 4;
constexpr size_t DO_RETKV = 0;
constexpr size_t DO_S5E = 24 * MiB;
constexpr size_t DO_MPO = 26 * MiB;
constexpr size_t X1_YG = 0;
constexpr size_t X1_MLIST = 32 * MiB;
constexpr size_t X1_MML = 44 * MiB;
constexpr int MLIST_PER_BH = 516096;
constexpr int CW_BAR = 4096;
constexpr int CW_ECNT = 1024;
constexpr int CW_MCNT = 8192;
constexpr int RING_BYTES = 131072, LDSCTL_OFF = RING_BYTES, MISC_OFF = LDSCTL_OFF + 320, MOE_TAB_OFF = LDSCTL_OFF + 1024;
constexpr int LDS_BYTES = 147456;

DI float bf2f(unsigned short v) { return __uint_as_float((unsigned)v << 16); }
DI unsigned f2bf(float f) { unsigned u = __float_as_uint(f); return (u + 0x7fffu + ((u >> 16) & 1u)) >> 16; }
DI unsigned pk2(float lo, float hi) { return f2bf(lo) | (f2bf(hi) << 16); }
DI void unpack8(const u32x4 v, float* o) {
    o[0] = __uint_as_float(v.x << 16); o[1] = __uint_as_float(v.x & 0xffff0000u); o[2] = __uint_as_float(v.y << 16); o[3] = __uint_as_float(v.y & 0xffff0000u);
    o[4] = __uint_as_float(v.z << 16); o[5] = __uint_as_float(v.z & 0xffff0000u); o[6] = __uint_as_float(v.w << 16); o[7] = __uint_as_float(v.w & 0xffff0000u);
}
DI void sincos_acc(float a, float& sn, float& cs) {
    const double ad = (double)a; const double kd = rint(ad * 0.63661977236758134308); const int k = (int)kd;
    const float r = (float)(ad - kd * 1.57079632679489661923), z = r * r;
    const float sp = r + r * z * (-1.6666667163e-01f + z * (8.3333337680e-03f + z * (-1.9841270114e-04f + z * (2.7557314297e-06f + z * (-2.5050759689e-08f)))));
    const float cp = 1.0f - 0.5f * z + z * z * (4.1666667908e-02f + z * (-1.3888889225e-03f + z * (2.4801587642e-05f + z * (-2.7557314297e-07f + z * (2.0875723372e-09f)))));
    const int q = k & 3;
    sn = q == 0 ? sp : q == 1 ? cp : q == 2 ? -sp : -cp;
    cs = q == 0 ? cp : q == 1 ? -sp : q == 2 ? -cp : sp;
}
DI int fresh_lane() { unsigned z_ = 0u; asm volatile("" : "+v"(z_)); return (int)__builtin_amdgcn_mbcnt_hi(~0u, __builtin_amdgcn_mbcnt_lo(~0u, z_)); }
DI float xor32_max(float v) { const auto rr = __builtin_amdgcn_permlane32_swap(__float_as_uint(v), __float_as_uint(v), false, false); return fmaxf(__uint_as_float(rr[0]), __uint_as_float(rr[1])); }
DI float xor32_sum(float v) { const auto rr = __builtin_amdgcn_permlane32_swap(__float_as_uint(v), __float_as_uint(v), false, false); return __uint_as_float(rr[0]) + __uint_as_float(rr[1]); }
DI float shfl_xor_f(float v, int mask, int lane) { return __uint_as_float((unsigned)__builtin_amdgcn_ds_bpermute((lane ^ mask) << 2, (int)__float_as_uint(v))); }
DI float wave_sum(float v, int lane) {
#pragma unroll
    for (int o = 1; o < 64; o <<= 1) v += shfl_xor_f(v, o, lane);
    return v;
}
DI float ret_log2g(int h) {
    return h == 0 ? -0.04580368961312479f : h == 1 ? -0.02272007650008353f : h == 2 ? -0.011315313227834146f : h == 3 ? -0.005646563141142063f : h == 4 ? -0.0028205190623786626f : -0.0014095702546713536f;
}
DI float alibi_slope(int h) {
    return h == 0 ? 0.3968502629920499f : h == 1 ? 0.15749013123685915f : h == 2 ? 0.0625f : h == 3 ? 0.024803141437003122f : h == 4 ? 0.009843133202303695f : 0.00390625f;
}

namespace pg8 {
#define PG8_LAS __attribute__((address_space(3)))
typedef unsigned short bf16_t;
constexpr int BM = 256, BK = 64, HALF = 128, HTB = HALF * BK * 2, STAGE_BYTES = 8 * HTB, NXCD = 8, WGM = 8;
__host__ __device__ __forceinline__ int lds_byte(int r, int c) { const int st = (r >> 4) * 2 + (c >> 5), rr = r & 15, cc = c & 31, ob = rr * 64 + cc * 2; return st * 1024 + (ob ^ (((ob >> 9) & 1) << 5)); }
__host__ __device__ __forceinline__ void stage_rc(int b, int& R, int& C) { const int st = b / 1024, sb = b % 1024, swz = sb ^ (((sb >> 9) & 1) << 5); R = (st >> 1) * 16 + swz / 64; C = (st & 1) * 32 + (swz % 64) / 2; }
__host__ __device__ __forceinline__ int perm32(int rho) { const int n = rho >> 4, i = rho & 15; return 8 * (i >> 2) + 4 * n + (i & 3); }

struct Unit { int pm, pn, e, jb; };

template <class Epi, class Sched, bool ALIGN_EPI>
__device__ __forceinline__ void gemm_phase(PG8_LAS unsigned char* lds, const int tid, const int K, const Sched& S, const Epi& E) {
    const int wid = __builtin_amdgcn_readfirstlane(tid >> 6), lane = tid & 63, wr = wid >> 2, wc = wid & 3, fr = lane & 15, fq = lane >> 4;
    const int nt = K / BK;
    unsigned voffB[2];
#pragma unroll
    for (int i = 0; i < 2; ++i) { int R, C; stage_rc(tid * 16 + i * 8192, R, C); const int Rb = Epi::PERM ? ((R & ~31) + perm32(R & 31)) : R; voffB[i] = (unsigned)(Rb * K + C) * 2u; }
    const size_t kstep = (size_t)(BK * 2);
    const size_t hstep = (size_t)HALF * K * 2;
    const unsigned ldsw = (unsigned)wid * 1024u;
    const int aoff = lds_byte(wr * 64 + fr, fq * 8), boff = lds_byte(wc * 32 + fr, fq * 8);
#define PG8_SA(b, h) (((b) * 2 + (h)) * HTB)
#define PG8_SB(b, h) ((4 + (b) * 2 + (h)) * HTB)
#define PG8_STAGE(bufoff, gbase, voff) do { _Pragma("unroll") for (int _i = 0; _i < 2; ++_i) \
        __builtin_amdgcn_global_load_lds((const unsigned*)((const char*)(gbase) + (voff)[_i]), (PG8_LAS unsigned*)(lds + (bufoff) + ldsw + _i * 8192), 16, 0, 0); } while (0)
#define PG8_LDA(dst, b, h) do { _Pragma("unroll") for (int m = 0; m < 4; ++m) _Pragma("unroll") for (int k = 0; k < 2; ++k) dst[m][k] = *(const PG8_LAS bf16x8*)(lds + PG8_SA(b, h) + aoff + m * 2048 + k * 1024); } while (0)
#define PG8_LDB(dst, b, h) do { _Pragma("unroll") for (int n = 0; n < 2; ++n) _Pragma("unroll") for (int k = 0; k < 2; ++k) dst[n][k] = *(const PG8_LAS bf16x8*)(lds + PG8_SB(b, h) + boff + n * 2048 + k * 1024); } while (0)
#define PG8_MMA(ai, bj, At, Bt) do { __builtin_amdgcn_s_setprio(1); _Pragma("unroll") for (int m = 0; m < 4; ++m) _Pragma("unroll") for (int n = 0; n < 2; ++n) _Pragma("unroll") for (int k = 0; k < 2; ++k) \
        acc[ai][bj][m][n] = __builtin_amdgcn_mfma_f32_16x16x32_bf16(Bt[n][k], At[m][k], acc[ai][bj][m][n], 0, 0, 0); __builtin_amdgcn_s_setprio(0); } while (0)
#define PG8_WAIT_V(n) asm volatile("s_waitcnt vmcnt(" #n ")" ::: "memory")
#define PG8_WAIT_L(n) asm volatile("s_waitcnt lgkmcnt(" #n ")" ::: "memory")
#define PG8_BAR __builtin_amdgcn_s_barrier()
#define PG8_SCHED __builtin_amdgcn_sched_barrier(0)
    Unit cur, nxt; int ui = 0;
    if (!S.next(0, cur)) return;
    f32x4 acc[2][2][4][2];
#pragma unroll
    for (int a = 0; a < 2; ++a)
#pragma unroll
        for (int b = 0; b < 2; ++b)
#pragma unroll
            for (int m = 0; m < 4; ++m)
#pragma unroll
                for (int n = 0; n < 2; ++n) acc[a][b][m][n] = (f32x4){0.f, 0.f, 0.f, 0.f};
    bf16x8 At[4][2], B0[2][2], B1[2][2];
    const char* cA; const char* cB; unsigned vA[2][2];
    S.addr(cur, tid, cA, vA, cB);
    PG8_STAGE(PG8_SB(0, 0), cB, voffB); PG8_STAGE(PG8_SB(0, 1), cB + hstep, voffB); PG8_STAGE(PG8_SA(0, 0), cA, vA[0]); PG8_STAGE(PG8_SA(0, 1), cA, vA[1]);
    if (wr == 1) PG8_BAR;
    PG8_WAIT_V(2); PG8_BAR;
    PG8_STAGE(PG8_SB(1, 0), cB + kstep, voffB); PG8_STAGE(PG8_SA(1, 0), cA + kstep, vA[0]); PG8_STAGE(PG8_SB(1, 1), cB + hstep + kstep, voffB);
    PG8_WAIT_V(6); PG8_BAR;
    for (;;) {
        const bool has_next = S.next(ui + 1, nxt);
        const char* nA = cA; const char* nB = cB; unsigned nvA[2][2] = {{vA[0][0], vA[0][1]}, {vA[1][0], vA[1][1]}};
        if (has_next) { if constexpr (Sched::A_VARIES) S.addr(nxt, tid, nA, nvA, nB); else { unsigned dummy[2][2]; S.addr(nxt, tid, nA, dummy, nB); } }
        for (int t = 0; t < nt; t += 2) {
            const bool last = (t == nt - 2);
            const char* a1 = cA + (size_t)(t + 1) * kstep;
            const char* a2 = last ? nA : cA + (size_t)(t + 2) * kstep; const char* b2 = last ? nB : cB + (size_t)(t + 2) * kstep;
            const char* a3 = a2 + kstep; const char* b3 = b2 + kstep;
            unsigned xA0[2], xA1[2];
            if constexpr (Sched::A_VARIES) { xA0[0] = last ? nvA[0][0] : vA[0][0]; xA0[1] = last ? nvA[0][1] : vA[0][1]; xA1[0] = last ? nvA[1][0] : vA[1][0]; xA1[1] = last ? nvA[1][1] : vA[1][1]; }
            else { xA0[0] = vA[0][0]; xA0[1] = vA[0][1]; xA1[0] = vA[1][0]; xA1[1] = vA[1][1]; }
            PG8_LDB(B0, 0, 0); PG8_LDB(B1, 0, 1); PG8_SCHED; PG8_LDA(At, 0, 0); PG8_STAGE(PG8_SA(1, 1), a1, vA[1]);
            PG8_WAIT_V(8); PG8_WAIT_L(0); PG8_BAR; PG8_MMA(0, 0, At, B0); PG8_MMA(0, 1, At, B1); PG8_BAR; PG8_SCHED;
            PG8_LDA(At, 0, 1); PG8_STAGE(PG8_SB(0, 0), b2, voffB); PG8_STAGE(PG8_SB(0, 1), b2 + hstep, voffB); PG8_STAGE(PG8_SA(0, 0), a2, xA0);
            PG8_WAIT_V(8); PG8_WAIT_L(0); PG8_BAR; PG8_MMA(1, 0, At, B0); PG8_MMA(1, 1, At, B1); PG8_BAR; PG8_SCHED;
            PG8_LDB(B0, 1, 0); PG8_LDB(B1, 1, 1); PG8_SCHED; PG8_LDA(At, 1, 0); PG8_STAGE(PG8_SA(0, 1), a2, xA1);
            PG8_WAIT_V(8); PG8_WAIT_L(0); PG8_BAR; PG8_MMA(0, 0, At, B0); PG8_MMA(0, 1, At, B1); PG8_BAR; PG8_SCHED;
            PG8_LDA(At, 1, 1); PG8_STAGE(PG8_SB(1, 0), b3, voffB); PG8_STAGE(PG8_SB(1, 1), b3 + hstep, voffB); PG8_STAGE(PG8_SA(1, 0), a3, xA0);
            PG8_WAIT_V(8); PG8_WAIT_L(0); PG8_BAR; PG8_MMA(1, 0, At, B0); PG8_MMA(1, 1, At, B1); PG8_BAR; PG8_SCHED;
        }
        if constexpr (ALIGN_EPI) { if (wr == 0) PG8_BAR; }
        E(acc, cur, wr, wc, fr, fq);
        if (!has_next) break;
#pragma unroll
        for (int a = 0; a < 2; ++a)
#pragma unroll
            for (int b = 0; b < 2; ++b)
#pragma unroll
                for (int m = 0; m < 4; ++m)
#pragma unroll
                    for (int n = 0; n < 2; ++n) acc[a][b][m][n] = (f32x4){0.f, 0.f, 0.f, 0.f};
        cur = nxt; cA = nA; cB = nB; if constexpr (Sched::A_VARIES) { vA[0][0] = nvA[0][0]; vA[0][1] = nvA[0][1]; vA[1][0] = nvA[1][0]; vA[1][1] = nvA[1][1]; } ++ui;
        if constexpr (ALIGN_EPI) { if (wr == 1) PG8_BAR; }
    }
    PG8_WAIT_V(0);
    if constexpr (!ALIGN_EPI) { if (wr == 0) PG8_BAR; }
    PG8_BAR;
#undef PG8_SA
#undef PG8_SB
#undef PG8_STAGE
#undef PG8_LDA
#undef PG8_LDB
#undef PG8_MMA
#undef PG8_WAIT_V
#undef PG8_WAIT_L
#undef PG8_BAR
#undef PG8_SCHED
}

struct DenseSched {
    static constexpr bool A_VARIES = false;
    const bf16_t* A; const bf16_t* Bt; int K; int nM, nN, nwg, G, c;
    __device__ void init(const bf16_t* A_, const bf16_t* Bt_, int M, int N, int K_, int G_, int c_) { A = A_; Bt = Bt_; K = K_; nM = M / BM; nN = N / BM; nwg = nM * nN; G = G_; c = c_; }
    __device__ __forceinline__ bool next(int i, Unit& u) const {
        const long L = (long)i * G + c; if (L >= nwg) return false;
        int wgid = (int)L; { const int q = nwg / NXCD, r = nwg % NXCD, xcd = wgid % NXCD, off = wgid / NXCD; wgid = (xcd < r ? xcd * (q + 1) : r * (q + 1) + (xcd - r) * q) + off; }
        const int nig = WGM * nN, gid = wgid / nig, fm = gid * WGM, gsz = (nM - fm) < WGM ? (nM - fm) : WGM;
        u.pm = __builtin_amdgcn_readfirstlane(fm + ((wgid % nig) % gsz)); u.pn = __builtin_amdgcn_readfirstlane((wgid % nig) / gsz); u.e = 0; u.jb = 0; return true;
    }
    __device__ __forceinline__ void addr(const Unit& u, int tid, const char*& a, unsigned (&vA)[2][2], const char*& b) const {
        asm volatile("" : "+v"(tid));
        a = (const char*)A + (size_t)u.pm * BM * K * 2; b = (const char*)Bt + (size_t)u.pn * BM * K * 2;
#pragma unroll
        for (int i = 0; i < 2; ++i) { int R, C; stage_rc(tid * 16 + i * 8192, R, C);
#pragma unroll
            for (int h = 0; h < 2; ++h) vA[h][i] = (unsigned)((h * HALF + R) * K + C) * 2u; }
    }
};
struct MoeUpSched {
    static constexpr bool A_VARIES = true;
    const bf16_t* X; const bf16_t* W; const unsigned* ltok; const PG8_LAS int* tab; int G, c;
    __device__ __forceinline__ bool next(int i, Unit& u) const {
        const int id = i * G + c; const int nb = __builtin_amdgcn_readfirstlane(tab[32]); if (id >= nb * 4) return false;
        const int blk = id >> 2; u.pm = blk; u.pn = id & 3; u.e = __builtin_amdgcn_readfirstlane(tab[64 + blk]); u.jb = blk - __builtin_amdgcn_readfirstlane(tab[16 + u.e]); return true;
    }
    __device__ __forceinline__ void addr(const Unit& u, int tid, const char*& a, unsigned (&vA)[2][2], const char*& b) const {
        asm volatile("" : "+v"(tid));
        a = (const char*)X; b = (const char*)W + ((size_t)u.e * 1024 + (size_t)u.pn * BM) * 1024 * 2;
        const int cnt = __builtin_amdgcn_readfirstlane(tab[u.e]); const unsigned* lt = ltok + (size_t)u.e * LCAP + u.jb * 256;
#pragma unroll
        for (int i = 0; i < 2; ++i) { int R, C; stage_rc(tid * 16 + i * 8192, R, C);
#pragma unroll
            for (int h = 0; h < 2; ++h) { const int r = h * HALF + R; const bool ok = (u.jb * 256 + r) < cnt; const unsigned tk = ok ? (lt[r] & 0x7fffffffu) : 0u; vA[h][i] = (tk * 1024u + (unsigned)C) * 2u; } }
    }
};
struct MoeDownSched {
    static constexpr bool A_VARIES = false;
    const bf16_t* Hb; const bf16_t* W; const PG8_LAS int* tab; int G, c;
    __device__ __forceinline__ bool next(int i, Unit& u) const {
        const int id = i * G + c; const int nb = __builtin_amdgcn_readfirstlane(tab[32]); if (id >= nb * 4) return false;
        const int blk = id >> 2; u.pm = blk; u.pn = id & 3; u.e = __builtin_amdgcn_readfirstlane(tab[64 + blk]); u.jb = blk - __builtin_amdgcn_readfirstlane(tab[16 + u.e]); return true;
    }
    __device__ __forceinline__ void addr(const Unit& u, int tid, const char*& a, unsigned (&vA)[2][2], const char*& b) const {
        asm volatile("" : "+v"(tid));
        a = (const char*)Hb + (size_t)u.pm * BM * DFF * 2; b = (const char*)W + ((size_t)u.e * 1024 + (size_t)u.pn * BM) * DFF * 2;
#pragma unroll
        for (int i = 0; i < 2; ++i) { int R, C; stage_rc(tid * 16 + i * 8192, R, C);
#pragma unroll
            for (int h = 0; h < 2; ++h) vA[h][i] = (unsigned)((h * HALF + R) * DFF + C) * 2u; }
    }
};

struct EpiBf16 {
    static constexpr bool PERM = true;
    bf16_t* O; int ldc;
    __device__ __forceinline__ void operator()(const f32x4 (&acc)[2][2][4][2], const Unit& u, int wr, int wc, int fr, int fq) const {
        asm volatile("" : "+v"(fr), "+v"(fq));
        const int row0 = u.pm * BM + wr * 64 + fr; const int col0 = u.pn * BM + wc * 32 + 8 * fq;
#pragma unroll
        for (int ai = 0; ai < 2; ++ai)
#pragma unroll
            for (int m = 0; m < 4; ++m) { bf16_t* rowp = O + (size_t)(row0 + ai * HALF + m * 16) * ldc + col0;
#pragma unroll
                for (int bj = 0; bj < 2; ++bj) { const f32x4 v0 = acc[ai][bj][m][0], v1 = acc[ai][bj][m][1];
                    u32x4 w; w.x = pk2(v0[0], v0[1]); w.y = pk2(v0[2], v0[3]); w.z = pk2(v1[0], v1[1]); w.w = pk2(v1[2], v1[3]);
                    *(u32x4*)(rowp + bj * HALF) = w; } }
    }
};
struct EpiResF32 {
    static constexpr bool PERM = false;
    float* V; const bf16_t* XBp;
    __device__ __forceinline__ void operator()(const f32x4 (&acc)[2][2][4][2], const Unit& u, int wr, int wc, int fr, int fq) const {
        asm volatile("" : "+v"(fr), "+v"(fq));
        const int row0 = u.pm * BM + wr * 64 + fr; const int col0 = u.pn * BM + wc * 32 + 4 * fq;
#pragma unroll
        for (int ai = 0; ai < 2; ++ai)
#pragma unroll
            for (int m = 0; m < 4; ++m) { const size_t off = (size_t)(row0 + ai * HALF + m * 16) * DM + col0;
#pragma unroll
                for (int bj = 0; bj < 2; ++bj)
#pragma unroll
                    for (int n = 0; n < 2; ++n) { const u32x2 xb = *(const u32x2*)(XBp + off + bj * HALF + n * 16); const f32x4 a = acc[ai][bj][m][n];
                        f32x4 o; o[0] = ALPHA * __uint_as_float(xb.x << 16) + a[0]; o[1] = ALPHA * __uint_as_float(xb.x & 0xffff0000u) + a[1];
                        o[2] = ALPHA * __uint_as_float(xb.y << 16) + a[2]; o[3] = ALPHA * __uint_as_float(xb.y & 0xffff0000u) + a[3];
                        *(f32x4*)(V + off + bj * HALF + n * 16) = o; } }
    }
};
__device__ __forceinline__ float silu_f(float x) { return x * __builtin_amdgcn_rcpf(1.0f + __builtin_amdgcn_exp2f(-1.4426950408889634f * x)); }
struct EpiSwiGLU {
    static constexpr bool PERM = true;
    bf16_t* Hb;
    __device__ __forceinline__ void operator()(const f32x4 (&acc)[2][2][4][2], const Unit& u, int wr, int wc, int fr, int fq) const {
        asm volatile("" : "+v"(fr), "+v"(fq));
        const int row0 = u.pm * BM + wr * 64 + fr; const int col0 = u.pn * HALF + wc * 32 + 8 * fq;
#pragma unroll
        for (int ai = 0; ai < 2; ++ai)
#pragma unroll
            for (int m = 0; m < 4; ++m) { bf16_t* p = Hb + (size_t)(row0 + ai * HALF + m * 16) * DFF + col0;
                const f32x4 g0 = acc[ai][0][m][0], g1 = acc[ai][0][m][1], u0 = acc[ai][1][m][0], u1 = acc[ai][1][m][1];
                u32x4 w; w.x = pk2(silu_f(g0[0]) * u0[0], silu_f(g0[1]) * u0[1]); w.y = pk2(silu_f(g0[2]) * u0[2], silu_f(g0[3]) * u0[3]);
                w.z = pk2(silu_f(g1[0]) * u1[0], silu_f(g1[1]) * u1[1]); w.w = pk2(silu_f(g1[2]) * u1[2], silu_f(g1[3]) * u1[3]);
                *(u32x4*)p = w; }
    }
};
struct EpiMoeScatter {
    static constexpr bool PERM = true;
    bf16_t* YM0; bf16_t* YM1; const unsigned* ltok; const float* lw; const PG8_LAS int* tab;
    __device__ __forceinline__ void operator()(const f32x4 (&acc)[2][2][4][2], const Unit& u, int wr, int wc, int fr, int fq) const {
        asm volatile("" : "+v"(fr), "+v"(fq));
        const int cnt = __builtin_amdgcn_readfirstlane(tab[u.e]); const int col0 = u.pn * BM + wc * 32 + 8 * fq;
        const size_t lbase = (size_t)u.e * LCAP + (size_t)u.jb * 256;
#pragma unroll
        for (int ai = 0; ai < 2; ++ai)
#pragma unroll
            for (int m = 0; m < 4; ++m) { const int r = ai * HALF + wr * 64 + m * 16 + fr;
                if (u.jb * 256 + r < cnt) {
                    const unsigned tk = ltok[lbase + r]; const float w = lw[lbase + r];
                    bf16_t* p = ((tk >> 31) ? YM1 : YM0) + (size_t)(tk & 0x7fffffffu) * DM + col0;
#pragma unroll
                    for (int bj = 0; bj < 2; ++bj) { const f32x4 v0 = acc[ai][bj][m][0], v1 = acc[ai][bj][m][1];
                        u32x4 o; o.x = pk2(w * v0[0], w * v0[1]); o.y = pk2(w * v0[2], w * v0[3]); o.z = pk2(w * v1[0], w * v1[1]); o.w = pk2(w * v1[2], w * v1[3]);
                        *(u32x4*)(p + bj * HALF) = o; } } }
    }
};
}

#define XB_TMO      128
#define XB_XCNT(j)  (256  + 64 * (j))
#define XB_XSUB(j)  (1280 + 64 * (j))
#define XB_XGEN(j)  (2304 + 64 * (j))
#define XB_TOP      3328
#define XB_TOPGEN   3392
#define XCD_BAR_WORDS 3456
#define XB_SPIN_CAP (1u << 22)
DI unsigned xb_ld(unsigned* p)              { return __hip_atomic_load(p, __ATOMIC_RELAXED, __HIP_MEMORY_SCOPE_AGENT); }
DI unsigned xb_add(unsigned* p, unsigned v) { return __hip_atomic_fetch_add(p, v, __ATOMIC_RELAXED, __HIP_MEMORY_SCOPE_AGENT); }
DI unsigned xb_xcc_id() { return (unsigned)__builtin_amdgcn_s_getreg((3 << 11) | 20) & 0xFu; }
#define XB_SPIN(cond, bar) do { unsigned _sp = 0; while (cond) { __builtin_amdgcn_s_sleep(1); \
    if ((++_sp & 255u) == 0u) { if (xb_ld(&(bar)[XB_TMO])) break; if (_sp > XB_SPIN_CAP) { atomicAdd(&(bar)[XB_TMO], 1u); break; } } } } while (0)
struct XcdBarrier { unsigned* bar; unsigned x; volatile LAS unsigned* st; };
DI XcdBarrier xcd_barrier_post(unsigned* bar, volatile LAS unsigned* st) {
    XcdBarrier b; b.bar = bar; b.x = xb_xcc_id(); b.st = st;
    if (threadIdx.x == 0) (void)xb_add(&bar[XB_XCNT(b.x)], 1u);
    return b;
}
DI void xcd_barrier_complete(unsigned* bar, unsigned x, unsigned& nloc, unsigned& nx) {
    const unsigned G = gridDim.x * gridDim.y * gridDim.z;
    unsigned sum, cnt, mine, sp = 0u;
    for (;;) {
        sum = 0u; cnt = 0u; mine = 0u;
#pragma unroll
        for (unsigned j = 0; j < 16; ++j) { const unsigned c = xb_ld(&bar[XB_XCNT(j)]); sum += c; cnt += (c > 0u) ? 1u : 0u; mine = (j == x) ? c : mine; }
        if (sum == G) break;
        __builtin_amdgcn_s_sleep(1);
        if ((++sp & 255u) == 0u) { if (xb_ld(&bar[XB_TMO])) break; if (sp > XB_SPIN_CAP) { atomicAdd(&bar[XB_TMO], 1u); break; } }
    }
    nloc = mine > 0u ? mine : 1u; nx = cnt > 0u ? cnt : 1u;
}
DI void xcd_barrier(const XcdBarrier& b) {
    asm volatile("s_waitcnt vmcnt(0)" ::: "memory");
    __syncthreads();
    if (threadIdx.x == 0) {
        unsigned* bar = b.bar;
        __builtin_amdgcn_s_waitcnt(0);
        unsigned nloc = b.st[0], nx = b.st[1];
        if (nloc == 0u) { xcd_barrier_complete(bar, b.x, nloc, nx); b.st[0] = nloc; b.st[1] = nx; }
        const unsigned old = xb_add(&bar[XB_XSUB(b.x)], 1u);
        const unsigned gen = old / nloc;
        if (old + 1u == (gen + 1u) * nloc) {
            __builtin_amdgcn_fence(__ATOMIC_RELEASE, "agent");
            asm volatile("s_waitcnt vmcnt(0)" ::: "memory");
            const unsigned og = xb_add(&bar[XB_TOP], 1u);
            const unsigned tg = og / nx;
            if (og + 1u == (tg + 1u) * nx) xb_add(&bar[XB_TOPGEN], 1u);
            else XB_SPIN(xb_ld(&bar[XB_TOPGEN]) == tg, bar);
            __builtin_amdgcn_fence(__ATOMIC_ACQUIRE, "agent");
            xb_add(&bar[XB_XGEN(b.x)], 1u);
            asm volatile("s_waitcnt vmcnt(0)" ::: "memory");
        } else {
            XB_SPIN(xb_ld(&bar[XB_XGEN(b.x)]) == gen, bar);
            __builtin_amdgcn_fence(__ATOMIC_ACQUIRE, "agent");
            asm volatile("s_waitcnt vmcnt(0)" ::: "memory");
        }
    }
    __syncthreads();
}

struct Args { const float* in[22]; float* out; unsigned char* ws; int ph_lo, ph_hi; };
struct Frame {
    LAS unsigned char* lds;
    const Args* ka;
    int tid, lane, wave, wg, G;
};
struct Ptrs {
    const Args* a; unsigned char* ws; float* out;
    DI const float* in(int k) const { return a->in[k]; }
    DI unsigned* ctl() const { return (unsigned*)(ws + WS_CTL); }
    DI bf16* Win_t() const { return (bf16*)(ws + WS_WIN); }
    DI bf16* Wout_t() const { return (bf16*)(ws + WS_WOUT); }
    DI bf16* Wgu_t() const { return (bf16*)(ws + WS_WGU); }
    DI bf16* Wd_t() const { return (bf16*)(ws + WS_WD); }
    DI bf16* XB() const { return (bf16*)(ws + WS_XB); }
    DI bf16* X1B() const { return (bf16*)(ws + WS_X1B); }
    DI bf16* PROJ() const { return (bf16*)(ws + WS_PROJ); }
    DI bf16* YMIX() const { return (bf16*)(ws + WS_YMIX); }
    DI bf16* Hb() const { return (bf16*)(ws + WS_H); }
    DI bf16* YM0() const { return (bf16*)(ws + WS_YM0); }
    DI bf16* YM1() const { return (bf16*)(ws + WS_YM1); }
    DI unsigned* ltok() const { return (unsigned*)(ws + WS_LTOK); }
    DI float* lw() const { return (float*)(ws + WS_LW); }
    DI float* small() const { return (float*)(ws + WS_SMALL); }
    DI float* kmean() const { return (float*)(ws + WS_SMALL + SM_KMEAN); }
    DI float* retkv() const { return (float*)((unsigned char*)out + DO_RETKV); }
    DI float* s5e() const { return (float*)((unsigned char*)out + DO_S5E); }
    DI float* yg() const { return (float*)(ws + WS_X1B + X1_YG); }
    DI unsigned short* mlist() const { return (unsigned short*)(ws + WS_X1B + X1_MLIST); }
    DI float* mml() const { return (float*)(ws + WS_X1B + X1_MML); }
    DI bf16* mpo() const { return (bf16*)((unsigned char*)out + DO_MPO); }
    DI float* V1() const { return out; }
};
DI Ptrs get_ptrs(const Frame& F) { const Args* a = F.ka; asm volatile("" : "+s"(a)); Ptrs P; P.a = a; P.ws = a->ws; P.out = a->out; return P; }

DI void transpose_item(const float* W, int K, int N, bf16* WT, int dst_row0, LAS float* scr, int k0, int n0, int lane) {
#pragma unroll 8
    for (int i = 0; i < 32; ++i) { const int kk = 2 * i + (lane >> 5); scr[kk * 33 + (lane & 31)] = W[(size_t)(k0 + kk) * N + n0 + (lane & 31)]; }
    asm volatile("s_waitcnt lgkmcnt(0)" ::: "memory");
    const int c = lane & 7;
#pragma unroll
    for (int j = 0; j < 4; ++j) { const int n = (lane >> 3) + 8 * j; const LAS float* s = scr + (8 * c) * 33 + n;
        u32x4 o; o.x = pk2(s[0 * 33], s[1 * 33]); o.y = pk2(s[2 * 33], s[3 * 33]); o.z = pk2(s[4 * 33], s[5 * 33]); o.w = pk2(s[6 * 33], s[7 * 33]);
        *(u32x4*)(WT + (size_t)(dst_row0 + n) * K + k0 + 8 * c) = o; }
    asm volatile("s_waitcnt lgkmcnt(0)" ::: "memory");
}
DI void ph_prologue(Frame& F) {
    const Ptrs Q = get_ptrs(F);
    LAS float* scr = (LAS float*)(F.lds + F.wave * 16384);
    const int gw = F.wg * NWAVES + F.wave, NGW = F.G * NWAVES;
    constexpr int I_IN = 16 * 92;
    constexpr int I_OUT = 16 * 32;
    constexpr int I_G = 16 * 16;
    constexpr int I_D = 8 * 32;
    constexpr int N_IN = 2 * I_IN, N_OUT = 2 * I_OUT, N_G = 2 * 16 * I_G, N_D = 2 * 16 * I_D;
    constexpr int NITEMS = N_IN + N_OUT + 2 * N_G + N_D;
    for (int it = gw; it < NITEMS; it += NGW) {
        int r = it;
        if (r < N_IN) { const int l = r / I_IN, q = r % I_IN, kb = q / 92, nb = q % 92;
            transpose_item(Q.in(1) + (size_t)l * DM * DIN, DM, DIN, Q.Win_t() + (size_t)l * DINP * DM, 32 * nb, scr, 64 * kb, 32 * nb, F.lane); continue; }
        r -= N_IN;
        if (r < N_OUT) { const int l = r / I_OUT, q = r % I_OUT, kb = q / 32, nb = q % 32;
            transpose_item(Q.in(2) + (size_t)l * DM * DM, DM, DM, Q.Wout_t() + (size_t)l * DM * DM, 32 * nb, scr, 64 * kb, 32 * nb, F.lane); continue; }
        r -= N_OUT;
        if (r < 2 * N_G) { const int s = r / N_G; const int rr = r % N_G; const int le = rr / I_G, q = rr % I_G, kb = q / 16, nb = q % 16; const int n0 = 32 * nb;
            const float* W = (s ? Q.in(20) : Q.in(19)) + (size_t)le * DM * DFF;
            transpose_item(W, DM, DFF, Q.Wgu_t() + (size_t)le * 1024 * 1024, 256 * (n0 >> 7) + 128 * s + (n0 & 127), scr, 64 * kb, n0, F.lane); continue; }
        r -= 2 * N_G;
        { const int le = r / I_D, q = r % I_D, kb = q / 32, nb = q % 32;
            transpose_item(Q.in(21) + (size_t)le * DFF * DM, DFF, DM, Q.Wd_t() + (size_t)le * 1024 * DFF, 32 * nb, scr, 64 * kb, 32 * nb, F.lane); }
    }
    const int gt = F.wg * NTHR + F.tid, NGT = F.G * NTHR;
    for (int i = gt; i < 2 * 128 * DM / 8; i += NGT) { const int l = i / (128 * DM / 8), q = i % (128 * DM / 8);
        *(u32x4*)(Q.Win_t() + (size_t)l * DINP * DM + (size_t)DIN * DM + (size_t)q * 8) = (u32x4){0u, 0u, 0u, 0u}; }
    for (int i = gt; i < TOK * DM / 8; i += NGT) { const f32x4 a = *(const f32x4*)(Q.in(0) + (size_t)i * 8), b = *(const f32x4*)(Q.in(0) + (size_t)i * 8 + 4);
        u32x4 o; o.x = pk2(a[0], a[1]); o.y = pk2(a[2], a[3]); o.z = pk2(b[0], b[1]); o.w = pk2(b[2], b[3]); *(u32x4*)(Q.XB() + (size_t)i * 8) = o; }
    for (int i = gt; i < 2 * 1024; i += NGT) { const int l = i >> 10, gn = i & 1023, g = gn >> 6;
        float* P = Q.small() + (size_t)l * SSMP_FLOATS;
        const float lr = fminf(Q.in(3)[l * 1024 + gn], -1e-4f), li = Q.in(4)[l * 1024 + gn], dt = expf(Q.in(5)[l * 16 + g]);
        float sn_, cs_; sincos_acc(li * dt, sn_, cs_);
        const float mag = expf(lr * dt), ar = mag * cs_, ai = mag * sn_;
        const float den = lr * lr + li * li, zr = ar - 1.0f, zi = ai;
        const float fr = (zr * lr + zi * li) / den, fi = (zi * lr - zr * li) / den;
        P[gn * 2] = ar; P[gn * 2 + 1] = ai;
        float pr = ar, pi = ai;
#pragma unroll
        for (int s = 0; s < 7; ++s) { const float nr = pr * pr - pi * pi, ni = 2.0f * pr * pi; pr = nr; pi = ni; }
        P[2048 + gn * 2] = pr; P[2048 + gn * 2 + 1] = pi;
        for (int c = 0; c < 16; ++c) { const float br = Q.in(6)[(size_t)l * 16384 + gn * 16 + c], bi = Q.in(7)[(size_t)l * 16384 + gn * 16 + c];
            P[4096 + (gn * 16 + c) * 2] = fr * br - fi * bi; P[4096 + (gn * 16 + c) * 2 + 1] = fr * bi + fi * br; } }
}

DI void ph_kmean(Frame& F) {
    const Ptrs Q = get_ptrs(F);
    LAS float* red = (LAS float*)F.lds;
    for (int it = F.wg; it < BATCH * NH * NKB; it += F.G) {
        const int b = it / (NH * NKB), h = (it / NKB) % NH, n = it % NKB;
        const bf16* p = Q.PROJ() + (size_t)(b * SEQ + n * KBLK + F.wave * 32) * DINP + C_KA + h * HD + F.lane;
        float s = 0.f;
        for (int r = 0; r < 32; ++r) s += bf2f(p[(size_t)r * DINP]);
        red[F.wave * 64 + F.lane] = s;
        __syncthreads();
        if (F.tid < 64) { float t = 0.f; for (int w = 0; w < 8; ++w) t += red[w * 64 + F.tid]; Q.kmean()[(size_t)((b * NH + h) * NKB + n) * HD + F.tid] = t * (1.0f / 256.0f); }
        __syncthreads();
    }
}
template <int MODE> DI void load_tile128(Frame& F, const bf16* src, LAS float* dst, float log2g) {
    const int row = F.tid >> 2, c0 = (F.tid & 3) * 16;
    const u32x4 a = *(const u32x4*)(src + (size_t)row * DINP + c0), b = *(const u32x4*)(src + (size_t)row * DINP + c0 + 8);
    float v[16]; unpack8(a, v); unpack8(b, v + 8);
    float sc = 1.0f; if (MODE == 1) sc = 0.125f; if (MODE == 2) sc = 0.125f * exp2f(log2g * (float)(127 - row));
#pragma unroll
    for (int k = 0; k < 16; k += 4) *(LAS f32x4*)(dst + row * 64 + c0 + k) = (f32x4){v[k] * sc, v[k + 1] * sc, v[k + 2] * sc, v[k + 3] * sc};
}
DI void ph_ret_kv(Frame& F) {
    const Ptrs Q = get_ptrs(F);
    LAS float* Ks = (LAS float*)F.lds; LAS float* Vs = Ks + 8192;
    for (int it = F.wg; it < BATCH * 128 * NH; it += F.G) {
        const int b = it / (128 * NH), c = (it / NH) % 128, h = it % NH;
        const float lg = ret_log2g(h);
        const bf16* base = Q.PROJ() + (size_t)(b * SEQ + c * 128) * DINP + h * HD;
        load_tile128<2>(F, base + C_KR, Ks, lg); load_tile128<0>(F, base + C_VR, Vs, lg);
        __syncthreads();
        float* o = Q.retkv() + (size_t)((b * 128 + c) * NH + h) * 4096;
        for (int i = 0; i < 8; ++i) { const int idx = F.tid + 512 * i, dk = idx >> 6, dv = idx & 63; float acc = 0.f;
            for (int j = 0; j < 128; ++j) acc += Ks[j * 64 + dk] * Vs[j * 64 + dv];
            o[idx] = acc; }
        __syncthreads();
    }
}
DI void ph_scans(Frame& F, int l) {
    const Ptrs Q = get_ptrs(F);
    const int gt = F.wg * NTHR + F.tid, NGT = F.G * NTHR;
    for (int i = gt; i < BATCH * NH * 4096; i += NGT) { const int e = i & 4095, h = (i >> 12) % NH, b = i / (NH * 4096);
        const float d128 = exp2f(ret_log2g(h) * 128.0f); float st = 0.f;
        float* p = Q.retkv() + (size_t)(b * 128 * NH + h) * 4096 + e;
        for (int c = 0; c < 128; ++c) { const float t = p[(size_t)c * NH * 4096]; p[(size_t)c * NH * 4096] = st; st = st * d128 + t; } }
    const float* P = Q.small() + (size_t)l * SSMP_FLOATS;
    for (int i = gt; i < BATCH * 16 * 64; i += NGT) { const int n = i & 63, g = (i >> 6) & 15, b = i >> 10;
        const float ar = P[2048 + (g * 64 + n) * 2], ai = P[2048 + (g * 64 + n) * 2 + 1]; float sr = 0.f, si = 0.f;
        float* p = Q.s5e() + ((size_t)((b * 16 + g) * 128) * 64 + n) * 2;
        for (int c = 0; c < 128; ++c) { const float tr = p[(size_t)c * 128], ti = p[(size_t)c * 128 + 1]; p[(size_t)c * 128] = sr; p[(size_t)c * 128 + 1] = si;
            const float nr = ar * sr - ai * si + tr, ni = ar * si + ai * sr + ti; sr = nr; si = ni; } }
}
DI void ph_ret_out(Frame& F) {
    const Ptrs Q = get_ptrs(F);
    LAS float* Ks = (LAS float*)F.lds; LAS float* Vs = Ks + 8192; LAS float* Ps = Vs + 8192;
    for (int it = F.wg; it < BATCH * 128 * NH; it += F.G) {
        const int tid_ = F.wave * 64 + fresh_lane(); const int i = tid_ >> 2, dq = tid_ & 3;
        const int b = it / (128 * NH), c = (it / NH) % 128, h = it % NH;
        const float lg = ret_log2g(h);
        const size_t row0 = (size_t)(b * SEQ + c * 128);
        const bf16* base = Q.PROJ() + row0 * DINP + h * HD;
        load_tile128<1>(F, base + C_KR, Ks, lg); load_tile128<0>(F, base + C_VR, Vs, lg);
        const float* pv = Q.retkv() + (size_t)((b * 128 + c) * NH + h) * 4096;
        for (int k = 0; k < 8; ++k) Ps[F.tid + 512 * k] = pv[F.tid + 512 * k];
        float q[64];
        { const bf16* qp = base + (size_t)i * DINP + C_QR;
#pragma unroll
          for (int k = 0; k < 8; ++k) { const u32x4 a = *(const u32x4*)(qp + 8 * k); unpack8(a, q + 8 * k); } }
        __syncthreads();
        float acc[16];
#pragma unroll
        for (int e = 0; e < 16; ++e) acc[e] = 0.f;
        for (int j = 0; j <= i; ++j) {
            float s = 0.f;
#pragma unroll
            for (int d = 0; d < 64; d += 4) { const f32x4 kk = *(const LAS f32x4*)(Ks + j * 64 + d); s += q[d] * kk[0] + q[d + 1] * kk[1] + q[d + 2] * kk[2] + q[d + 3] * kk[3]; }
            s *= exp2f(lg * (float)(i - j));
#pragma unroll
            for (int e = 0; e < 16; e += 4) { const f32x4 vv = *(const LAS f32x4*)(Vs + j * 64 + dq * 16 + e); acc[e] += s * vv[0]; acc[e + 1] += s * vv[1]; acc[e + 2] += s * vv[2]; acc[e + 3] += s * vv[3]; }
        }
        const float xi = exp2f(lg * (float)(i + 1));
#pragma unroll
        for (int dk = 0; dk < 64; ++dk) { const float qd = q[dk] * xi;
#pragma unroll
            for (int e = 0; e < 16; e += 4) { const f32x4 pp = *(const LAS f32x4*)(Ps + dk * 64 + dq * 16 + e); acc[e] += qd * pp[0]; acc[e + 1] += qd * pp[1]; acc[e + 2] += qd * pp[2]; acc[e + 3] += qd * pp[3]; } }
        float s1 = 0.f;
#pragma unroll
        for (int e = 0; e < 16; ++e) s1 += acc[e];
        s1 += shfl_xor_f(s1, 1, tid_); s1 += shfl_xor_f(s1, 2, tid_);
        const float mean = s1 * (1.0f / 64.0f); float s2 = 0.f;
#pragma unroll
        for (int e = 0; e < 16; ++e) { acc[e] -= mean; s2 += acc[e] * acc[e]; }
        s2 += shfl_xor_f(s2, 1, tid_); s2 += shfl_xor_f(s2, 2, tid_);
        const float rstd = 1.0f / sqrtf(s2 * (1.0f / 64.0f) + GN_EPS);
        const bf16* gp = base + (size_t)i * DINP + C_GR + dq * 16;
        float gv[16]; { const u32x4 a = *(const u32x4*)gp, bb = *(const u32x4*)(gp + 8); unpack8(a, gv); unpack8(bb, gv + 8); }
        float ov[16];
#pragma unroll
        for (int e = 0; e < 16; ++e) { const float g = gv[e]; ov[e] = acc[e] * rstd * (g / (1.0f + expf(-g))); }
        bf16* op = Q.YMIX() + (row0 + i) * DM + 384 + h * HD + dq * 16;
        *(u32x4*)op = (u32x4){pk2(ov[0], ov[1]), pk2(ov[2], ov[3]), pk2(ov[4], ov[5]), pk2(ov[6], ov[7])};
        *(u32x4*)(op + 8) = (u32x4){pk2(ov[8], ov[9]), pk2(ov[10], ov[11]), pk2(ov[12], ov[13]), pk2(ov[14], ov[15])};
        __syncthreads();
    }
}
DI void s5_load_u(const bf16* up, float* u) { const u32x4 a = *(const u32x4*)up, b = *(const u32x4*)(up + 8); unpack8(a, u); unpack8(b, u + 8); }
DI void ph_s5_local(Frame& F, int l) {
    const Ptrs Q = get_ptrs(F);
    const float* P = Q.small() + (size_t)l * SSMP_FLOATS;
    for (int it = F.wg * NWAVES + F.wave; it < BATCH * 16 * 128; it += F.G * NWAVES) {
        const int ch = it & 127, g = (it >> 7) & 15, b = it >> 11; const int n = F.lane;
        const float ar = P[(g * 64 + n) * 2], ai = P[(g * 64 + n) * 2 + 1];
        float bbr[16], bbi[16];
#pragma unroll
        for (int c = 0; c < 16; ++c) { bbr[c] = P[4096 + ((g * 64 + n) * 16 + c) * 2]; bbi[c] = P[4096 + ((g * 64 + n) * 16 + c) * 2 + 1]; }
        float hr = 0.f, hi = 0.f;
        const bf16* up = Q.PROJ() + (size_t)(b * SEQ + ch * 128) * DINP + C_US + g * 16;
        for (int s = 0; s < 128; ++s) { float u[16]; s5_load_u(up + (size_t)s * DINP, u); float xr = 0.f, xi = 0.f;
#pragma unroll
            for (int c = 0; c < 16; ++c) { xr += bbr[c] * u[c]; xi += bbi[c] * u[c]; }
            const float nr = ar * hr - ai * hi + xr, ni = ar * hi + ai * hr + xi; hr = nr; hi = ni; }
        float* e = Q.s5e() + ((size_t)((b * 16 + g) * 128 + ch) * 64 + n) * 2; e[0] = hr; e[1] = hi;
    }
}
DI float gelu_tanh(float v) { const float z = 0.7978845608028654f * (v + 0.044715f * v * v * v); const float t = 1.0f - 2.0f / (expf(2.0f * z) + 1.0f); return 0.5f * v * (1.0f + t); }
DI void ph_s5_out(Frame& F, int l) {
    const Ptrs Q = get_ptrs(F);
    const float* P = Q.small() + (size_t)l * SSMP_FLOATS;
    LAS float* Cre = (LAS float*)F.lds; LAS float* Cim = Cre + 16 * 65;
    LAS float* hre = Cim + 16 * 65 + F.wave * (2 * 16 * 65); LAS float* him = hre + 16 * 65;
    const float* cre_g = Q.in(8) + (size_t)l * 16384; const float* cim_g = Q.in(9) + (size_t)l * 16384; const float* dsk = Q.in(10) + (size_t)l * 256;
    for (int it = F.wg; it < BATCH * 16 * 16; it += F.G) {
        const int cgp = it & 15, g = (it >> 4) & 15, b = it >> 8; const int ch = cgp * 8 + F.wave; const int n = F.lane;
        for (int idx = F.tid; idx < 1024; idx += NTHR) { const int c = idx >> 6, nn = idx & 63; Cre[c * 65 + nn] = cre_g[(g * 16 + c) * 64 + nn]; Cim[c * 65 + nn] = cim_g[(g * 16 + c) * 64 + nn]; }
        __syncthreads();
        const float ar = P[(g * 64 + n) * 2], ai = P[(g * 64 + n) * 2 + 1];
        float bbr[16], bbi[16];
#pragma unroll
        for (int c = 0; c < 16; ++c) { bbr[c] = P[4096 + ((g * 64 + n) * 16 + c) * 2]; bbi[c] = P[4096 + ((g * 64 + n) * 16 + c) * 2 + 1]; }
        const float* e = Q.s5e() + ((size_t)((b * 16 + g) * 128 + ch) * 64 + n) * 2;
        float hr = e[0], hi = e[1];
        const size_t row0 = (size_t)(b * SEQ + ch * 128);
        const bf16* up = Q.PROJ() + row0 * DINP + C_US + g * 16;
        const int tl = F.lane >> 2, cq = F.lane & 3;
        for (int blk = 0; blk < 8; ++blk) {
            for (int s = 0; s < 16; ++s) { float u[16]; s5_load_u(up + (size_t)(blk * 16 + s) * DINP, u); float xr = 0.f, xi = 0.f;
#pragma unroll
                for (int c = 0; c < 16; ++c) { xr += bbr[c] * u[c]; xi += bbi[c] * u[c]; }
                const float nr = ar * hr - ai * hi + xr, ni = ar * hi + ai * hr + xi; hr = nr; hi = ni;
                hre[s * 65 + n] = hr; him[s * 65 + n] = hi; }
            __builtin_amdgcn_wave_barrier();
            float y[4] = {0.f, 0.f, 0.f, 0.f};
            for (int n2 = 0; n2 < 64; ++n2) { const float a = hre[tl * 65 + n2], bq = him[tl * 65 + n2];
#pragma unroll
                for (int k = 0; k < 4; ++k) y[k] += a * Cre[(4 * cq + k) * 65 + n2] - bq * Cim[(4 * cq + k) * 65 + n2]; }
            __builtin_amdgcn_wave_barrier();
            const size_t t = row0 + blk * 16 + tl;
            const u32x2 uu = *(const u32x2*)(Q.PROJ() + t * DINP + C_US + g * 16 + 4 * cq);
            const float u0 = __uint_as_float(uu.x << 16), u1 = __uint_as_float(uu.x & 0xffff0000u), u2 = __uint_as_float(uu.y << 16), u3 = __uint_as_float(uu.y & 0xffff0000u);
            f32x4 o; o[0] = gelu_tanh(y[0] + dsk[g * 16 + 4 * cq] * u0); o[1] = gelu_tanh(y[1] + dsk[g * 16 + 4 * cq + 1] * u1);
            o[2] = gelu_tanh(y[2] + dsk[g * 16 + 4 * cq + 2] * u2); o[3] = gelu_tanh(y[3] + dsk[g * 16 + 4 * cq + 3] * u3);
            *(f32x4*)(Q.yg() + t * 256 + g * 16 + 4 * cq) = o;
        }
        __syncthreads();
    }
}
DI void ph_s5_glu(Frame& F, int l) {
    const Ptrs Q = get_ptrs(F);
    LAS float* ys = (LAS float*)F.lds;
    const float* W = Q.in(11) + (size_t)l * 65536; const float* bg = Q.in(12) + (size_t)l * 256;
    const int j = F.tid & 255, half = F.tid >> 8;
    for (int it = F.wg; it < TOK / 64; it += F.G) {
        const float* src = Q.yg() + (size_t)it * 64 * 256;
        for (int k = 0; k < 8; ++k) { const int idx = (F.tid + 512 * k) * 4; *(LAS f32x4*)(ys + idx) = *(const f32x4*)(src + idx); }
        __syncthreads();
        float acc[32];
        const float b0 = bg[j];
#pragma unroll
        for (int tk = 0; tk < 32; ++tk) acc[tk] = b0;
        for (int i = 0; i < 256; i += 4) { const float w0 = W[(i) * 256 + j], w1 = W[(i + 1) * 256 + j], w2 = W[(i + 2) * 256 + j], w3 = W[(i + 3) * 256 + j];
#pragma unroll
            for (int tk = 0; tk < 32; ++tk) { const f32x4 yv = *(const LAS f32x4*)(ys + (half * 32 + tk) * 256 + i); acc[tk] += yv[0] * w0 + yv[1] * w1 + yv[2] * w2 + yv[3] * w3; } }
#pragma unroll
        for (int tk = 0; tk < 32; ++tk) { const float yv = ys[(half * 32 + tk) * 256 + j]; const float o = yv / (1.0f + expf(-acc[tk]));
            Q.YMIX()[((size_t)it * 64 + half * 32 + tk) * DM + 768 + j] = (bf16)f2bf(o); }
        __syncthreads();
    }
}
DI void ph_moba_simple(Frame& F) {
    const Ptrs Q = get_ptrs(F);
    LAS float* km = (LAS float*)F.lds;
    for (int it = F.wg; it < BATCH * NH * 32; it += F.G) {
        const int qc = it & 31, h = (it >> 5) % NH, b = it / (NH * 32);
        const float* kmg = Q.kmean() + (size_t)(b * NH + h) * 4096;
        for (int k = 0; k < 8; ++k) km[F.tid + 512 * k] = kmg[F.tid + 512 * k];
        __syncthreads();
        const int t = qc * 512 + F.tid; const int own = t >> 8; const size_t row = (size_t)b * SEQ + t;
        float q[64];
        { const bf16* qp = Q.PROJ() + row * DINP + C_QA + h * HD;
#pragma unroll
          for (int k = 0; k < 8; ++k) { const u32x4 a = *(const u32x4*)(qp + 8 * k); unpack8(a, q + 8 * k); } }
        float v0 = -INFINITY, v1 = -INFINITY, v2 = -INFINITY; int i0 = 0, i1 = 0, i2 = 0;
        for (int n = 0; n < own; ++n) { float g = 0.f;
#pragma unroll
            for (int d = 0; d < 64; d += 4) { const f32x4 kk = *(const LAS f32x4*)(km + n * 64 + d); g += q[d] * kk[0] + q[d + 1] * kk[1] + q[d + 2] * kk[2] + q[d + 3] * kk[3]; }
            if (g > v0) { v2 = v1; i2 = i1; v1 = v0; i1 = i0; v0 = g; i0 = n; } else if (g > v1) { v2 = v1; i2 = i1; v1 = g; i1 = n; } else if (g > v2) { v2 = g; i2 = n; } }
        const int nsel = own < 3 ? own : 3;
        const float slope = alibi_slope(h);
        float m = -INFINITY, lsum = 0.f; float o[64];
#pragma unroll
        for (int d = 0; d < 64; ++d) o[d] = 0.f;
        for (int p = 0; p < 4; ++p) {
            if (p < 3 && p >= nsel) continue;
            const int blk = p == 0 ? i0 : p == 1 ? i1 : p == 2 ? i2 : own;
            const int kend = p == 3 ? (t & 255) : 255;
            const bf16* kp = Q.PROJ() + ((size_t)b * SEQ + (size_t)blk * 256) * DINP + h * HD;
            for (int s = 0; s <= kend; ++s) {
                float kv[64];
#pragma unroll
                for (int k = 0; k < 8; ++k) { const u32x4 a = *(const u32x4*)(kp + (size_t)s * DINP + C_KA + 8 * k); unpack8(a, kv + 8 * k); }
                float dot = 0.f;
#pragma unroll
                for (int d = 0; d < 64; ++d) dot += q[d] * kv[d];
                const float sc = dot * 0.125f - slope * (float)(t - (blk * 256 + s));
                if (sc > m) { const float corr = expf(m - sc); lsum *= corr;
#pragma unroll
                    for (int d = 0; d < 64; ++d) o[d] *= corr;
                    m = sc; }
                const float pw = expf(sc - m); lsum += pw;
#pragma unroll
                for (int k = 0; k < 8; ++k) { const u32x4 a = *(const u32x4*)(kp + (size_t)s * DINP + C_VA + 8 * k); unpack8(a, kv + 8 * k); }
#pragma unroll
                for (int d = 0; d < 64; ++d) o[d] += pw * kv[d];
            }
        }
        const float inv = 1.0f / lsum;
        bf16* op = Q.YMIX() + row * DM + h * HD;
#pragma unroll
        for (int k = 0; k < 8; ++k) *(u32x4*)(op + 8 * k) = (u32x4){pk2(o[8 * k] * inv, o[8 * k + 1] * inv), pk2(o[8 * k + 2] * inv, o[8 * k + 3] * inv), pk2(o[8 * k + 4] * inv, o[8 * k + 5] * inv), pk2(o[8 * k + 6] * inv, o[8 * k + 7] * inv)};
        __syncthreads();
    }
}

typedef float f32x16 __attribute__((ext_vector_type(16)));
typedef short s16x4 __attribute__((ext_vector_type(4)));
DI int crow16(int r, int hi) { return (r & 3) + 8 * (r >> 2) + 4 * hi; }
DI int mlist_base(int n) { return 256 * (63 * n - (n * (n - 1)) / 2); }
DI void ph_moba_gate(Frame& F, int l) {
    const Ptrs Q = get_ptrs(F);
    LAS float* km = (LAS float*)F.lds;
    unsigned* mcnt = Q.ctl() + CW_MCNT + 1024 * l;
    for (int it = F.wg; it < BATCH * NH * 32; it += F.G) {
        const int qc = it & 31, h = (it >> 5) % NH, b = it / (NH * 32);
        const float* kmg = Q.kmean() + (size_t)(b * NH + h) * 4096;
        for (int k = 0; k < 8; ++k) km[F.tid + 512 * k] = kmg[F.tid + 512 * k];
        __syncthreads();
        const int t = qc * 512 + F.tid; const int own = t >> 8; const size_t row = (size_t)b * SEQ + t;
        float q[64];
        { const bf16* qp = Q.PROJ() + row * DINP + C_QA + h * HD;
#pragma unroll
          for (int k = 0; k < 8; ++k) { const u32x4 a = *(const u32x4*)(qp + 8 * k); unpack8(a, q + 8 * k); } }
        float v0 = -INFINITY, v1 = -INFINITY, v2 = -INFINITY; int i0 = 0, i1 = 0, i2 = 0;
        for (int n = 0; n < own; ++n) { float g = 0.f;
#pragma unroll
            for (int d = 0; d < 64; d += 4) { const f32x4 kk = *(const LAS f32x4*)(km + n * 64 + d); g += q[d] * kk[0] + q[d + 1] * kk[1] + q[d + 2] * kk[2] + q[d + 3] * kk[3]; }
            if (g > v0) { v2 = v1; i2 = i1; v1 = v0; i1 = i0; v0 = g; i0 = n; } else if (g > v1) { v2 = v1; i2 = i1; v1 = g; i1 = n; } else if (g > v2) { v2 = g; i2 = n; } }
        const int nsel = own < 3 ? own : 3;
        unsigned short* lst = Q.mlist() + (size_t)(b * NH + h) * MLIST_PER_BH;
        unsigned* cn = mcnt + (b * NH + h) * 64;
#pragma unroll
        for (int j = 0; j < 3; ++j) { if (j < nsel) { const int n = j == 0 ? i0 : j == 1 ? i1 : i2; const unsigned pos = atomicAdd(&cn[n], 1u); lst[mlist_base(n) + pos] = (unsigned short)(t | (j << 14)); } }
        __syncthreads();
    }
}
DI void ph_moba_attn(Frame& F, int l) {
    const Ptrs Q0 = get_ptrs(F);
    LAS unsigned char* Ks = F.lds; LAS unsigned char* Vs = F.lds + 32768; LAS unsigned char* Os = F.lds + 65536 + F.wave * 4096;
    LAS int* pre = (LAS int*)(F.lds + 65536 + 32768);
    const unsigned* mcnt0 = Q0.ctl() + CW_MCNT + 1024 * l;
    { int a0 = 0, a1 = 0;
      if (F.tid < 384) { const unsigned c0 = __hip_atomic_load(mcnt0 + 2 * F.tid, __ATOMIC_RELAXED, __HIP_MEMORY_SCOPE_AGENT), c1 = __hip_atomic_load(mcnt0 + 2 * F.tid + 1, __ATOMIC_RELAXED, __HIP_MEMORY_SCOPE_AGENT);
          a0 = 1 + (int)((c0 + 255u) >> 8); a1 = 1 + (int)((c1 + 255u) >> 8); }
      int sc = a0 + a1;
#pragma unroll
      for (int o = 1; o < 64; o <<= 1) { const int v = __builtin_amdgcn_ds_bpermute((F.lane - o) << 2, sc); if (F.lane >= o) sc += v; }
      if (F.lane == 63) pre[800 + F.wave] = sc;
      __syncthreads();
      int wb = 0;
      for (int w = 0; w < 8; ++w) { const int v = pre[800 + w]; if (w < F.wave) wb += v; }
      const int incl = wb + sc;
      if (F.tid < 384) { pre[2 * F.tid + 1] = incl - a1; pre[2 * F.tid + 2] = incl; }
      if (F.tid == 0) pre[0] = 0;
      __syncthreads(); }
    const int nitems = __builtin_amdgcn_readfirstlane(pre[768]);
    const float C2 = 0.125f * 1.4426950408889634f;
    for (int it = F.wg; it < nitems; it += F.G) {
        const int lane = fresh_lane();
        const int ql = lane & 31, hi = lane >> 5; const int tid = F.wave * 64 + lane;
        const Ptrs Q = get_ptrs(F); const unsigned* mcnt = Q.ctl() + CW_MCNT + 1024 * l;
        int lo = 0, hiE = 768;
        while (hiE - lo > 1) { const int mid = (lo + hiE) >> 1; if (pre[mid] <= it) lo = mid; else hiE = mid; }
        const int ent = __builtin_amdgcn_readfirstlane(lo); const int chunk = it - __builtin_amdgcn_readfirstlane(pre[ent]);
        const int n = ent & 63, bh = ent >> 6, h = bh % NH, b = bh / NH;
        const int cnt = (int)__builtin_amdgcn_readfirstlane(__hip_atomic_load(mcnt + ent, __ATOMIC_RELAXED, __HIP_MEMORY_SCOPE_AGENT));
        { const int r = tid >> 1, hf = tid & 1;
          const bf16* kp = Q.PROJ() + ((size_t)b * SEQ + (size_t)n * 256 + r) * DINP + C_KA + h * HD + hf * 32;
          const bf16* vp = kp + (C_VA - C_KA);
          u32x4 kv[4], vv[4];
#pragma unroll
          for (int c = 0; c < 4; ++c) { kv[c] = *(const u32x4*)(kp + 8 * c); vv[c] = *(const u32x4*)(vp + 8 * c); }
#pragma unroll
          for (int c = 0; c < 4; ++c) { const int ch = hf * 4 + c; *(LAS u32x4*)(Ks + r * 128 + ((ch ^ (r & 7)) << 4)) = kv[c]; *(LAS u32x4*)(Vs + r * 128 + (ch << 4)) = vv[c]; } }
        __syncthreads();
        const int e0 = F.wave * 32 + ql;
        bool valid; int t, js;
        if (chunk == 0) { valid = true; t = n * 256 + e0; js = 3; }
        else { const int li = (chunk - 1) * 256 + e0; valid = li < cnt; unsigned v = 0u;
               if (valid) v = Q.mlist()[(size_t)bh * MLIST_PER_BH + mlist_base(n) + li];
               t = valid ? (int)(v & 0x3fffu) : n * 256; js = (int)(v >> 14); }
        const bool wave_work = __builtin_amdgcn_readfirstlane((int)__any((int)valid)) != 0;
        if (wave_work) {
            const float slope2 = alibi_slope(h) * 1.4426950408889634f;
            bf16x8 qf[4];
            { const bf16* qp = Q.PROJ() + ((size_t)b * SEQ + t) * DINP + C_QA + h * HD + 8 * hi;
#pragma unroll
              for (int ks = 0; ks < 4; ++ks) qf[ks] = *(const bf16x8*)(qp + 16 * ks); }
            f32x16 acc[8];
            const float kst = slope2 * (1.0f / C2); const float zoffs = kst * (float)(n * 256 + 4 * hi - t);
            bf16x8 kfr[2][4];
#define MOBA_LDK(buf, kt_) do { _Pragma("unroll") for (int ks = 0; ks < 4; ++ks) { const int row = 32 * (kt_) + ql; kfr[buf][ks] = *(const LAS bf16x8*)(Ks + row * 128 + ((((2 * ks + hi)) ^ (row & 7)) << 4)); } } while (0)
            MOBA_LDK(0, 0);
#pragma unroll
            for (int kt = 0; kt < 8; ++kt) {
                if (kt < 7) MOBA_LDK((kt + 1) & 1, kt + 1);
                const float zk = zoffs + kst * (float)(32 * kt);
#pragma unroll
                for (int r = 0; r < 16; ++r) acc[kt][r] = __builtin_fmaf(kst, (float)(8 * (r >> 2) + (r & 3)), zk);
#pragma unroll
                for (int ks = 0; ks < 4; ++ks) acc[kt] = __builtin_amdgcn_mfma_f32_32x32x16_bf16(kfr[kt & 1][ks], qf[ks], acc[kt], 0, 0, 0);
                __builtin_amdgcn_sched_barrier(0); }
#undef MOBA_LDK
            if (chunk == 0) {
                int e0o = e0 - 4 * hi; asm volatile("" : "+v"(e0o));
#pragma unroll
                for (int kt = 0; kt < 8; ++kt) { const int dq = e0o - 32 * kt;
#pragma unroll
                    for (int r = 0; r < 16; ++r) { if (crow16(r, 0) > dq) acc[kt][r] = -1e30f; } } }
            float mx = acc[0][0];
#pragma unroll
            for (int kt = 0; kt < 8; ++kt)
#pragma unroll
                for (int r = 0; r < 16; ++r) mx = fmaxf(mx, acc[kt][r]);
            mx = xor32_max(mx);
            const float mz = mx * C2;
            f32x16 o0, o1;
#pragma unroll
            for (int r = 0; r < 16; ++r) { o0[r] = 0.f; o1[r] = 0.f; }
            float lsum = 0.f;
            const int qrow = (lane & 15) >> 2, pp = lane & 3, g1 = (lane >> 4) & 1;
            const LAS unsigned char* vb = Vs + (4 * hi + qrow) * 128 + (16 * g1 + 4 * pp) * 2;
#pragma unroll
            for (int kt = 0; kt < 8; ++kt) {
                unsigned pk[8];
#pragma unroll
                for (int r = 0; r < 16; r += 2) { const float p0 = __builtin_amdgcn_exp2f(acc[kt][r] * C2 - mz), p1 = __builtin_amdgcn_exp2f(acc[kt][r + 1] * C2 - mz); lsum += p0 + p1; pk[r >> 1] = pk2(p0, p1); }
#pragma unroll
                for (int s = 0; s < 2; ++s) {
                    const bf16x8 pf = __builtin_bit_cast(bf16x8, (u32x4){pk[4 * s], pk[4 * s + 1], pk[4 * s + 2], pk[4 * s + 3]});
#pragma unroll
                    for (int dt = 0; dt < 2; ++dt) {
                        const LAS unsigned char* va = vb + (32 * kt + 16 * s) * 128 + 64 * dt;
                        const s16x4 lo4 = __builtin_bit_cast(s16x4, __builtin_amdgcn_ds_read_tr16_b64_v4i16((LAS s16x4*)va));
                        const s16x4 hi4 = __builtin_bit_cast(s16x4, __builtin_amdgcn_ds_read_tr16_b64_v4i16((LAS s16x4*)(va + 8 * 128)));
                        const bf16x8 vf = (bf16x8){lo4[0], lo4[1], lo4[2], lo4[3], hi4[0], hi4[1], hi4[2], hi4[3]};
                        if (dt == 0) o0 = __builtin_amdgcn_mfma_f32_32x32x16_bf16(pf, vf, o0, 0, 0, 0); else o1 = __builtin_amdgcn_mfma_f32_32x32x16_bf16(pf, vf, o1, 0, 0, 0);
                    } }
                __builtin_amdgcn_sched_barrier(0); }
            lsum = xor32_sum(lsum);
#pragma unroll
            for (int r = 0; r < 16; ++r) { const int qq = crow16(r, hi); *(LAS unsigned short*)(Os + qq * 128 + ql * 2) = (unsigned short)f2bf(o0[r]); *(LAS unsigned short*)(Os + qq * 128 + (32 + ql) * 2) = (unsigned short)f2bf(o1[r]); }
            const int tj = valid ? (t * 4 + js) : -1;
            const int tjq = __builtin_amdgcn_ds_bpermute((lane >> 1) << 2, tj);
            __builtin_amdgcn_wave_barrier();
            if (tjq >= 0) { const size_t pidx = (size_t)bh * SEQ * 4 + tjq; bf16* dst = Q.mpo() + pidx * 64 + (lane & 1) * 32; const LAS unsigned char* src = Os + (lane >> 1) * 128 + (lane & 1) * 64;
#pragma unroll
                for (int c = 0; c < 4; ++c) *(u32x4*)(dst + 8 * c) = *(const LAS u32x4*)(src + 16 * c); }
            if (valid && hi == 0) { const size_t pidx = (size_t)bh * SEQ * 4 + tj; *(f32x2*)(Q.mml() + pidx * 2) = (f32x2){mz, lsum}; }
        }
        __syncthreads();
    }
}
DI void ph_moba_combine(Frame& F) {
    const Ptrs Q = get_ptrs(F);
    const int gt = F.wg * NTHR + F.tid, NGT = F.G * NTHR;
    for (int i = gt; i < BATCH * NH * SEQ * 8; i += NGT) {
        const int sub = i & 7, qh = i >> 3, t = qh & (SEQ - 1), bh = qh >> 14, h = bh % NH, b = bh / NH;
        const int own = t >> 8, nsel = own < 3 ? own : 3;
        const size_t p0 = (size_t)qh * 4;
        float mj[4], lj[4]; float M = -INFINITY;
#pragma unroll
        for (int j = 0; j < 4; ++j) { const bool ok = (j == 3) || (j < nsel); mj[j] = -INFINITY; lj[j] = 0.f; if (ok) { const f32x2 ml = *(const f32x2*)(Q.mml() + (p0 + j) * 2); mj[j] = ml[0]; lj[j] = ml[1]; } M = fmaxf(M, mj[j]); }
        float o[8], L = 0.f;
#pragma unroll
        for (int k = 0; k < 8; ++k) o[k] = 0.f;
#pragma unroll
        for (int j = 0; j < 4; ++j) { const bool ok = (j == 3) || (j < nsel); if (ok) { const float w = __builtin_amdgcn_exp2f(mj[j] - M); L += w * lj[j];
                float v[8]; unpack8(*(const u32x4*)(Q.mpo() + (p0 + j) * 64 + sub * 8), v);
#pragma unroll
                for (int k = 0; k < 8; ++k) o[k] += w * v[k]; } }
        const float inv = 1.0f / L;
        *(u32x4*)(Q.YMIX() + ((size_t)b * SEQ + t) * DM + h * HD + sub * 8) = (u32x4){pk2(o[0] * inv, o[1] * inv), pk2(o[2] * inv, o[3] * inv), pk2(o[4] * inv, o[5] * inv), pk2(o[6] * inv, o[7] * inv)};
    }
}
DI void ph_ln1_router(Frame& F, int l) {
    const Ptrs Q = get_ptrs(F);
    LAS float* rwT = (LAS float*)F.lds;
    for (int idx = F.tid; idx < 16384; idx += NTHR) { const int d = idx >> 4, e = idx & 15; rwT[e * 1024 + d] = Q.in(17)[idx]; }
    __syncthreads();
    const float* gam = Q.in(13) + l * DM; const float* bet = Q.in(14) + l * DM; const float* rb = Q.in(18);
    unsigned* ecnt = Q.ctl() + CW_ECNT + 64 * l;
    for (int r = F.wg * NWAVES + F.wave; r < TOK; r += F.G * NWAVES) {
        f32x4 v[4]; float s = 0.f;
#pragma unroll
        for (int j = 0; j < 4; ++j) { v[j] = *(const f32x4*)(Q.V1() + (size_t)r * DM + j * 256 + F.lane * 4); s += (v[j][0] + v[j][1]) + (v[j][2] + v[j][3]); }
        const float mean = wave_sum(s, F.lane) * (1.0f / DM); float s2 = 0.f;
#pragma unroll
        for (int j = 0; j < 4; ++j) { v[j] = v[j] - mean; s2 += (v[j][0] * v[j][0] + v[j][1] * v[j][1]) + (v[j][2] * v[j][2] + v[j][3] * v[j][3]); }
        const float rstd = 1.0f / sqrtf(wave_sum(s2, F.lane) * (1.0f / DM) + LN_EPS);
        float lg[16];
#pragma unroll
        for (int e = 0; e < 16; ++e) lg[e] = 0.f;
#pragma unroll
        for (int j = 0; j < 4; ++j) { const int d0 = j * 256 + F.lane * 4; const f32x4 gg = *(const f32x4*)(gam + d0), bb = *(const f32x4*)(bet + d0);
            v[j] = v[j] * rstd * gg + bb;
            *(u32x2*)(Q.X1B() + (size_t)r * DM + d0) = (u32x2){pk2(v[j][0], v[j][1]), pk2(v[j][2], v[j][3])}; }
#pragma unroll
        for (int e = 0; e < 16; ++e) { float a_ = 0.f;
#pragma unroll
            for (int j = 0; j < 4; ++j) { const f32x4 w = *(const LAS f32x4*)(rwT + e * 1024 + j * 256 + F.lane * 4); a_ += v[j][0] * w[0] + v[j][1] * w[1] + v[j][2] * w[2] + v[j][3] * w[3]; }
            lg[e] = a_; asm volatile("" ::: "memory"); }
        float aff[16], sel[16];
#pragma unroll
        for (int e = 0; e < 16; ++e) { const float z = wave_sum(lg[e], F.lane); aff[e] = 1.0f / (1.0f + expf(-z)); sel[e] = aff[e] + rb[e]; }
        float gs[4];
#pragma unroll
        for (int g = 0; g < 4; ++g) { const float a = sel[4 * g], bq = sel[4 * g + 1], c = sel[4 * g + 2], d = sel[4 * g + 3];
            gs[g] = fmaxf(fmaxf(fmaxf(a + bq, a + c), fmaxf(a + d, bq + c)), fmaxf(bq + d, c + d)); }
        int gb = 0; float gbv = gs[0];
#pragma unroll
        for (int g = 1; g < 4; ++g) if (gs[g] > gbv) { gbv = gs[g]; gb = g; }
        float s4[4], a4[4];
#pragma unroll
        for (int k = 0; k < 4; ++k) { s4[k] = gb == 0 ? sel[k] : gb == 1 ? sel[4 + k] : gb == 2 ? sel[8 + k] : sel[12 + k]; a4[k] = gb == 0 ? aff[k] : gb == 1 ? aff[4 + k] : gb == 2 ? aff[8 + k] : aff[12 + k]; }
        int f0 = 0; float fv = s4[0], fa = a4[0];
#pragma unroll
        for (int k = 1; k < 4; ++k) if (s4[k] > fv) { fv = s4[k]; f0 = k; fa = a4[k]; }
        int f1 = -1; float sv = -INFINITY, sa = 0.f;
#pragma unroll
        for (int k = 0; k < 4; ++k) if (k != f0 && s4[k] > sv) { sv = s4[k]; f1 = k; sa = a4[k]; }
        const float wsum = fa + sa;
        if (F.lane == 0) {
            const int e0 = gb * 4 + f0, e1 = gb * 4 + f1;
            const unsigned p0 = atomicAdd(&ecnt[e0], 1u); Q.ltok()[(size_t)e0 * LCAP + p0] = (unsigned)r; Q.lw()[(size_t)e0 * LCAP + p0] = fa / wsum;
            const unsigned p1 = atomicAdd(&ecnt[e1], 1u); Q.ltok()[(size_t)e1 * LCAP + p1] = (unsigned)r | 0x80000000u; Q.lw()[(size_t)e1 * LCAP + p1] = sa / wsum;
        }
    }
}
DI void moe_build_tab(Frame& F, int l) {
    const Ptrs Q = get_ptrs(F);
    LAS int* tab = (LAS int*)(F.lds + MOE_TAB_OFF);
    __syncthreads();
    if (F.tid == 0) {
        const unsigned* ecnt = Q.ctl() + CW_ECNT + 64 * l; int pb = 0;
        for (int e = 0; e < 16; ++e) { const int c = (int)__hip_atomic_load(ecnt + e, __ATOMIC_RELAXED, __HIP_MEMORY_SCOPE_AGENT); tab[e] = c; tab[16 + e] = pb; const int nb = (c + 255) >> 8;
            for (int j = 0; j < nb; ++j) tab[64 + pb + j] = e;
            pb += nb; }
        tab[32] = pb;
    }
    __syncthreads();
}
DI void ph_ln2(Frame& F, int l) {
    const Ptrs Q = get_ptrs(F);
    const float* gam = Q.in(15) + l * DM; const float* bet = Q.in(16) + l * DM;
    for (int r = F.wg * NWAVES + F.wave; r < TOK; r += F.G * NWAVES) {
        float v[16]; float s = 0.f;
#pragma unroll
        for (int j = 0; j < 2; ++j) { const size_t off = (size_t)r * DM + j * 512 + F.lane * 8;
            float a[8], b0[8], b1[8]; unpack8(*(const u32x4*)(Q.X1B() + off), a); unpack8(*(const u32x4*)(Q.YM0() + off), b0); unpack8(*(const u32x4*)(Q.YM1() + off), b1);
#pragma unroll
            for (int k = 0; k < 8; ++k) { v[j * 8 + k] = ALPHA * a[k] + (b0[k] + b1[k]); s += v[j * 8 + k]; } }
        const float mean = wave_sum(s, F.lane) * (1.0f / DM); float s2 = 0.f;
#pragma unroll
        for (int k = 0; k < 16; ++k) { v[k] -= mean; s2 += v[k] * v[k]; }
        const float rstd = 1.0f / sqrtf(wave_sum(s2, F.lane) * (1.0f / DM) + LN_EPS);
#pragma unroll
        for (int j = 0; j < 2; ++j) { const int d0 = j * 512 + F.lane * 8; float o[8];
#pragma unroll
            for (int k = 0; k < 8; ++k) o[k] = v[j * 8 + k] * rstd * gam[d0 + k] + bet[d0 + k];
            if (l == DEPTH - 1) { *(f32x4*)(Q.out + (size_t)r * DM + d0) = (f32x4){o[0], o[1], o[2], o[3]}; *(f32x4*)(Q.out + (size_t)r * DM + d0 + 4) = (f32x4){o[4], o[5], o[6], o[7]}; }
            else *(u32x4*)(Q.XB() + (size_t)r * DM + d0) = (u32x4){pk2(o[0], o[1]), pk2(o[2], o[3]), pk2(o[4], o[5]), pk2(o[6], o[7])}; }
    }
}

constexpr int PH_PER_LAYER = 10, NPH = 1 + DEPTH * PH_PER_LAYER;
DI void grid_barrier(const Frame& F) {
    const Ptrs Q = get_ptrs(F);
    XcdBarrier b; b.bar = Q.ctl() + CW_BAR; b.x = xb_xcc_id(); b.st = (volatile LAS unsigned*)(F.lds + MISC_OFF) + 8;
    xcd_barrier(b);
}
DI void refresh_ids(Frame& F, int wave0) {
    int w_ = wave0; asm volatile("" : "+s"(w_)); unsigned z_ = 0u; asm volatile("" : "+v"(z_));
    const int ln_ = (int)__builtin_amdgcn_mbcnt_hi(~0u, __builtin_amdgcn_mbcnt_lo(~0u, z_));
    F.wave = w_; F.lane = ln_; F.tid = w_ * 64 + ln_;
}
#if MK_ONE_LAUNCH
#define PHASE_END(k) do { if ((k) + 1 < ph_hi) grid_barrier(F); } while (0)
#else
#define PHASE_END(k) do { __syncthreads(); } while (0)
#endif
#define PHASE_IN(k) (ph_lo <= (k) && (k) < ph_hi)
template <int L> DI void run_layer(Frame& F, const int wave0, const int ph_lo, const int ph_hi) {
    constexpr int base = 1 + L * PH_PER_LAYER;
    const LAS int* tab = (const LAS int*)(F.lds + MOE_TAB_OFF);
    if (PHASE_IN(base + 0)) { refresh_ids(F, wave0);
        { const Ptrs Q = get_ptrs(F);
          pg8::DenseSched S; S.init(Q.XB(), Q.Win_t() + (size_t)L * DINP * DM, TOK, DINP, DM, F.G, F.wg);
          pg8::EpiBf16 E{Q.PROJ(), DINP};
          pg8::gemm_phase<pg8::EpiBf16, pg8::DenseSched, true>(F.lds, F.tid, DM, S, E); }
        PHASE_END(base + 0); }
    if (PHASE_IN(base + 1)) { refresh_ids(F, wave0); ph_kmean(F); ph_ret_kv(F); ph_s5_local(F, L); PHASE_END(base + 1); }
    if (PHASE_IN(base + 2)) { refresh_ids(F, wave0); ph_scans(F, L); refresh_ids(F, wave0); ph_moba_gate(F, L); PHASE_END(base + 2); }
    if (PHASE_IN(base + 3)) { refresh_ids(F, wave0); ph_moba_attn(F, L); refresh_ids(F, wave0); ph_ret_out(F); refresh_ids(F, wave0); ph_s5_out(F, L); PHASE_END(base + 3); }
    if (PHASE_IN(base + 4)) { refresh_ids(F, wave0); ph_s5_glu(F, L); refresh_ids(F, wave0); ph_moba_combine(F); PHASE_END(base + 4); }
    if (PHASE_IN(base + 5)) { refresh_ids(F, wave0);
        { const Ptrs Q = get_ptrs(F);
          pg8::DenseSched S; S.init(Q.YMIX(), Q.Wout_t() + (size_t)L * DM * DM, TOK, DM, DM, F.G, F.wg);
          pg8::EpiResF32 E{Q.V1(), Q.XB()};
          pg8::gemm_phase<pg8::EpiResF32, pg8::DenseSched, true>(F.lds, F.tid, DM, S, E); }
        PHASE_END(base + 5); }
    if (PHASE_IN(base + 6)) { refresh_ids(F, wave0); ph_ln1_router(F, L); PHASE_END(base + 6); }
    if (PHASE_IN(base + 7)) { refresh_ids(F, wave0);
        moe_build_tab(F, L);
        { const Ptrs Q = get_ptrs(F);
          pg8::MoeUpSched S{Q.X1B(), Q.Wgu_t() + (size_t)L * 16 * 1024 * 1024, Q.ltok(), tab, F.G, F.wg};
          pg8::EpiSwiGLU E{Q.Hb()};
          pg8::gemm_phase<pg8::EpiSwiGLU, pg8::MoeUpSched, true>(F.lds, F.tid, DM, S, E); }
        PHASE_END(base + 7); }
    if (PHASE_IN(base + 8)) { refresh_ids(F, wave0);
        moe_build_tab(F, L);
        { const Ptrs Q = get_ptrs(F);
          pg8::MoeDownSched S{Q.Hb(), Q.Wd_t() + (size_t)L * 16 * 1024 * DFF, tab, F.G, F.wg};
          pg8::EpiMoeScatter E{Q.YM0(), Q.YM1(), Q.ltok(), Q.lw(), tab};
          pg8::gemm_phase<pg8::EpiMoeScatter, pg8::MoeDownSched, true>(F.lds, F.tid, DFF, S, E); }
        PHASE_END(base + 8); }
    if (PHASE_IN(base + 9)) { refresh_ids(F, wave0); ph_ln2(F, L); PHASE_END(base + 9); }
}
__global__ void __launch_bounds__(NTHR, 2) fwd_kernel(Args args_unused) {
    extern __shared__ __attribute__((aligned(16))) unsigned char lds_raw[];
    Frame F;
    F.lds = (LAS unsigned char*)lds_raw;
    F.ka = (const Args*)__builtin_amdgcn_kernarg_segment_ptr();
    F.tid = threadIdx.x; F.lane = F.tid & 63; F.wave = __builtin_amdgcn_readfirstlane(F.tid >> 6);
    F.G = gridDim.x; F.wg = blockIdx.x;
    for (int u = F.tid; u < (LDS_BYTES - LDSCTL_OFF) / 4; u += NTHR) ((LAS unsigned*)(F.lds + LDSCTL_OFF))[u] = 0u;
    __syncthreads();
    const int ph_lo = F.ka->ph_lo, ph_hi = F.ka->ph_hi;
    const int wave0 = F.wave;
#if MK_ONE_LAUNCH
    { const Ptrs Q = get_ptrs(F); (void)xcd_barrier_post(Q.ctl() + CW_BAR, (volatile LAS unsigned*)(F.lds + MISC_OFF) + 8); }
#endif
    if (PHASE_IN(0)) { refresh_ids(F, wave0); ph_prologue(F);
#if MK_ONE_LAUNCH
        if (1 < ph_hi) { __threadfence(); cg::this_grid().sync(); __builtin_amdgcn_fence(__ATOMIC_ACQUIRE, "agent"); asm volatile("s_waitcnt vmcnt(0)" ::: "memory"); __syncthreads(); }
#else
        PHASE_END(0);
#endif
    }
    run_layer<0>(F, wave0, ph_lo, ph_hi);
    run_layer<1>(F, wave0, ph_lo, ph_hi);
}

extern "C" void kernel_launch(void* const* d_in, const int* in_sizes, int n_in, void* d_out, int out_size, void* d_ws, size_t ws_size, hipStream_t stream) {
    static int grid = 0;
    if (grid == 0) {
        if (n_in != 22 || in_sizes[0] != TOK * DM || out_size != TOK * DM || ws_size < WS_END) {
            fprintf(stderr, "kernel_launch: unexpected shapes (n_in %d, in0 %d, out %d, ws %zu); nothing launched\n", n_in, n_in > 0 ? in_sizes[0] : -1, out_size, ws_size); grid = -1; return; }
        int dev = 0, cus = 0, per_cu = 0;
        if (hipGetDevice(&dev) != hipSuccess || hipDeviceGetAttribute(&cus, hipDeviceAttributeMultiprocessorCount, dev) != hipSuccess) { grid = -1; return; }
        if (hipFuncSetAttribute((const void*)fwd_kernel, hipFuncAttributeMaxDynamicSharedMemorySize, LDS_BYTES) != hipSuccess) { fprintf(stderr, "kernel_launch: hipFuncSetAttribute failed\n"); grid = -1; return; }
        if (hipOccupancyMaxActiveBlocksPerMultiprocessor(&per_cu, (const void*)fwd_kernel, NTHR, LDS_BYTES) != hipSuccess || per_cu < 1) { fprintf(stderr, "kernel_launch: occupancy query says %d blocks per CU\n", per_cu); (void)hipGetLastError(); grid = -1; return; }
        grid = cus;
    }
    if (grid < 0) return;
    (void)hipMemsetAsync((char*)d_ws + WS_CTL, 0, CTL_ZERO_BYTES, stream);
    Args a{};
    for (int i = 0; i < 22; ++i) a.in[i] = (const float*)d_in[i];
    a.out = (float*)d_out; a.ws = (unsigned char*)d_ws;
#if MK_ONE_LAUNCH
    a.ph_lo = 0; a.ph_hi = NPH;
    void* kargs[] = {&a};
    hipError_t e = hipLaunchCooperativeKernel((const void*)fwd_kernel, dim3(grid), dim3(NTHR), kargs, LDS_BYTES, stream);
    if (e != hipSuccess) fprintf(stderr, "cooperative launch failed: %s (grid %d)\n", hipGetErrorString(e), grid);
#else
    for (int ph = 0; ph < NPH; ++ph) { a.ph_lo = ph; a.ph_hi = ph + 1; hipLaunchKernelGGL(fwd_kernel, dim3(grid), dim3(NTHR), LDS_BYTES, stream, a); }
#endif
}
```

```cpp
#include <hip/hip_runtime.h>
#include <hip/hip_cooperative_groups.h>
#include <cstdio>
#include <cstdint>
namespace cg = cooperative_groups;

#ifndef PROBE_WG
#define PROBE_WG 0
#endif
#ifndef PROBE_K
#define PROBE_K 0.45f
#endif
#ifndef PROBE_SUB_A
#define PROBE_SUB_A -1
#define PROBE_SUB_B -1
#endif
#ifndef PROBE_TS_SEL
#define PROBE_TS_SEL 0
#endif
#ifndef S5_SIMPLE
#define S5_SIMPLE 0
#endif
#ifndef MK_ONE_LAUNCH
#define MK_ONE_LAUNCH 1
#endif

#define DI __device__ __forceinline__
#define GAS __attribute__((address_space(1)))
#define LAS __attribute__((address_space(3)))
typedef unsigned short bf16;
typedef float f32x4 __attribute__((ext_vector_type(4)));
typedef float f32x2 __attribute__((ext_vector_type(2)));
typedef unsigned u32x4 __attribute__((ext_vector_type(4)));
typedef unsigned u32x2 __attribute__((ext_vector_type(2)));
typedef short bf16x8 __attribute__((ext_vector_type(8)));

constexpr int BATCH = 2, SEQ = 16384, DM = 1024, TOK = BATCH * SEQ, DEPTH = 2;
constexpr int DIN = 2944, DINP = 3072;
constexpr int C_QA = 0, C_KA = 384, C_VA = 768, C_QR = 1152, C_KR = 1536, C_VR = 1920, C_GR = 2304, C_US = 2688;
constexpr int NH = 6, HD = 64, NKB = 64, KBLK = 256;
constexpr int NE = 16, DFF = 512, LCAP = TOK;
constexpr int MAXBLK = 288;
constexpr float ALPHA = 1.41421356237309505f;
constexpr float LN_EPS = 1e-5f, GN_EPS = 1e-6f;
constexpr int NWAVES = 8, NTHR = 512;

constexpr size_t MiB = 1u << 20;
constexpr size_t WS_CTL = 0, CTL_ZERO_BYTES = 64 * 1024;
constexpr size_t WS_SMALL = 1 * MiB;
constexpr size_t WS_WIN = 5 * MiB;
constexpr size_t WS_WOUT = 17 * MiB;
constexpr size_t WS_WGU = 21 * MiB;
constexpr size_t WS_WD = 85 * MiB;
constexpr size_t WS_XB = 117 * MiB;
constexpr size_t WS_X1B = 181 * MiB;
constexpr size_t WS_PROJ = 245 * MiB;
constexpr size_t WS_H = WS_PROJ, WS_YM0 = WS_PROJ + 68 * MiB;
constexpr size_t WS_YMIX = 437 * MiB;
constexpr size_t WS_YM1 = WS_YMIX;
constexpr size_t WS_LTOK = 501 * MiB;
constexpr size_t WS_LW = 503 * MiB;
constexpr size_t WS_END = 505 * MiB;
constexpr int SSMP_FLOATS = 235520;
constexpr int SP_APOW = 36864, SP_KT = 104448;
constexpr size_t SM_WGLUT = 2560 * 1024;
constexpr size_t SM_SSMP = 0;
constexpr size_t SM_KMEAN = 2 * SSMP_FLOATS * 4;
constexpr size_t SM_RIMG = 3 * 1024 * 1024;
constexpr size_t DO_RETKV = 0;
constexpr size_t DO_UG = 12 * MiB;
constexpr size_t DO_S5E = 24 * MiB;
constexpr size_t DO_MPO = 28 * MiB;
constexpr size_t X1_YG = 0;
constexpr size_t X1_YI = 0;
constexpr size_t X1_S5EG = 16 * MiB;
constexpr size_t X1_S5CB = 24 * MiB;
constexpr size_t X1_S5M = 50 * MiB;
constexpr size_t X1_S5MC = 62 * MiB;
constexpr size_t X1_MLIST = 32 * MiB;
constexpr size_t X1_MML = 44 * MiB;
constexpr int MLIST_PER_BH = 516096;
constexpr int CW_BAR = 4096;
constexpr int CW_ECNT = 1024;
constexpr int CW_MCNT = 8192;
constexpr int RING_BYTES = 131072, LDSCTL_OFF = RING_BYTES, MISC_OFF = LDSCTL_OFF + 320, MOE_TAB_OFF = LDSCTL_OFF + 1024;
constexpr int LDS_BYTES = 147456;

DI float bf2f(unsigned short v) { return __uint_as_float((unsigned)v << 16); }
DI unsigned f2bf(float f) { unsigned u = __float_as_uint(f); return (u + 0x7fffu + ((u >> 16) & 1u)) >> 16; }
typedef __bf16 bf16x2_t __attribute__((ext_vector_type(2)));
DI unsigned pk2(float lo, float hi) { const f32x2 v = {lo, hi}; const bf16x2_t b = __builtin_convertvector(v, bf16x2_t); return __builtin_bit_cast(unsigned, b); }
DI void unpack8(const u32x4 v, float* o) {
    o[0] = __uint_as_float(v.x << 16); o[1] = __uint_as_float(v.x & 0xffff0000u); o[2] = __uint_as_float(v.y << 16); o[3] = __uint_as_float(v.y & 0xffff0000u);
    o[4] = __uint_as_float(v.z << 16); o[5] = __uint_as_float(v.z & 0xffff0000u); o[6] = __uint_as_float(v.w << 16); o[7] = __uint_as_float(v.w & 0xffff0000u);
}
DI void sincos_acc(float a, float& sn, float& cs) {
    const double ad = (double)a; const double kd = rint(ad * 0.63661977236758134308); const int k = (int)kd;
    const float r = (float)(ad - kd * 1.57079632679489661923), z = r * r;
    const float sp = r + r * z * (-1.6666667163e-01f + z * (8.3333337680e-03f + z * (-1.9841270114e-04f + z * (2.7557314297e-06f + z * (-2.5050759689e-08f)))));
    const float cp = 1.0f - 0.5f * z + z * z * (4.1666667908e-02f + z * (-1.3888889225e-03f + z * (2.4801587642e-05f + z * (-2.7557314297e-07f + z * (2.0875723372e-09f)))));
    const int q = k & 3;
    sn = q == 0 ? sp : q == 1 ? cp : q == 2 ? -sp : -cp;
    cs = q == 0 ? cp : q == 1 ? -sp : q == 2 ? -cp : sp;
}
DI int fresh_lane() { unsigned z_ = 0u; asm volatile("" : "+v"(z_)); return (int)__builtin_amdgcn_mbcnt_hi(~0u, __builtin_amdgcn_mbcnt_lo(~0u, z_)); }
DI float xor32_max(float v) { const auto rr = __builtin_amdgcn_permlane32_swap(__float_as_uint(v), __float_as_uint(v), false, false); return fmaxf(__uint_as_float(rr[0]), __uint_as_float(rr[1])); }
DI float xor32_sum(float v) { const auto rr = __builtin_amdgcn_permlane32_swap(__float_as_uint(v), __float_as_uint(v), false, false); return __uint_as_float(rr[0]) + __uint_as_float(rr[1]); }
DI float shfl_xor_f(float v, int mask, int lane) { return __uint_as_float((unsigned)__builtin_amdgcn_ds_bpermute((lane ^ mask) << 2, (int)__float_as_uint(v))); }
template <int CTRL> DI float dppf(float v) { return __builtin_bit_cast(float, __builtin_amdgcn_update_dpp(0, __builtin_bit_cast(int, v), CTRL, 0xf, 0xf, true)); }
constexpr int DPP_XOR1 = 0xB1, DPP_XOR2 = 0x4E, DPP_HALF_MIRROR = 0x141, DPP_MIRROR = 0x140, DPP_ROR8 = 0x128;
DI float swap16_sum(float a, float b) { const auto r = __builtin_amdgcn_permlane16_swap(__float_as_uint(a), __float_as_uint(b), false, false); return __uint_as_float(r[0]) + __uint_as_float(r[1]); }
DI float swap32_sum(float a, float b) { const auto r = __builtin_amdgcn_permlane32_swap(__float_as_uint(a), __float_as_uint(b), false, false); return __uint_as_float(r[0]) + __uint_as_float(r[1]); }
DI float wave_sum(float v, int lane) {
    (void)lane;
    v += dppf<DPP_XOR1>(v); v += dppf<DPP_XOR2>(v); v += dppf<DPP_HALF_MIRROR>(v); v += dppf<DPP_MIRROR>(v);
    v = swap16_sum(v, v); v = swap32_sum(v, v);
    return v;
}
DI float ret_log2g(int h) {
    return h == 0 ? -0.04580368961312479f : h == 1 ? -0.02272007650008353f : h == 2 ? -0.011315313227834146f : h == 3 ? -0.005646563141142063f : h == 4 ? -0.0028205190623786626f : -0.0014095702546713536f;
}
DI float alibi_slope(int h) {
    return h == 0 ? 0.3968502629920499f : h == 1 ? 0.15749013123685915f : h == 2 ? 0.0625f : h == 3 ? 0.024803141437003122f : h == 4 ? 0.009843133202303695f : 0.00390625f;
}

namespace pg8 {
#define PG8_LAS __attribute__((address_space(3)))
typedef unsigned short bf16_t;
constexpr int BM = 256, BK = 64, HALF = 128, HTB = HALF * BK * 2, STAGE_BYTES = 8 * HTB, NXCD = 8, WGM = 8;
__host__ __device__ __forceinline__ int lds_byte(int r, int c) { const int st = (r >> 4) * 2 + (c >> 5), rr = r & 15, cc = c & 31, ob = rr * 64 + cc * 2; return st * 1024 + (ob ^ (((ob >> 9) & 1) << 5)); }
__host__ __device__ __forceinline__ void stage_rc(int b, int& R, int& C) { const int st = b / 1024, sb = b % 1024, swz = sb ^ (((sb >> 9) & 1) << 5); R = (st >> 1) * 16 + swz / 64; C = (st & 1) * 32 + (swz % 64) / 2; }
__host__ __device__ __forceinline__ int perm32(int rho) { const int n = rho >> 4, i = rho & 15; return 8 * (i >> 2) + 4 * n + (i & 3); }

struct Unit { int pm, pn, e, jb; };

template <class Epi, class Sched, bool ALIGN_EPI>
__device__ __forceinline__ void gemm_phase(PG8_LAS unsigned char* lds, const int tid, const int K, const Sched& S, const Epi& E) {
    const int wid = __builtin_amdgcn_readfirstlane(tid >> 6), lane = tid & 63, wr = wid >> 2, wc = wid & 3, fr = lane & 15, fq = lane >> 4;
    const int nt = K / BK;
    unsigned voffB[2];
#pragma unroll
    for (int i = 0; i < 2; ++i) { int R, C; stage_rc(tid * 16 + i * 8192, R, C); const int Rb = Epi::PERM ? ((R & ~31) + perm32(R & 31)) : R; voffB[i] = (unsigned)(Rb * K + C) * 2u; }
    const size_t kstepA = S.kstep(), kstepB = (size_t)(BK * 2);
    const size_t hstep = (size_t)HALF * K * 2;
    const unsigned ldsw = (unsigned)wid * 1024u;
    const int aoff = lds_byte(wr * 64 + fr, fq * 8), boff = lds_byte(wc * 32 + fr, fq * 8);
#define PG8_SA(b, h) (((b) * 2 + (h)) * HTB)
#define PG8_SB(b, h) ((4 + (b) * 2 + (h)) * HTB)
#define PG8_STAGE(bufoff, gbase, voff) do { _Pragma("unroll") for (int _i = 0; _i < 2; ++_i) \
        __builtin_amdgcn_global_load_lds((const unsigned*)((const char*)(gbase) + (voff)[_i]), (PG8_LAS unsigned*)(lds + (bufoff) + ldsw + _i * 8192), 16, 0, 0); } while (0)
#define PG8_LDA(dst, b, h) do { _Pragma("unroll") for (int m = 0; m < 4; ++m) _Pragma("unroll") for (int k = 0; k < 2; ++k) dst[m][k] = *(const PG8_LAS bf16x8*)(lds + PG8_SA(b, h) + aoff + m * 2048 + k * 1024); } while (0)
#define PG8_LDB(dst, b, h) do { _Pragma("unroll") for (int n = 0; n < 2; ++n) _Pragma("unroll") for (int k = 0; k < 2; ++k) dst[n][k] = *(const PG8_LAS bf16x8*)(lds + PG8_SB(b, h) + boff + n * 2048 + k * 1024); } while (0)
#define PG8_MMA(ai, bj, At, Bt) do { __builtin_amdgcn_s_setprio(1); _Pragma("unroll") for (int m = 0; m < 4; ++m) _Pragma("unroll") for (int n = 0; n < 2; ++n) _Pragma("unroll") for (int k = 0; k < 2; ++k) \
        acc[ai][bj][m][n] = __builtin_amdgcn_mfma_f32_16x16x32_bf16(Bt[n][k], At[m][k], acc[ai][bj][m][n], 0, 0, 0); __builtin_amdgcn_s_setprio(0); } while (0)
#define PG8_WAIT_V(n) asm volatile("s_waitcnt vmcnt(" #n ")" ::: "memory")
#define PG8_WAIT_L(n) asm volatile("s_waitcnt lgkmcnt(" #n ")" ::: "memory")
#define PG8_BAR __builtin_amdgcn_s_barrier()
#define PG8_SCHED __builtin_amdgcn_sched_barrier(0)
    Unit cur, nxt; int ui = 0;
    if (!S.next(0, cur)) return;
    f32x4 acc[2][2][4][2];
#pragma unroll
    for (int a = 0; a < 2; ++a)
#pragma unroll
        for (int b = 0; b < 2; ++b)
#pragma unroll
            for (int m = 0; m < 4; ++m)
#pragma unroll
                for (int n = 0; n < 2; ++n) acc[a][b][m][n] = (f32x4){0.f, 0.f, 0.f, 0.f};
    bf16x8 At[4][2], B0[2][2], B1[2][2];
    const char* cA; const char* cB; unsigned vA[2][2];
    S.addr(cur, tid, cA, vA, cB);
    PG8_STAGE(PG8_SB(0, 0), cB, voffB); PG8_STAGE(PG8_SB(0, 1), cB + hstep, voffB); PG8_STAGE(PG8_SA(0, 0), cA, vA[0]); PG8_STAGE(PG8_SA(0, 1), cA, vA[1]);
    if (wr == 1) PG8_BAR;
    PG8_WAIT_V(2); PG8_BAR;
    PG8_STAGE(PG8_SB(1, 0), cB + kstepB, voffB); PG8_STAGE(PG8_SA(1, 0), cA + kstepA, vA[0]); PG8_STAGE(PG8_SB(1, 1), cB + hstep + kstepB, voffB);
    PG8_WAIT_V(6); PG8_BAR;
    for (;;) {
        const bool has_next = S.next(ui + 1, nxt);
        const char* nA = cA; const char* nB = cB; unsigned nvA[2][2] = {{vA[0][0], vA[0][1]}, {vA[1][0], vA[1][1]}};
        if (has_next) { if constexpr (Sched::A_VARIES) S.addr(nxt, tid, nA, nvA, nB); else { unsigned dummy[2][2]; S.addr(nxt, tid, nA, dummy, nB); } }
        typename Epi::Pre pre; E.prefetch(cur, wr, wc, fr, fq, pre);
        for (int t = 0; t < nt; t += 2) {
            const bool last = (t == nt - 2);
            const char* a1 = cA + (size_t)(t + 1) * kstepA;
            const char* a2 = last ? nA : cA + (size_t)(t + 2) * kstepA; const char* b2 = last ? nB : cB + (size_t)(t + 2) * kstepB;
            const char* a3 = a2 + kstepA; const char* b3 = b2 + kstepB;
            unsigned xA0[2], xA1[2];
            if constexpr (Sched::A_VARIES) { xA0[0] = last ? nvA[0][0] : vA[0][0]; xA0[1] = last ? nvA[0][1] : vA[0][1]; xA1[0] = last ? nvA[1][0] : vA[1][0]; xA1[1] = last ? nvA[1][1] : vA[1][1]; }
            else { xA0[0] = vA[0][0]; xA0[1] = vA[0][1]; xA1[0] = vA[1][0]; xA1[1] = vA[1][1]; }
            PG8_LDB(B0, 0, 0); PG8_LDB(B1, 0, 1); PG8_SCHED; PG8_LDA(At, 0, 0); PG8_STAGE(PG8_SA(1, 1), a1, vA[1]);
            PG8_WAIT_V(8); PG8_WAIT_L(0); PG8_BAR; PG8_MMA(0, 0, At, B0); PG8_MMA(0, 1, At, B1); PG8_BAR; PG8_SCHED;
            PG8_LDA(At, 0, 1); PG8_STAGE(PG8_SB(0, 0), b2, voffB); PG8_STAGE(PG8_SB(0, 1), b2 + hstep, voffB); PG8_STAGE(PG8_SA(0, 0), a2, xA0);
            PG8_WAIT_V(8); PG8_WAIT_L(0); PG8_BAR; PG8_MMA(1, 0, At, B0); PG8_MMA(1, 1, At, B1); PG8_BAR; PG8_SCHED;
            PG8_LDB(B0, 1, 0); PG8_LDB(B1, 1, 1); PG8_SCHED; PG8_LDA(At, 1, 0); PG8_STAGE(PG8_SA(0, 1), a2, xA1);
            PG8_WAIT_V(8); PG8_WAIT_L(0); PG8_BAR; PG8_MMA(0, 0, At, B0); PG8_MMA(0, 1, At, B1); PG8_BAR; PG8_SCHED;
            PG8_LDA(At, 1, 1); PG8_STAGE(PG8_SB(1, 0), b3, voffB); PG8_STAGE(PG8_SB(1, 1), b3 + hstep, voffB); PG8_STAGE(PG8_SA(1, 0), a3, xA0);
            PG8_WAIT_V(8); PG8_WAIT_L(0); PG8_BAR; PG8_MMA(1, 0, At, B0); PG8_MMA(1, 1, At, B1); PG8_BAR; PG8_SCHED;
        }
        if constexpr (ALIGN_EPI) { if (wr == 0) PG8_BAR; }
        E(acc, cur, wr, wc, fr, fq, pre);
        if (!has_next) break;
#pragma unroll
        for (int a = 0; a < 2; ++a)
#pragma unroll
            for (int b = 0; b < 2; ++b)
#pragma unroll
                for (int m = 0; m < 4; ++m)
#pragma unroll
                    for (int n = 0; n < 2; ++n) acc[a][b][m][n] = (f32x4){0.f, 0.f, 0.f, 0.f};
        cur = nxt; cA = nA; cB = nB; if constexpr (Sched::A_VARIES) { vA[0][0] = nvA[0][0]; vA[0][1] = nvA[0][1]; vA[1][0] = nvA[1][0]; vA[1][1] = nvA[1][1]; } ++ui;
        if constexpr (ALIGN_EPI) { if (wr == 1) PG8_BAR; }
    }
    PG8_WAIT_V(0);
    if constexpr (!ALIGN_EPI) { if (wr == 0) PG8_BAR; }
    PG8_BAR;
#undef PG8_SA
#undef PG8_SB
#undef PG8_STAGE
#undef PG8_LDA
#undef PG8_LDB
#undef PG8_MMA
#undef PG8_WAIT_V
#undef PG8_WAIT_L
#undef PG8_BAR
#undef PG8_SCHED
}

struct DenseSched {
    static constexpr bool A_VARIES = false;
    __device__ __forceinline__ size_t kstep() const { return (size_t)(BK * 2); }
    const bf16_t* A; const bf16_t* Bt; int K; int nM, nN, nwg, G, c;
    __device__ void init(const bf16_t* A_, const bf16_t* Bt_, int M, int N, int K_, int G_, int c_) { A = A_; Bt = Bt_; K = K_; nM = M / BM; nN = N / BM; nwg = nM * nN; G = G_; c = c_; }
    __device__ __forceinline__ bool next(int i, Unit& u) const {
        const long L = (long)i * G + c; if (L >= nwg) return false;
        int wgid = (int)L; { const int q = nwg / NXCD, r = nwg % NXCD, xcd = wgid % NXCD, off = wgid / NXCD; wgid = (xcd < r ? xcd * (q + 1) : r * (q + 1) + (xcd - r) * q) + off; }
        const int nig = WGM * nN, gid = wgid / nig, fm = gid * WGM, gsz = (nM - fm) < WGM ? (nM - fm) : WGM;
        u.pm = __builtin_amdgcn_readfirstlane(fm + ((wgid % nig) % gsz)); u.pn = __builtin_amdgcn_readfirstlane((wgid % nig) / gsz); u.e = 0; u.jb = 0; return true;
    }
    __device__ __forceinline__ void addr(const Unit& u, int tid, const char*& a, unsigned (&vA)[2][2], const char*& b) const {
        asm volatile("" : "+v"(tid));
        a = (const char*)A + (size_t)u.pm * BM * K * 2; b = (const char*)Bt + (size_t)u.pn * BM * K * 2;
#pragma unroll
        for (int i = 0; i < 2; ++i) { int R, C; stage_rc(tid * 16 + i * 8192, R, C);
#pragma unroll
            for (int h = 0; h < 2; ++h) vA[h][i] = (unsigned)((h * HALF + R) * K + C) * 2u; }
    }
};
struct MoeUpSched {
    static constexpr bool A_VARIES = true;
    __device__ __forceinline__ size_t kstep() const { return (size_t)(BK * 2); }
    const bf16_t* X; const bf16_t* W; const unsigned* ltok; const PG8_LAS int* tab; int G, c;
    __device__ __forceinline__ bool next(int i, Unit& u) const {
        const int id = i * G + c; const int nb = __builtin_amdgcn_readfirstlane(tab[32]); if (id >= nb * 4) return false;
        const int blk = id >> 2; u.pm = blk; u.pn = id & 3; u.e = __builtin_amdgcn_readfirstlane(tab[64 + blk]); u.jb = blk - __builtin_amdgcn_readfirstlane(tab[16 + u.e]); return true;
    }
    __device__ __forceinline__ void addr(const Unit& u, int tid, const char*& a, unsigned (&vA)[2][2], const char*& b) const {
        asm volatile("" : "+v"(tid));
        a = (const char*)X; b = (const char*)W + ((size_t)u.e * 1024 + (size_t)u.pn * BM) * 1024 * 2;
        const int cnt = __builtin_amdgcn_readfirstlane(tab[u.e]); const unsigned* lt = ltok + (size_t)u.e * LCAP + u.jb * 256;
#pragma unroll
        for (int i = 0; i < 2; ++i) { int R, C; stage_rc(tid * 16 + i * 8192, R, C);
#pragma unroll
            for (int h = 0; h < 2; ++h) { const int r = h * HALF + R; const bool ok = (u.jb * 256 + r) < cnt; const unsigned tk = ok ? (lt[r] & 0x7fffffffu) : 0u; vA[h][i] = (tk * 1024u + (unsigned)C) * 2u; } }
    }
};
struct MoeDownSched {
    static constexpr bool A_VARIES = false;
    __device__ __forceinline__ size_t kstep() const { return (size_t)(BK * 2); }
    const bf16_t* Hb; const bf16_t* W; const PG8_LAS int* tab; int G, c;
    __device__ __forceinline__ bool next(int i, Unit& u) const {
        const int id = i * G + c; const int nb = __builtin_amdgcn_readfirstlane(tab[32]); if (id >= nb * 4) return false;
        const int blk = id >> 2; u.pm = blk; u.pn = id & 3; u.e = __builtin_amdgcn_readfirstlane(tab[64 + blk]); u.jb = blk - __builtin_amdgcn_readfirstlane(tab[16 + u.e]); return true;
    }
    __device__ __forceinline__ void addr(const Unit& u, int tid, const char*& a, unsigned (&vA)[2][2], const char*& b) const {
        asm volatile("" : "+v"(tid));
        a = (const char*)Hb + (size_t)u.pm * BM * DFF * 2; b = (const char*)W + ((size_t)u.e * 1024 + (size_t)u.pn * BM) * DFF * 2;
#pragma unroll
        for (int i = 0; i < 2; ++i) { int R, C; stage_rc(tid * 16 + i * 8192, R, C);
#pragma unroll
            for (int h = 0; h < 2; ++h) vA[h][i] = (unsigned)((h * HALF + R) * DFF + C) * 2u; }
    }
};

struct EpiBf16 {
    static constexpr bool PERM = true;
    struct Pre {}; __device__ __forceinline__ void prefetch(const Unit&, int, int, int, int, Pre&) const {}
    bf16_t* O; int ldc; bf16_t* UG;
    __device__ __forceinline__ void operator()(const f32x4 (&acc)[2][2][4][2], const Unit& u, int wr, int wc, int fr, int fq, const Pre& pre) const { (void)pre;
        asm volatile("" : "+v"(fr), "+v"(fq));
        const int row0 = u.pm * BM + wr * 64 + fr; const int col0 = u.pn * BM + wc * 32 + 8 * fq;
#pragma unroll
        for (int ai = 0; ai < 2; ++ai)
#pragma unroll
            for (int m = 0; m < 4; ++m) { bf16_t* rowp = O + (size_t)(row0 + ai * HALF + m * 16) * ldc + col0;
#pragma unroll
                for (int bj = 0; bj < 2; ++bj) { const f32x4 v0 = acc[ai][bj][m][0], v1 = acc[ai][bj][m][1];
                    u32x4 w; w.x = pk2(v0[0], v0[1]); w.y = pk2(v0[2], v0[3]); w.z = pk2(v1[0], v1[1]); w.w = pk2(v1[2], v1[3]);
                    const int col = col0 + bj * HALF;
                    if (col >= C_US) { if (col < DIN) *(u32x4*)(UG + ((size_t)((col - C_US) >> 4) * TOK + (size_t)(row0 + ai * HALF + m * 16)) * 16 + ((col - C_US) & 15)) = w; }
                    else *(u32x4*)(rowp + bj * HALF) = w; } }
    }
};
struct EpiResF32 {
    static constexpr bool PERM = true;
    struct Pre { u32x4 x0[4][2]; };
    __device__ __forceinline__ void prefetch(const Unit& u, int wr, int wc, int fr, int fq, Pre& pre) const {
        const int row0 = u.pm * BM + wr * 64 + fr; const int col0 = u.pn * BM + wc * 32 + 8 * fq;
#pragma unroll
        for (int m = 0; m < 4; ++m)
#pragma unroll
            for (int bj = 0; bj < 2; ++bj) pre.x0[m][bj] = *(const u32x4*)(XBp + (size_t)(row0 + m * 16) * DM + col0 + bj * HALF);
    }
    bf16_t* V; const bf16_t* XBp;
    __device__ __forceinline__ void operator()(const f32x4 (&acc)[2][2][4][2], const Unit& u, int wr, int wc, int fr, int fq, const Pre& pre) const { (void)pre;
        asm volatile("" : "+v"(fr), "+v"(fq));
        const int row0 = u.pm * BM + wr * 64 + fr; const int col0 = u.pn * BM + wc * 32 + 8 * fq;
        u32x4 x1[4][2];
#pragma unroll
        for (int m = 0; m < 4; ++m)
#pragma unroll
            for (int bj = 0; bj < 2; ++bj) x1[m][bj] = *(const u32x4*)(XBp + (size_t)(row0 + HALF + m * 16) * DM + col0 + bj * HALF);
#pragma unroll
        for (int ai = 0; ai < 2; ++ai) {
#pragma unroll
            for (int m = 0; m < 4; ++m)
#pragma unroll
                for (int bj = 0; bj < 2; ++bj) { float x[8]; unpack8(ai == 0 ? pre.x0[m][bj] : x1[m][bj], x); const f32x4 a0 = acc[ai][bj][m][0], a1 = acc[ai][bj][m][1];
                    *(u32x4*)(V + (size_t)(row0 + ai * HALF + m * 16) * DM + col0 + bj * HALF) = (u32x4){pk2(ALPHA * x[0] + a0[0], ALPHA * x[1] + a0[1]), pk2(ALPHA * x[2] + a0[2], ALPHA * x[3] + a0[3]),
                                                                                                    pk2(ALPHA * x[4] + a1[0], ALPHA * x[5] + a1[1]), pk2(ALPHA * x[6] + a1[2], ALPHA * x[7] + a1[3])}; } }
    }
};
__device__ __forceinline__ float silu_f(float x) { return x * __builtin_amdgcn_rcpf(1.0f + __builtin_amdgcn_exp2f(-1.4426950408889634f * x)); }
struct EpiSwiGLU {
    static constexpr bool PERM = true;
    struct Pre {}; __device__ __forceinline__ void prefetch(const Unit&, int, int, int, int, Pre&) const {}
    bf16_t* Hb;
    __device__ __forceinline__ void operator()(const f32x4 (&acc)[2][2][4][2], const Unit& u, int wr, int wc, int fr, int fq, const Pre& pre) const { (void)pre;
        asm volatile("" : "+v"(fr), "+v"(fq));
        const int row0 = u.pm * BM + wr * 64 + fr; const int col0 = u.pn * HALF + wc * 32 + 8 * fq;
#pragma unroll
        for (int ai = 0; ai < 2; ++ai)
#pragma unroll
            for (int m = 0; m < 4; ++m) { bf16_t* p = Hb + (size_t)(row0 + ai * HALF + m * 16) * DFF + col0;
                const f32x4 g0 = acc[ai][0][m][0], g1 = acc[ai][0][m][1], u0 = acc[ai][1][m][0], u1 = acc[ai][1][m][1];
                u32x4 w; w.x = pk2(silu_f(g0[0]) * u0[0], silu_f(g0[1]) * u0[1]); w.y = pk2(silu_f(g0[2]) * u0[2], silu_f(g0[3]) * u0[3]);
                w.z = pk2(silu_f(g1[0]) * u1[0], silu_f(g1[1]) * u1[1]); w.w = pk2(silu_f(g1[2]) * u1[2], silu_f(g1[3]) * u1[3]);
                *(u32x4*)p = w; }
    }
};
struct EpiMoeScatter {
    static constexpr bool PERM = true;
    struct Pre { unsigned tkv[2][4]; float wv[2][4]; };
    __device__ __forceinline__ void prefetch(const Unit& u, int wr, int wc, int fr, int fq, Pre& pre) const { (void)wc; (void)fq;
        const int cnt = __builtin_amdgcn_readfirstlane(tab[u.e]); const size_t lbase = (size_t)u.e * LCAP + (size_t)u.jb * 256;
#pragma unroll
        for (int ai = 0; ai < 2; ++ai)
#pragma unroll
            for (int m = 0; m < 4; ++m) { const int r = ai * HALF + wr * 64 + m * 16 + fr; const bool ok = u.jb * 256 + r < cnt; pre.tkv[ai][m] = ok ? ltok[lbase + r] : 0u; pre.wv[ai][m] = ok ? lw[lbase + r] : 0.f; }
    }
    bf16_t* YM0; bf16_t* YM1; const unsigned* ltok; const float* lw; const PG8_LAS int* tab;
    __device__ __forceinline__ void operator()(const f32x4 (&acc)[2][2][4][2], const Unit& u, int wr, int wc, int fr, int fq, const Pre& pre) const { (void)pre;
        asm volatile("" : "+v"(fr), "+v"(fq));
        const int cnt = __builtin_amdgcn_readfirstlane(tab[u.e]); const int col0 = u.pn * BM + wc * 32 + 8 * fq;
        const size_t lbase = (size_t)u.e * LCAP + (size_t)u.jb * 256;
#pragma unroll
        for (int ai = 0; ai < 2; ++ai)
#pragma unroll
            for (int m = 0; m < 4; ++m) { const int r = ai * HALF + wr * 64 + m * 16 + fr;
                if (u.jb * 256 + r < cnt) {
                    const unsigned tk = pre.tkv[ai][m]; const float w = pre.wv[ai][m];
                    bf16_t* p = ((tk >> 31) ? YM1 : YM0) + (size_t)(tk & 0x7fffffffu) * DM + col0;
#pragma unroll
                    for (int bj = 0; bj < 2; ++bj) { const f32x4 v0 = acc[ai][bj][m][0], v1 = acc[ai][bj][m][1];
                        u32x4 o; o.x = pk2(w * v0[0], w * v0[1]); o.y = pk2(w * v0[2], w * v0[3]); o.z = pk2(w * v1[0], w * v1[1]); o.w = pk2(w * v1[2], w * v1[3]);
                        *(u32x4*)(p + bj * HALF) = o; } } }
    }
};

struct S5ASched {
    static constexpr bool A_VARIES = false;
    const bf16_t* UGp; const bf16_t* Mg; int G, c;
    __device__ __forceinline__ size_t kstep() const { return (size_t)(BK * 2); }
    __device__ __forceinline__ bool next(int i, Unit& u) const { const int id = i * G + c; if (id >= 192) return false; const int e_ = id / 12, rem = id - 12 * e_, pm_ = rem / 3; u.e = __builtin_amdgcn_readfirstlane(e_); u.pm = __builtin_amdgcn_readfirstlane(pm_); u.pn = __builtin_amdgcn_readfirstlane(rem - 3 * pm_); u.jb = 0; return true; }
    __device__ __forceinline__ void addr(const Unit& u, int tid, const char*& a, unsigned (&vA)[2][2], const char*& b) const {
        asm volatile("" : "+v"(tid));
        a = (const char*)UGp + ((size_t)u.e * TOK * 16 + (size_t)u.pm * BM * 512) * 2; b = (const char*)Mg + ((size_t)u.e * 768 + (size_t)u.pn * BM) * 512 * 2;
#pragma unroll
        for (int i = 0; i < 2; ++i) { int R, C; stage_rc(tid * 16 + i * 8192, R, C);
#pragma unroll
            for (int h = 0; h < 2; ++h) vA[h][i] = (unsigned)((h * HALF + R) * 512 + C) * 2u; }
    }
};
struct S5BSched {
    static constexpr bool A_VARIES = false;
    const bf16_t* CB; const bf16_t* MC; int G, c;
    __device__ __forceinline__ size_t kstep() const { return (size_t)(BK * 2); }
    __device__ __forceinline__ bool next(int i, Unit& u) const { const int id = __builtin_amdgcn_readfirstlane(i * G + c); if (id >= 128) return false; u.e = id >> 3; u.pm = (id & 7) >> 1; u.pn = id & 1; u.jb = 0; return true; }
    __device__ __forceinline__ void addr(const Unit& u, int tid, const char*& a, unsigned (&vA)[2][2], const char*& b) const {
        asm volatile("" : "+v"(tid));
        a = (const char*)CB + ((size_t)u.e * 1024 + (size_t)u.pm * BM) * 128 * 2; b = (const char*)MC + ((size_t)u.e * 512 + (size_t)u.pn * BM) * 128 * 2;
#pragma unroll
        for (int i = 0; i < 2; ++i) { int R, C; stage_rc(tid * 16 + i * 8192, R, C);
#pragma unroll
            for (int h = 0; h < 2; ++h) vA[h][i] = (unsigned)((h * HALF + R) * 128 + C) * 2u; }
    }
};
struct EpiS5A {
    static constexpr bool PERM = true;
    struct Pre {}; __device__ __forceinline__ void prefetch(const Unit&, int, int, int, int, Pre&) const {}
    bf16_t* YI; float* EG;
    __device__ __forceinline__ void operator()(const f32x4 (&acc)[2][2][4][2], const Unit& u, int wr, int wc, int fr, int fq, const Pre& pre) const { (void)pre;
        asm volatile("" : "+v"(fr), "+v"(fq));
        const int row0 = u.pm * BM + wr * 64 + fr;
#pragma unroll
        for (int ai = 0; ai < 2; ++ai)
#pragma unroll
            for (int m = 0; m < 4; ++m) { const int q = row0 + ai * HALF + m * 16;
                if (u.pn < 2) {
#pragma unroll
                    for (int bj = 0; bj < 2; ++bj) { const int tc = u.pn * BM + bj * HALF + wc * 32 + 8 * fq; const f32x4 v0 = acc[ai][bj][m][0], v1 = acc[ai][bj][m][1];
                        u32x4 w; w.x = pk2(v0[0], v0[1]); w.y = pk2(v0[2], v0[3]); w.z = pk2(v1[0], v1[1]); w.w = pk2(v1[2], v1[3]);
                        *(u32x4*)(YI + ((size_t)q * 32 + (tc >> 4)) * 256 + u.e * 16 + (tc & 15)) = w; }
                } else { float* ep = EG + ((size_t)u.e * 1024 + q) * 128 + wc * 32 + 8 * fq; *(f32x4*)ep = acc[ai][0][m][0]; *(f32x4*)(ep + 4) = acc[ai][0][m][1]; } }
    }
};
__device__ __forceinline__ float gelu_tanh_f(float v) { const float z = 0.7978845608028654f * (v + 0.044715f * v * v * v); const float e = __builtin_amdgcn_exp2f(2.8853900817779268f * z); return 0.5f * v * (2.0f - 2.0f * __builtin_amdgcn_rcpf(e + 1.0f)); }
struct EpiS5B {
    static constexpr bool PERM = true;
    struct Pre {}; __device__ __forceinline__ void prefetch(const Unit&, int, int, int, int, Pre&) const {}
    bf16_t* YI; const bf16_t* UGp; const float* dsk;
    __device__ __forceinline__ void operator()(const f32x4 (&acc)[2][2][4][2], const Unit& u, int wr, int wc, int fr, int fq, const Pre& pre) const { (void)pre;
        asm volatile("" : "+v"(fr), "+v"(fq));
        const int row0 = u.pm * BM + wr * 64 + fr;
        const int chl = u.e * 16 + 8 * (fq & 1);
        const f32x4 d0 = *(const f32x4*)(dsk + chl), d1 = *(const f32x4*)(dsk + chl + 4);
#pragma unroll
        for (int aim = 0; aim < 4; ++aim) { const int ai = aim >> 1, m0 = (aim & 1) * 2;
            u32x4 yvv[4][2], uvv[4][2];
#pragma unroll
            for (int m = m0; m < m0 + 2; ++m) { const int q = row0 + ai * HALF + m * 16;
#pragma unroll
                for (int bj = 0; bj < 2; ++bj) { const int tc = u.pn * BM + bj * HALF + wc * 32 + 8 * fq; const size_t tok = (size_t)q * 32 + (tc >> 4); const int ch = u.e * 16 + (tc & 15);
                    yvv[m][bj] = *(const u32x4*)(YI + tok * 256 + ch); uvv[m][bj] = *(const u32x4*)(UGp + ((size_t)u.e * TOK + tok) * 16 + (tc & 15)); } }
#pragma unroll
            for (int m = m0; m < m0 + 2; ++m) { const int q = row0 + ai * HALF + m * 16;
#pragma unroll
                for (int bj = 0; bj < 2; ++bj) { const int tc = u.pn * BM + bj * HALF + wc * 32 + 8 * fq; const size_t tok = (size_t)q * 32 + (tc >> 4); const int ch = u.e * 16 + (tc & 15);
                    bf16_t* yp = YI + tok * 256 + ch; const u32x4 yv = yvv[m][bj], uv = uvv[m][bj];
                    const f32x4 v0 = acc[ai][bj][m][0], v1 = acc[ai][bj][m][1];
                    float y[8], uu[8]; unpack8(yv, y); unpack8(uv, uu);
                    float o[8];
#pragma unroll
                    for (int k = 0; k < 4; ++k) { o[k] = gelu_tanh_f(v0[k] + y[k] + d0[k] * uu[k]); o[4 + k] = gelu_tanh_f(v1[k] + y[4 + k] + d1[k] * uu[4 + k]); }
                    *(u32x4*)yp = (u32x4){pk2(o[0], o[1]), pk2(o[2], o[3]), pk2(o[4], o[5]), pk2(o[6], o[7])}; } } }
    }
};
struct EpiGLU {
    static constexpr bool PERM = true;
    struct Pre {}; __device__ __forceinline__ void prefetch(const Unit&, int, int, int, int, Pre&) const {}
    const bf16_t* YG; const float* bg; bf16_t* YMIXp;
    __device__ __forceinline__ void operator()(const f32x4 (&acc)[2][2][4][2], const Unit& u, int wr, int wc, int fr, int fq, const Pre& pre) const { (void)pre;
        asm volatile("" : "+v"(fr), "+v"(fq));
        const int row0 = u.pm * BM + wr * 64 + fr;
        f32x4 bb0[2], bb1[2];
#pragma unroll
        for (int bj = 0; bj < 2; ++bj) { const int col = bj * HALF + wc * 32 + 8 * fq; bb0[bj] = *(const f32x4*)(bg + col); bb1[bj] = *(const f32x4*)(bg + col + 4); }
#pragma unroll
        for (int ai = 0; ai < 2; ++ai) {
            u32x4 ygv[2][4][2];
#pragma unroll
            for (int m = 0; m < 4; ++m)
#pragma unroll
                for (int bj = 0; bj < 2; ++bj) ygv[ai][m][bj] = *(const u32x4*)(YG + (size_t)(row0 + ai * HALF + m * 16) * 256 + bj * HALF + wc * 32 + 8 * fq);
#pragma unroll
            for (int m = 0; m < 4; ++m) { const size_t row = (size_t)(row0 + ai * HALF + m * 16);
#pragma unroll
                for (int bj = 0; bj < 2; ++bj) { const int col = bj * HALF + wc * 32 + 8 * fq; const u32x4 yv = ygv[ai][m][bj];
                    const f32x4 b0 = bb0[bj], b1 = bb1[bj]; const f32x4 v0 = acc[ai][bj][m][0], v1 = acc[ai][bj][m][1];
                    float y[8]; unpack8(yv, y); float o[8];
#pragma unroll
                    for (int k = 0; k < 4; ++k) { o[k] = y[k] * __builtin_amdgcn_rcpf(1.0f + __builtin_amdgcn_exp2f(-1.4426950408889634f * (v0[k] + b0[k]))); o[4 + k] = y[4 + k] * __builtin_amdgcn_rcpf(1.0f + __builtin_amdgcn_exp2f(-1.4426950408889634f * (v1[k] + b1[k]))); }
                    *(u32x4*)(YMIXp + row * DM + 768 + col) = (u32x4){pk2(o[0], o[1]), pk2(o[2], o[3]), pk2(o[4], o[5]), pk2(o[6], o[7])}; } } }
    }
};
}

#define XB_TMO      128
#define XB_XCNT(j)  (256  + 64 * (j))
#define XB_XSUB(j)  (1280 + 64 * (j))
#define XB_XGEN(j)  (2304 + 64 * (j))
#define XB_TOP      3328
#define XB_TOPGEN   3392
#define XCD_BAR_WORDS 3456
#define XB_SPIN_CAP (1u << 22)
DI unsigned xb_ld(unsigned* p)              { return __hip_atomic_load(p, __ATOMIC_RELAXED, __HIP_MEMORY_SCOPE_AGENT); }
DI unsigned xb_add(unsigned* p, unsigned v) { return __hip_atomic_fetch_add(p, v, __ATOMIC_RELAXED, __HIP_MEMORY_SCOPE_AGENT); }
DI unsigned xb_xcc_id() { return (unsigned)__builtin_amdgcn_s_getreg((3 << 11) | 20) & 0xFu; }
#define XB_SPIN(cond, bar) do { unsigned _sp = 0; while (cond) { __builtin_amdgcn_s_sleep(1); \
    if ((++_sp & 255u) == 0u) { if (xb_ld(&(bar)[XB_TMO])) break; if (_sp > XB_SPIN_CAP) { atomicAdd(&(bar)[XB_TMO], 1u); break; } } } } while (0)
struct XcdBarrier { unsigned* bar; unsigned x; volatile LAS unsigned* st; };
DI XcdBarrier xcd_barrier_post(unsigned* bar, volatile LAS unsigned* st) {
    XcdBarrier b; b.bar = bar; b.x = xb_xcc_id(); b.st = st;
    if (threadIdx.x == 0) (void)xb_add(&bar[XB_XCNT(b.x)], 1u);
    return b;
}
DI void xcd_barrier_complete(unsigned* bar, unsigned x, unsigned& nloc, unsigned& nx) {
    const unsigned G = gridDim.x * gridDim.y * gridDim.z;
    unsigned sum, cnt, mine, sp = 0u;
    for (;;) {
        sum = 0u; cnt = 0u; mine = 0u;
#pragma unroll
        for (unsigned j = 0; j < 16; ++j) { const unsigned c = xb_ld(&bar[XB_XCNT(j)]); sum += c; cnt += (c > 0u) ? 1u : 0u; mine = (j == x) ? c : mine; }
        if (sum == G) break;
        __builtin_amdgcn_s_sleep(1);
        if ((++sp & 255u) == 0u) { if (xb_ld(&bar[XB_TMO])) break; if (sp > XB_SPIN_CAP) { atomicAdd(&bar[XB_TMO], 1u); break; } }
    }
    nloc = mine > 0u ? mine : 1u; nx = cnt > 0u ? cnt : 1u;
}
DI void xcd_barrier(const XcdBarrier& b) {
    asm volatile("s_waitcnt vmcnt(0)" ::: "memory");
    __syncthreads();
    if (threadIdx.x == 0) {
        unsigned* bar = b.bar;
        __builtin_amdgcn_s_waitcnt(0);
        unsigned nloc = b.st[0], nx = b.st[1];
        if (nloc == 0u) { xcd_barrier_complete(bar, b.x, nloc, nx); b.st[0] = nloc; b.st[1] = nx; }
        const unsigned old = xb_add(&bar[XB_XSUB(b.x)], 1u);
        const unsigned gen = old / nloc;
        if (old + 1u == (gen + 1u) * nloc) {
            __builtin_amdgcn_fence(__ATOMIC_RELEASE, "agent");
            asm volatile("s_waitcnt vmcnt(0)" ::: "memory");
            const unsigned og = xb_add(&bar[XB_TOP], 1u);
            const unsigned tg = og / nx;
            if (og + 1u == (tg + 1u) * nx) xb_add(&bar[XB_TOPGEN], 1u);
            else XB_SPIN(xb_ld(&bar[XB_TOPGEN]) == tg, bar);
            __builtin_amdgcn_fence(__ATOMIC_ACQUIRE, "agent");
            xb_add(&bar[XB_XGEN(b.x)], 1u);
            asm volatile("s_waitcnt vmcnt(0)" ::: "memory");
        } else {
            XB_SPIN(xb_ld(&bar[XB_XGEN(b.x)]) == gen, bar);
            __builtin_amdgcn_fence(__ATOMIC_ACQUIRE, "agent");
            asm volatile("s_waitcnt vmcnt(0)" ::: "memory");
        }
    }
    __syncthreads();
}

struct Args { const float* in[22]; float* out; unsigned char* ws; int ph_lo, ph_hi; };
typedef const __attribute__((address_space(4))) Args* KArgs;
struct Frame {
    LAS unsigned char* lds;
    KArgs ka;
    int tid, lane, wave, wg, G;
};
struct Ptrs {
    KArgs a; unsigned char* ws; float* out;
    DI const float* in(int k) const { return a->in[k]; }
    DI unsigned* ctl() const { return (unsigned*)(ws + WS_CTL); }
    DI bf16* Win_t() const { return (bf16*)(ws + WS_WIN); }
    DI bf16* Wout_t() const { return (bf16*)(ws + WS_WOUT); }
    DI bf16* Wgu_t() const { return (bf16*)(ws + WS_WGU); }
    DI bf16* Wd_t() const { return (bf16*)(ws + WS_WD); }
    DI bf16* XB() const { return (bf16*)(ws + WS_XB); }
    DI bf16* X1B() const { return (bf16*)(ws + WS_X1B); }
    DI bf16* PROJ() const { return (bf16*)(ws + WS_PROJ); }
    DI bf16* YMIX() const { return (bf16*)(ws + WS_YMIX); }
    DI bf16* Hb() const { return (bf16*)(ws + WS_H); }
    DI bf16* YM0() const { return (bf16*)(ws + WS_YM0); }
    DI bf16* YM1() const { return (bf16*)(ws + WS_YM1); }
    DI unsigned* ltok() const { return (unsigned*)(ws + WS_LTOK); }
    DI float* lw() const { return (float*)(ws + WS_LW); }
    DI float* small() const { return (float*)(ws + WS_SMALL); }
    DI float* kmean() const { return (float*)(ws + WS_SMALL + SM_KMEAN); }
    DI bf16* retkv() const { return (bf16*)((unsigned char*)out + DO_RETKV); }
    DI bf16* ug() const { return (bf16*)((unsigned char*)out + DO_UG); }
    DI float* s5e() const { return (float*)((unsigned char*)out + DO_S5E); }
    DI float* yg() const { return (float*)(ws + WS_X1B + X1_YG); }
    DI bf16* yi() const { return (bf16*)(ws + WS_X1B + X1_YI); }
    DI float* s5eg() const { return (float*)(ws + WS_X1B + X1_S5EG); }
    DI bf16* s5cb() const { return (bf16*)(ws + WS_X1B + X1_S5CB); }
    DI bf16* s5m() const { return (bf16*)(ws + WS_X1B + X1_S5M); }
    DI bf16* s5mc() const { return (bf16*)(ws + WS_X1B + X1_S5MC); }
    DI bf16* wglut() const { return (bf16*)(ws + WS_SMALL + SM_WGLUT); }
    DI u32x4* rimg() const { return (u32x4*)(ws + WS_SMALL + SM_RIMG); }
    DI unsigned short* mlist() const { return (unsigned short*)(ws + WS_X1B + X1_MLIST); }
    DI float* mml() const { return (float*)(ws + WS_X1B + X1_MML); }
    DI bf16* mpo() const { return (bf16*)((unsigned char*)out + DO_MPO); }
    DI bf16* V1() const { return (bf16*)out; }
};
DI Ptrs get_ptrs(const Frame& F) { KArgs a = F.ka; asm volatile("" : "+s"(a)); Ptrs P; P.a = a; P.ws = a->ws; P.out = a->out; return P; }

DI void transpose_item(const float* W, int K, int N, bf16* WT, int dst_row0, LAS float* scr, int k0, int n0, int lane) {
    f32x4 ld[8];
#pragma unroll
    for (int i = 0; i < 8; ++i) ld[i] = *(const f32x4*)(W + (size_t)(k0 + 8 * i + (lane >> 3)) * N + n0 + (lane & 7) * 4);
#pragma unroll
    for (int i = 0; i < 8; ++i) { LAS float* d = scr + (8 * i + (lane >> 3)) * 33 + (lane & 7) * 4; d[0] = ld[i][0]; d[1] = ld[i][1]; d[2] = ld[i][2]; d[3] = ld[i][3]; }
    asm volatile("s_waitcnt lgkmcnt(0)" ::: "memory");
    const int c = lane & 7;
#pragma unroll
    for (int j = 0; j < 4; ++j) { const int n = (lane >> 3) + 8 * j; const LAS float* s = scr + (8 * c) * 33 + n;
        u32x4 o; o.x = pk2(s[0 * 33], s[1 * 33]); o.y = pk2(s[2 * 33], s[3 * 33]); o.z = pk2(s[4 * 33], s[5 * 33]); o.w = pk2(s[6 * 33], s[7 * 33]);
        *(u32x4*)(WT + (size_t)(dst_row0 + n) * K + k0 + 8 * c) = o; }
    asm volatile("s_waitcnt lgkmcnt(0)" ::: "memory");
}
#define TS_MARKP(id) do { if (PROBE_TS_SEL != 0 && F.wg == PROBE_WG && F.wave == 0 && F.lane == 0) { __builtin_amdgcn_s_waitcnt(0); ((LAS unsigned long long*)(F.lds + LDSCTL_OFF + 4096))[64 + (id)] = __builtin_amdgcn_s_memrealtime(); } } while (0)
DI void conv_moe_item(const Ptrs& Q, int l, int idx, LAS float* scr, int lane) {
    if (idx < 8192) { const int sg = idx >> 12, rr = idx & 4095, le = l * 16 + (rr >> 8), q = rr & 255, kb = q >> 4, nb = q & 15; const int n0 = 32 * nb;
        const float* W = (sg ? Q.in(20) : Q.in(19)) + (size_t)le * DM * DFF;
        transpose_item(W, DM, DFF, Q.Wgu_t() + (size_t)le * 1024 * 1024, 256 * (n0 >> 7) + 128 * sg + (n0 & 127), scr, 64 * kb, n0, lane); }
    else { const int rr = idx - 8192, le = l * 16 + (rr >> 8), q = rr & 255, kb = q >> 5, nb = q & 31;
        transpose_item(Q.in(21) + (size_t)le * DFF * DM, DFF, DM, Q.Wd_t() + (size_t)le * 1024 * DFF, 32 * nb, scr, 64 * kb, 32 * nb, lane); }
}
constexpr int MOE_CONV_ITEMS = 12288;
DI void ph_conv_deferred(Frame& F, int half) {
    const Ptrs Q = get_ptrs(F);
    LAS float* scr = (LAS float*)(F.lds + F.wave * 16384);
    int slot, nslots;
    if (F.G == 256) { const int vcu = (F.wg & 7) * 32 + (F.wg >> 3); if (vcu < 96) return; slot = (vcu - 96) * NWAVES + F.wave; nslots = 160 * NWAVES; }
    else { slot = F.wg * NWAVES + F.wave; nslots = F.G * NWAVES; }
    for (int i = slot; i < MOE_CONV_ITEMS / 2; i += nslots) conv_moe_item(Q, 1, half * (MOE_CONV_ITEMS / 2) + i, scr, F.lane);
}
DI void ph_prologue(Frame& F) {
    const Ptrs Q = get_ptrs(F);
    TS_MARKP(11);
    LAS float* scr = (LAS float*)(F.lds + F.wave * 16384);
    const int gw = F.wg * NWAVES + F.wave, NGW = F.G * NWAVES;
    constexpr int I_IN = 16 * 92;
    constexpr int I_OUT = 16 * 32;
    constexpr int N_IN = 2 * I_IN, N_OUT = 2 * I_OUT, N_GLU = 2 * 32;
    constexpr int NITEMS = N_IN + N_OUT + N_GLU + MOE_CONV_ITEMS;
    for (int it = gw; it < NITEMS; it += NGW) {
        int r = it;
        if (r < N_IN) { const int l = r / I_IN, q = r % I_IN, kb = q / 92, nb = q % 92;
            transpose_item(Q.in(1) + (size_t)l * DM * DIN, DM, DIN, Q.Win_t() + (size_t)l * DINP * DM, 32 * nb, scr, 64 * kb, 32 * nb, F.lane); continue; }
        r -= N_IN;
        if (r < N_OUT) { const int l = r / I_OUT, q = r % I_OUT, kb = q / 32, nb = q % 32;
            transpose_item(Q.in(2) + (size_t)l * DM * DM, DM, DM, Q.Wout_t() + (size_t)l * DM * DM, 32 * nb, scr, 64 * kb, 32 * nb, F.lane); continue; }
        r -= N_OUT;
        if (r < N_GLU) { const int l = r / 32, q = r % 32, kb = q / 8, nb = q % 8;
            transpose_item(Q.in(11) + (size_t)l * 65536, 256, 256, Q.wglut() + (size_t)l * 65536, 32 * nb, scr, 64 * kb, 32 * nb, F.lane); continue; }
        r -= N_GLU;
        conv_moe_item(Q, 0, r, scr, F.lane);
    }
    TS_MARKP(12);
    const int gt = F.wg * NTHR + F.tid, NGT = F.G * NTHR;
    for (int i = gt; i < 2 * 128 * DM / 8; i += NGT) { const int l = i / (128 * DM / 8), q = i % (128 * DM / 8);
        *(u32x4*)(Q.Win_t() + (size_t)l * DINP * DM + (size_t)DIN * DM + (size_t)q * 8) = (u32x4){0u, 0u, 0u, 0u}; }
    for (int idx = gt; idx < 2048; idx += NGT) { const int s_ = idx >> 6, ln = idx & 63; const float* wp = Q.in(17) + (size_t)(32 * s_ + 8 * (ln >> 4)) * 16 + (ln & 15);
        float w[8], hf[8];
#pragma unroll
        for (int j = 0; j < 8; ++j) w[j] = wp[16 * j];
        const u32x4 h = (u32x4){pk2(w[0], w[1]), pk2(w[2], w[3]), pk2(w[4], w[5]), pk2(w[6], w[7])}; unpack8(h, hf);
        Q.rimg()[idx] = h; Q.rimg()[2048 + idx] = (u32x4){pk2(w[0] - hf[0], w[1] - hf[1]), pk2(w[2] - hf[2], w[3] - hf[3]), pk2(w[4] - hf[4], w[5] - hf[5]), pk2(w[6] - hf[6], w[7] - hf[7])}; }
    for (int i = gt; i < TOK * DM / 8; i += NGT) { const f32x4 a = *(const f32x4*)(Q.in(0) + (size_t)i * 8), b = *(const f32x4*)(Q.in(0) + (size_t)i * 8 + 4);
        u32x4 o; o.x = pk2(a[0], a[1]); o.y = pk2(a[2], a[3]); o.z = pk2(b[0], b[1]); o.w = pk2(b[2], b[3]); *(u32x4*)(Q.XB() + (size_t)i * 8) = o; }
    TS_MARKP(13);
    for (int i = gt; i < 2 * 1024 * 51; i += NGT) { const int e = i % 51, lgn = i / 51, l = lgn >> 10, gn = lgn & 1023, g = gn >> 6;
        float* P = Q.small() + (size_t)l * SSMP_FLOATS;
        const float lr = fminf(Q.in(3)[l * 1024 + gn], -1e-4f), li = Q.in(4)[l * 1024 + gn], dt = expf(Q.in(5)[l * 16 + g]);
        if (e < 35) {
            const float tau = e <= 32 ? (float)e : (e == 33 ? 1.0f : 128.0f);
            float sn_, cs_; sincos_acc(tau * (li * dt), sn_, cs_); const float mg = expf(tau * (lr * dt));
            float* dst = e <= 32 ? P + SP_APOW + (gn * 33 + e) * 2 : (e == 33 ? P + gn * 2 : P + 2048 + gn * 2);
            dst[0] = mg * cs_; dst[1] = mg * sn_;
        } else { const int c = e - 35;
            float sn_, cs_; sincos_acc(li * dt, sn_, cs_);
            const float mag = expf(lr * dt), ar = mag * cs_, ai = mag * sn_;
            const float den = lr * lr + li * li, zr = ar - 1.0f, zi = ai;
            const float fr = (zr * lr + zi * li) / den, fi = (zi * lr - zr * li) / den;
            const float br = Q.in(6)[(size_t)l * 16384 + gn * 16 + c], bi = Q.in(7)[(size_t)l * 16384 + gn * 16 + c];
            P[4096 + (gn * 16 + c) * 2] = fr * br - fi * bi; P[4096 + (gn * 16 + c) * 2 + 1] = fr * bi + fi * br; } }
    TS_MARKP(14);
    __syncthreads();
    { LAS float* w = (LAS float*)F.lds;
      for (int it = F.wg; it < 2 * 16 * 32; it += F.G) { const int tau = it & 31, g = (it >> 5) & 15, l = it >> 9;
        for (int k = 0; k < 2; ++k) { const int idx = F.tid + 512 * k, n = idx >> 4, cp = idx & 15, gn = g * 64 + n;
            const float lr = fminf(Q.in(3)[l * 1024 + gn], -1e-4f), li = Q.in(4)[l * 1024 + gn], dt = expf(Q.in(5)[l * 16 + g]);
            float sn_, cs_; sincos_acc(li * dt, sn_, cs_);
            const float mag = expf(lr * dt), ar = mag * cs_, ai = mag * sn_;
            const float den = lr * lr + li * li, zr = ar - 1.0f, zi = ai;
            const float fr = (zr * lr + zi * li) / den, fi = (zi * lr - zr * li) / den;
            const float br = Q.in(6)[(size_t)l * 16384 + gn * 16 + cp], bi = Q.in(7)[(size_t)l * 16384 + gn * 16 + cp];
            const float bbr = fr * br - fi * bi, bbi = fr * bi + fi * br;
            float sn2, cs2; sincos_acc((float)tau * (li * dt), sn2, cs2);
            const float mg = expf((float)tau * (lr * dt)), pr = mg * cs2, pi = mg * sn2;
            w[idx * 2] = pr * bbr - pi * bbi; w[idx * 2 + 1] = pr * bbi + pi * bbr; }
        __syncthreads();
        if (F.tid < 256) { const int c = F.tid >> 4, cp = F.tid & 15; float acc = 0.f;
            const float* cr = Q.in(8) + (size_t)l * 16384 + (g * 16 + c) * 64; const float* ci = Q.in(9) + (size_t)l * 16384 + (g * 16 + c) * 64;
#pragma unroll 16
            for (int n = 0; n < 64; ++n) acc += cr[n] * w[(n * 16 + cp) * 2] - ci[n] * w[(n * 16 + cp) * 2 + 1];
            (Q.small() + (size_t)l * SSMP_FLOATS)[SP_KT + ((g * 32 + tau) * 16 + c) * 16 + cp] = acc; }
        __syncthreads(); } }
    TS_MARKP(15);
}

DI void p1_range(const Frame& F, int& lo, int& hi, int& step) { if (F.G == 256) { step = 1; if (F.wg < 64) { lo = F.wg * 6; hi = lo + 6; } else { lo = 384 + (F.wg - 64) * 2; hi = lo + 2; } } else { lo = F.wg; hi = 768; step = F.G; } }
DI void ph_kmean(Frame& F) {
    const Ptrs Q = get_ptrs(F);
    LAS float* red = (LAS float*)F.lds;
    int it_lo_, it_hi_, it_st_; p1_range(F, it_lo_, it_hi_, it_st_);
    for (int it = it_lo_; it < it_hi_; it += it_st_) {
        const int b = it / (NH * NKB), h = (it / NKB) % NH, n = it % NKB;
        const bf16* p = Q.PROJ() + (size_t)(b * SEQ + n * KBLK + (F.tid >> 3)) * DINP + C_KA + h * HD + 8 * (F.tid & 7);
        u32x4 v[4];
#pragma unroll
        for (int j = 0; j < 4; ++j) v[j] = *(const u32x4*)(p + (size_t)64 * j * DINP);
        float s[8];
#pragma unroll
        for (int k = 0; k < 8; ++k) s[k] = 0.f;
#pragma unroll
        for (int j = 0; j < 4; ++j) { float x[8]; unpack8(v[j], x);
#pragma unroll
            for (int k = 0; k < 8; ++k) s[k] += x[k]; }
#pragma unroll
        for (int k = 0; k < 8; ++k) { s[k] += dppf<DPP_ROR8>(s[k]); s[k] = swap16_sum(s[k], s[k]); s[k] = swap32_sum(s[k], s[k]); }
        if (F.lane < 8) {
#pragma unroll
            for (int k = 0; k < 8; ++k) red[F.wave * 64 + 8 * F.lane + k] = s[k]; }
        __syncthreads();
        if (F.tid < 64) { float t = 0.f; for (int w = 0; w < 8; ++w) t += red[w * 64 + F.tid]; Q.kmean()[(size_t)((b * NH + h) * NKB + n) * HD + F.tid] = t * (1.0f / 256.0f); }
        __syncthreads();
    }
}
template <int MODE> DI void load_tile128(Frame& F, const bf16* src, LAS float* dst, float log2g) {
    const int row = F.tid >> 2, c0 = (F.tid & 3) * 16;
    const u32x4 a = *(const u32x4*)(src + (size_t)row * DINP + c0), b = *(const u32x4*)(src + (size_t)row * DINP + c0 + 8);
    float v[16]; unpack8(a, v); unpack8(b, v + 8);
    float sc = 1.0f; if (MODE == 1) sc = 0.125f; if (MODE == 2) sc = 0.125f * exp2f(log2g * (float)(127 - row));
#pragma unroll
    for (int k = 0; k < 16; k += 4) *(LAS f32x4*)(dst + row * 64 + c0 + k) = (f32x4){v[k] * sc, v[k + 1] * sc, v[k + 2] * sc, v[k + 3] * sc};
}
DI void ph_ret_kv(Frame& F) {
    const Ptrs Q = get_ptrs(F);
    LAS float* Ks = (LAS float*)F.lds; LAS float* Vs = Ks + 8192;
    for (int it = F.wg; it < BATCH * 128 * NH; it += F.G) {
        const int b = it / (128 * NH), c = (it / NH) % 128, h = it % NH;
        const float lg = ret_log2g(h);
        const bf16* base = Q.PROJ() + (size_t)(b * SEQ + c * 128) * DINP + h * HD;
        load_tile128<2>(F, base + C_KR, Ks, lg); load_tile128<0>(F, base + C_VR, Vs, lg);
        __syncthreads();
        float* o = (float*)Q.retkv() + (size_t)((b * 128 + c) * NH + h) * 4096;
        for (int i = 0; i < 8; ++i) { const int idx = F.tid + 512 * i, dk = idx >> 6, dv = idx & 63; float acc = 0.f;
            for (int j = 0; j < 128; ++j) acc += Ks[j * 64 + dk] * Vs[j * 64 + dv];
            o[idx] = acc; }
        __syncthreads();
    }
}
DI void ph_scans(Frame& F, int l, int blk_lo, int blk_hi, int blk_step) {
    const Ptrs Q = get_ptrs(F);
    const int gt = F.wg * NTHR + F.tid, NGT = F.G * NTHR;
    for (int blk = blk_lo; blk < blk_hi; blk += blk_step) { const int i = blk * NTHR + F.tid; const int e = i & 4095, h = (i >> 12) % NH, b = i / (NH * 4096);
        const float d128 = exp2f(ret_log2g(h) * 128.0f); float st = 0.f;
        bf16* p = Q.retkv() + (size_t)(b * 128 * NH + h) * 4096 + e;
        for (int cb = 0; cb < 128; cb += 16) { float t[16];
#pragma unroll
            for (int c = 0; c < 16; ++c) t[c] = bf2f(p[(size_t)(cb + c) * NH * 4096]);
#pragma unroll
            for (int c = 0; c < 16; ++c) { p[(size_t)(cb + c) * NH * 4096] = (bf16)pk2(st, 0.f); st = st * d128 + t[c]; } } }
    const float* P = Q.small() + (size_t)l * SSMP_FLOATS;
    for (int i = gt; i < (S5_SIMPLE ? BATCH * 16 * 64 : 0); i += NGT) { const int n = i & 63, g = (i >> 6) & 15, b = i >> 10;
        const float ar = P[2048 + (g * 64 + n) * 2], ai = P[2048 + (g * 64 + n) * 2 + 1]; float sr = 0.f, si = 0.f;
        float* p = Q.s5e() + ((size_t)((b * 16 + g) * 128) * 64 + n) * 2;
        for (int cb = 0; cb < 128; cb += 16) { f32x2 t[16];
#pragma unroll
            for (int c = 0; c < 16; ++c) t[c] = *(const f32x2*)(p + (size_t)(cb + c) * 128);
#pragma unroll
            for (int c = 0; c < 16; ++c) { *(f32x2*)(p + (size_t)(cb + c) * 128) = (f32x2){sr, si};
                const float nr = ar * sr - ai * si + t[c][0], ni = ar * si + ai * sr + t[c][1]; sr = nr; si = ni; } } }
}
DI void ph_s5_build(Frame& F, int l) {
    const Ptrs Q = get_ptrs(F);
    const float* P = Q.small() + (size_t)l * SSMP_FLOATS;
    const int gt = F.wg * NTHR + F.tid, NGT = F.G * NTHR;
    for (int i = gt; i < 16 * 768 * 64; i += NGT) { const int k8 = i & 63, row = (i >> 6) % 768, g = i / (768 * 64); const int sidx = k8 >> 1, c0 = (k8 & 1) * 8;
        float v[8];
#pragma unroll
        for (int j = 0; j < 8; ++j) v[j] = 0.f;
        if (row < 512) { const int t = row >> 4, c = row & 15; if (t >= sidx) { const float* kt = P + SP_KT + ((g * 32 + (t - sidx)) * 16 + c) * 16 + c0;
#pragma unroll
                for (int j = 0; j < 8; ++j) v[j] = kt[j]; } }
        else if (row < 640) { const int ri = (row - 512) >> 6, n = (row - 512) & 63; const float pr = P[SP_APOW + ((g * 64 + n) * 33 + (31 - sidx)) * 2], pi = P[SP_APOW + ((g * 64 + n) * 33 + (31 - sidx)) * 2 + 1];
#pragma unroll
            for (int j = 0; j < 8; ++j) { const float br = P[4096 + ((g * 64 + n) * 16 + c0 + j) * 2], bi = P[4096 + ((g * 64 + n) * 16 + c0 + j) * 2 + 1]; v[j] = ri == 0 ? (pr * br - pi * bi) : (pr * bi + pi * br); } }
        *(u32x4*)(Q.s5m() + (size_t)i * 8) = (u32x4){pk2(v[0], v[1]), pk2(v[2], v[3]), pk2(v[4], v[5]), pk2(v[6], v[7])}; }
    const float* cre = Q.in(8) + (size_t)l * 16384; const float* cim = Q.in(9) + (size_t)l * 16384;
    for (int i = gt; i < 16 * 512 * 16; i += NGT) { const int n8 = i & 15, row = (i >> 4) & 511, g = i >> 13; const int t = row >> 4, c = row & 15, ri = n8 >> 3, n0 = (n8 & 7) * 8;
        float v[8];
#pragma unroll
        for (int j = 0; j < 8; ++j) { const int n = n0 + j; const float cr = cre[(g * 16 + c) * 64 + n], ci = cim[(g * 16 + c) * 64 + n];
            const float pr = P[SP_APOW + ((g * 64 + n) * 33 + (t + 1)) * 2], pi = P[SP_APOW + ((g * 64 + n) * 33 + (t + 1)) * 2 + 1];
            v[j] = ri == 0 ? (cr * pr - ci * pi) : -(cr * pi + ci * pr); }
        *(u32x4*)(Q.s5mc() + (size_t)i * 8) = (u32x4){pk2(v[0], v[1]), pk2(v[2], v[3]), pk2(v[4], v[5]), pk2(v[6], v[7])}; }
}
DI void ph_s5_scan2(Frame& F, int l, int it_lo, int it_hi, int it_step) {
    const Ptrs Q = get_ptrs(F);
    const float* P = Q.small() + (size_t)l * SSMP_FLOATS;
    LAS float* sg = (LAS float*)F.lds;
    for (int it = it_lo; it < it_hi; it += it_step) { const int g = it >> 1, b = it & 1; const int n = F.tid & 63, seg = F.tid >> 6;
        const float ar = P[SP_APOW + ((g * 64 + n) * 33 + 32) * 2], ai = P[SP_APOW + ((g * 64 + n) * 33 + 32) * 2 + 1];
        const size_t base = ((size_t)g * 1024 + (size_t)b * 512 + (size_t)seg * 64) * 128 + n;
        const float* e = Q.s5eg() + base; bf16* cb = Q.s5cb() + base;
        float pr[64], pi[64];
        float sr = 0.f, si = 0.f;
#pragma unroll
        for (int c0 = 0; c0 < 64; c0 += 16) { float tr[16], ti[16];
#pragma unroll
            for (int c = 0; c < 16; ++c) { tr[c] = e[(size_t)(c0 + c) * 128]; ti[c] = e[(size_t)(c0 + c) * 128 + 64]; }
#pragma unroll
            for (int c = 0; c < 16; ++c) { pr[c0 + c] = sr; pi[c0 + c] = si; const float nr = ar * sr - ai * si + tr[c], ni = ar * si + ai * sr + ti[c]; sr = nr; si = ni; } }
        sg[(seg * 64 + n) * 2] = sr; sg[(seg * 64 + n) * 2 + 1] = si;
        float mr = ar, mi = ai;
#pragma unroll
        for (int k = 0; k < 6; ++k) { const float nr = mr * mr - mi * mi, ni = 2.0f * mr * mi; mr = nr; mi = ni; }
        __syncthreads();
        float cr = 0.f, ci = 0.f;
        for (int s2 = 0; s2 < seg; ++s2) { const float er = sg[(s2 * 64 + n) * 2], ei = sg[(s2 * 64 + n) * 2 + 1]; const float nr = mr * cr - mi * ci + er, ni = mr * ci + mi * cr + ei; cr = nr; ci = ni; }
#pragma unroll
        for (int c = 0; c < 64; ++c) { cb[(size_t)c * 128] = (bf16)f2bf(pr[c] + cr); cb[(size_t)c * 128 + 64] = (bf16)f2bf(pi[c] + ci);
            const float nr = ar * cr - ai * ci, ni = ar * ci + ai * cr; cr = nr; ci = ni; }
        __syncthreads();
    }
}
DI void ph_ret_out(Frame& F) {
    const Ptrs Q = get_ptrs(F);
    LAS float* Ks = (LAS float*)F.lds; LAS float* Vs = Ks + 8192; LAS float* Ps = Vs + 8192;
    for (int it = F.wg; it < BATCH * 128 * NH; it += F.G) {
        const int tid_ = F.wave * 64 + fresh_lane(); const int i = tid_ >> 2, dq = tid_ & 3;
        const int b = it / (128 * NH), c = (it / NH) % 128, h = it % NH;
        const float lg = ret_log2g(h);
        const size_t row0 = (size_t)(b * SEQ + c * 128);
        const bf16* base = Q.PROJ() + row0 * DINP + h * HD;
        load_tile128<1>(F, base + C_KR, Ks, lg); load_tile128<0>(F, base + C_VR, Vs, lg);
        const float* pv = (const float*)Q.retkv() + (size_t)((b * 128 + c) * NH + h) * 4096;
        for (int k = 0; k < 8; ++k) Ps[F.tid + 512 * k] = pv[F.tid + 512 * k];
        float q[64];
        { const bf16* qp = base + (size_t)i * DINP + C_QR;
#pragma unroll
          for (int k = 0; k < 8; ++k) { const u32x4 a = *(const u32x4*)(qp + 8 * k); unpack8(a, q + 8 * k); } }
        __syncthreads();
        float acc[16];
#pragma unroll
        for (int e = 0; e < 16; ++e) acc[e] = 0.f;
        for (int j = 0; j <= i; ++j) {
            float s = 0.f;
#pragma unroll
            for (int d = 0; d < 64; d += 4) { const f32x4 kk = *(const LAS f32x4*)(Ks + j * 64 + d); s += q[d] * kk[0] + q[d + 1] * kk[1] + q[d + 2] * kk[2] + q[d + 3] * kk[3]; }
            s *= exp2f(lg * (float)(i - j));
#pragma unroll
            for (int e = 0; e < 16; e += 4) { const f32x4 vv = *(const LAS f32x4*)(Vs + j * 64 + dq * 16 + e); acc[e] += s * vv[0]; acc[e + 1] += s * vv[1]; acc[e + 2] += s * vv[2]; acc[e + 3] += s * vv[3]; }
        }
        const float xi = exp2f(lg * (float)(i + 1));
#pragma unroll
        for (int dk = 0; dk < 64; ++dk) { const float qd = q[dk] * xi;
#pragma unroll
            for (int e = 0; e < 16; e += 4) { const f32x4 pp = *(const LAS f32x4*)(Ps + dk * 64 + dq * 16 + e); acc[e] += qd * pp[0]; acc[e + 1] += qd * pp[1]; acc[e + 2] += qd * pp[2]; acc[e + 3] += qd * pp[3]; } }
        float s1 = 0.f;
#pragma unroll
        for (int e = 0; e < 16; ++e) s1 += acc[e];
        s1 += dppf<DPP_XOR1>(s1); s1 += dppf<DPP_XOR2>(s1);
        const float mean = s1 * (1.0f / 64.0f); float s2 = 0.f;
#pragma unroll
        for (int e = 0; e < 16; ++e) { acc[e] -= mean; s2 += acc[e] * acc[e]; }
        s2 += dppf<DPP_XOR1>(s2); s2 += dppf<DPP_XOR2>(s2);
        const float rstd = 1.0f / sqrtf(s2 * (1.0f / 64.0f) + GN_EPS);
        const bf16* gp = base + (size_t)i * DINP + C_GR + dq * 16;
        float gv[16]; { const u32x4 a = *(const u32x4*)gp, bb = *(const u32x4*)(gp + 8); unpack8(a, gv); unpack8(bb, gv + 8); }
        float ov[16];
#pragma unroll
        for (int e = 0; e < 16; ++e) { const float g = gv[e]; ov[e] = acc[e] * rstd * (g / (1.0f + expf(-g))); }
        bf16* op = Q.YMIX() + (row0 + i) * DM + 384 + h * HD + dq * 16;
        *(u32x4*)op = (u32x4){pk2(ov[0], ov[1]), pk2(ov[2], ov[3]), pk2(ov[4], ov[5]), pk2(ov[6], ov[7])};
        *(u32x4*)(op + 8) = (u32x4){pk2(ov[8], ov[9]), pk2(ov[10], ov[11]), pk2(ov[12], ov[13]), pk2(ov[14], ov[15])};
        __syncthreads();
    }
}
DI void s5_load_u(const bf16* up, float* u) { const u32x4 a = *(const u32x4*)up, b = *(const u32x4*)(up + 8); unpack8(a, u); unpack8(b, u + 8); }
DI void ph_s5_local(Frame& F, int l) {
    const Ptrs Q = get_ptrs(F);
    const float* P = Q.small() + (size_t)l * SSMP_FLOATS;
    for (int it = F.wg * NWAVES + F.wave; it < BATCH * 16 * 128; it += F.G * NWAVES) {
        const int ch = it & 127, g = (it >> 7) & 15, b = it >> 11; const int n = F.lane;
        const float ar = P[(g * 64 + n) * 2], ai = P[(g * 64 + n) * 2 + 1];
        float bbr[16], bbi[16];
#pragma unroll
        for (int c = 0; c < 16; ++c) { bbr[c] = P[4096 + ((g * 64 + n) * 16 + c) * 2]; bbi[c] = P[4096 + ((g * 64 + n) * 16 + c) * 2 + 1]; }
        float hr = 0.f, hi = 0.f;
        const bf16* up = Q.PROJ() + (size_t)(b * SEQ + ch * 128) * DINP + C_US + g * 16;
        for (int s = 0; s < 128; ++s) { float u[16]; s5_load_u(up + (size_t)s * DINP, u); float xr = 0.f, xi = 0.f;
#pragma unroll
            for (int c = 0; c < 16; ++c) { xr += bbr[c] * u[c]; xi += bbi[c] * u[c]; }
            const float nr = ar * hr - ai * hi + xr, ni = ar * hi + ai * hr + xi; hr = nr; hi = ni; }
        float* e = Q.s5e() + ((size_t)((b * 16 + g) * 128 + ch) * 64 + n) * 2; e[0] = hr; e[1] = hi;
    }
}
DI float gelu_tanh(float v) { const float z = 0.7978845608028654f * (v + 0.044715f * v * v * v); const float t = 1.0f - 2.0f / (expf(2.0f * z) + 1.0f); return 0.5f * v * (1.0f + t); }
DI void ph_s5_out(Frame& F, int l) {
    const Ptrs Q = get_ptrs(F);
    const float* P = Q.small() + (size_t)l * SSMP_FLOATS;
    LAS float* Cre = (LAS float*)F.lds; LAS float* Cim = Cre + 16 * 65;
    LAS float* hre = Cim + 16 * 65 + F.wave * (2 * 16 * 65); LAS float* him = hre + 16 * 65;
    const float* cre_g = Q.in(8) + (size_t)l * 16384; const float* cim_g = Q.in(9) + (size_t)l * 16384; const float* dsk = Q.in(10) + (size_t)l * 256;
    for (int it = F.wg; it < BATCH * 16 * 16; it += F.G) {
        const int cgp = it & 15, g = (it >> 4) & 15, b = it >> 8; const int ch = cgp * 8 + F.wave; const int n = F.lane;
        for (int idx = F.tid; idx < 1024; idx += NTHR) { const int c = idx >> 6, nn = idx & 63; Cre[c * 65 + nn] = cre_g[(g * 16 + c) * 64 + nn]; Cim[c * 65 + nn] = cim_g[(g * 16 + c) * 64 + nn]; }
        __syncthreads();
        const float ar = P[(g * 64 + n) * 2], ai = P[(g * 64 + n) * 2 + 1];
        float bbr[16], bbi[16];
#pragma unroll
        for (int c = 0; c < 16; ++c) { bbr[c] = P[4096 + ((g * 64 + n) * 16 + c) * 2]; bbi[c] = P[4096 + ((g * 64 + n) * 16 + c) * 2 + 1]; }
        const float* e = Q.s5e() + ((size_t)((b * 16 + g) * 128 + ch) * 64 + n) * 2;
        float hr = e[0], hi = e[1];
        const size_t row0 = (size_t)(b * SEQ + ch * 128);
        const bf16* up = Q.PROJ() + row0 * DINP + C_US + g * 16;
        const int tl = F.lane >> 2, cq = F.lane & 3;
        for (int blk = 0; blk < 8; ++blk) {
            for (int s = 0; s < 16; ++s) { float u[16]; s5_load_u(up + (size_t)(blk * 16 + s) * DINP, u); float xr = 0.f, xi = 0.f;
#pragma unroll
                for (int c = 0; c < 16; ++c) { xr += bbr[c] * u[c]; xi += bbi[c] * u[c]; }
                const float nr = ar * hr - ai * hi + xr, ni = ar * hi + ai * hr + xi; hr = nr; hi = ni;
                hre[s * 65 + n] = hr; him[s * 65 + n] = hi; }
            __builtin_amdgcn_wave_barrier();
            float y[4] = {0.f, 0.f, 0.f, 0.f};
            for (int n2 = 0; n2 < 64; ++n2) { const float a = hre[tl * 65 + n2], bq = him[tl * 65 + n2];
#pragma unroll
                for (int k = 0; k < 4; ++k) y[k] += a * Cre[(4 * cq + k) * 65 + n2] - bq * Cim[(4 * cq + k) * 65 + n2]; }
            __builtin_amdgcn_wave_barrier();
            const size_t t = row0 + blk * 16 + tl;
            const u32x2 uu = *(const u32x2*)(Q.PROJ() + t * DINP + C_US + g * 16 + 4 * cq);
            const float u0 = __uint_as_float(uu.x << 16), u1 = __uint_as_float(uu.x & 0xffff0000u), u2 = __uint_as_float(uu.y << 16), u3 = __uint_as_float(uu.y & 0xffff0000u);
            f32x4 o; o[0] = gelu_tanh(y[0] + dsk[g * 16 + 4 * cq] * u0); o[1] = gelu_tanh(y[1] + dsk[g * 16 + 4 * cq + 1] * u1);
            o[2] = gelu_tanh(y[2] + dsk[g * 16 + 4 * cq + 2] * u2); o[3] = gelu_tanh(y[3] + dsk[g * 16 + 4 * cq + 3] * u3);
            *(f32x4*)(Q.yg() + t * 256 + g * 16 + 4 * cq) = o;
        }
        __syncthreads();
    }
}
DI void ph_s5_glu(Frame& F, int l) {
    const Ptrs Q = get_ptrs(F);
    LAS float* ys = (LAS float*)F.lds;
    const float* W = Q.in(11) + (size_t)l * 65536; const float* bg = Q.in(12) + (size_t)l * 256;
    const int j = F.tid & 255, half = F.tid >> 8;
    for (int it = F.wg; it < TOK / 64; it += F.G) {
        const float* src = Q.yg() + (size_t)it * 64 * 256;
        for (int k = 0; k < 8; ++k) { const int idx = (F.tid + 512 * k) * 4; *(LAS f32x4*)(ys + idx) = *(const f32x4*)(src + idx); }
        __syncthreads();
        float acc[32];
        const float b0 = bg[j];
#pragma unroll
        for (int tk = 0; tk < 32; ++tk) acc[tk] = b0;
        for (int i = 0; i < 256; i += 4) { const float w0 = W[(i) * 256 + j], w1 = W[(i + 1) * 256 + j], w2 = W[(i + 2) * 256 + j], w3 = W[(i + 3) * 256 + j];
#pragma unroll
            for (int tk = 0; tk < 32; ++tk) { const f32x4 yv = *(const LAS f32x4*)(ys + (half * 32 + tk) * 256 + i); acc[tk] += yv[0] * w0 + yv[1] * w1 + yv[2] * w2 + yv[3] * w3; } }
#pragma unroll
        for (int tk = 0; tk < 32; ++tk) { const float yv = ys[(half * 32 + tk) * 256 + j]; const float o = yv / (1.0f + expf(-acc[tk]));
            Q.YMIX()[((size_t)it * 64 + half * 32 + tk) * DM + 768 + j] = (bf16)f2bf(o); }
        __syncthreads();
    }
}
DI void ph_moba_simple(Frame& F) {
    const Ptrs Q = get_ptrs(F);
    LAS float* km = (LAS float*)F.lds;
    for (int it = F.wg; it < BATCH * NH * 32; it += F.G) {
        const int qc = it & 31, h = (it >> 5) % NH, b = it / (NH * 32);
        const float* kmg = Q.kmean() + (size_t)(b * NH + h) * 4096;
        for (int k = 0; k < 8; ++k) km[F.tid + 512 * k] = kmg[F.tid + 512 * k];
        __syncthreads();
        const int t = qc * 512 + F.tid; const int own = t >> 8; const size_t row = (size_t)b * SEQ + t;
        float q[64];
        { const bf16* qp = Q.PROJ() + row * DINP + C_QA + h * HD;
#pragma unroll
          for (int k = 0; k < 8; ++k) { const u32x4 a = *(const u32x4*)(qp + 8 * k); unpack8(a, q + 8 * k); } }
        float v0 = -INFINITY, v1 = -INFINITY, v2 = -INFINITY; int i0 = 0, i1 = 0, i2 = 0;
        for (int n = 0; n < own; ++n) { float g = 0.f;
#pragma unroll
            for (int d = 0; d < 64; d += 4) { const f32x4 kk = *(const LAS f32x4*)(km + n * 64 + d); g += q[d] * kk[0] + q[d + 1] * kk[1] + q[d + 2] * kk[2] + q[d + 3] * kk[3]; }
            if (g > v0) { v2 = v1; i2 = i1; v1 = v0; i1 = i0; v0 = g; i0 = n; } else if (g > v1) { v2 = v1; i2 = i1; v1 = g; i1 = n; } else if (g > v2) { v2 = g; i2 = n; } }
        const int nsel = own < 3 ? own : 3;
        const float slope = alibi_slope(h);
        float m = -INFINITY, lsum = 0.f; float o[64];
#pragma unroll
        for (int d = 0; d < 64; ++d) o[d] = 0.f;
        for (int p = 0; p < 4; ++p) {
            if (p < 3 && p >= nsel) continue;
            const int blk = p == 0 ? i0 : p == 1 ? i1 : p == 2 ? i2 : own;
            const int kend = p == 3 ? (t & 255) : 255;
            const bf16* kp = Q.PROJ() + ((size_t)b * SEQ + (size_t)blk * 256) * DINP + h * HD;
            for (int s = 0; s <= kend; ++s) {
                float kv[64];
#pragma unroll
                for (int k = 0; k < 8; ++k) { const u32x4 a = *(const u32x4*)(kp + (size_t)s * DINP + C_KA + 8 * k); unpack8(a, kv + 8 * k); }
                float dot = 0.f;
#pragma unroll
                for (int d = 0; d < 64; ++d) dot += q[d] * kv[d];
                const float sc = dot * 0.125f - slope * (float)(t - (blk * 256 + s));
                if (sc > m) { const float corr = expf(m - sc); lsum *= corr;
#pragma unroll
                    for (int d = 0; d < 64; ++d) o[d] *= corr;
                    m = sc; }
                const float pw = expf(sc - m); lsum += pw;
#pragma unroll
                for (int k = 0; k < 8; ++k) { const u32x4 a = *(const u32x4*)(kp + (size_t)s * DINP + C_VA + 8 * k); unpack8(a, kv + 8 * k); }
#pragma unroll
                for (int d = 0; d < 64; ++d) o[d] += pw * kv[d];
            }
        }
        const float inv = 1.0f / lsum;
        bf16* op = Q.YMIX() + row * DM + h * HD;
#pragma unroll
        for (int k = 0; k < 8; ++k) *(u32x4*)(op + 8 * k) = (u32x4){pk2(o[8 * k] * inv, o[8 * k + 1] * inv), pk2(o[8 * k + 2] * inv, o[8 * k + 3] * inv), pk2(o[8 * k + 4] * inv, o[8 * k + 5] * inv), pk2(o[8 * k + 6] * inv, o[8 * k + 7] * inv)};
        __syncthreads();
    }
}

typedef float f32x16 __attribute__((ext_vector_type(16)));
typedef short s16x4 __attribute__((ext_vector_type(4)));
DI int crow16(int r, int hi) { return (r & 3) + 8 * (r >> 2) + 4 * hi; }
DI int mlist_base(int n) { return 256 * (63 * n - (n * (n - 1)) / 2); }
#define TOP3_INS(G, N, V0, V1, V2, I0, I1, I2) do { const float g_ = (G); const int n_ = (N); \
    if (g_ > V0) { V2 = V1; I2 = I1; V1 = V0; I1 = I0; V0 = g_; I0 = n_; } else if (g_ > V1) { V2 = V1; I2 = I1; V1 = g_; I1 = n_; } else if (g_ > V2) { V2 = g_; I2 = n_; } } while (0)
DI void ph_moba_gate(Frame& F, int l, int it_lo, int it_hi, int it_step) {
    const Ptrs Q = get_ptrs(F);
    LAS float* km = (LAS float*)F.lds;
    unsigned* mcnt = Q.ctl() + CW_MCNT + 1024 * l;
    for (int it = it_lo; it < it_hi; it += it_step) {
        const int qc = it & 31, h = (it >> 5) % NH, b = it / (NH * 32);
        const float* kmg = Q.kmean() + (size_t)(b * NH + h) * 4096;
        for (int k = 0; k < 8; ++k) { const int idx = F.tid + 512 * k; km[(idx >> 6) * 68 + (idx & 63)] = kmg[idx]; }
        const int lane = F.lane, ql = lane & 31, hi = lane >> 5;
        const int t = qc * 512 + F.tid; const int own = __builtin_amdgcn_readfirstlane(t >> 8);
        bf16x8 qf[2][4];
#pragma unroll
        for (int qt = 0; qt < 2; ++qt) { const bf16* qp = Q.PROJ() + ((size_t)b * SEQ + qc * 512 + F.wave * 64 + 32 * qt + ql) * DINP + C_QA + h * HD + 8 * hi;
#pragma unroll
            for (int ks = 0; ks < 4; ++ks) qf[qt][ks] = *(const bf16x8*)(qp + 16 * ks); }
        __syncthreads();
        f32x16 acc[2][2];
#pragma unroll
        for (int nt = 0; nt < 2; ++nt)
#pragma unroll
            for (int qt = 0; qt < 2; ++qt)
#pragma unroll
                for (int r = 0; r < 16; ++r) acc[nt][qt][r] = 0.f;
#pragma unroll
        for (int nt = 0; nt < 2; ++nt) { if (32 * nt < own) {
#pragma unroll
            for (int ks = 0; ks < 4; ++ks) { const LAS float* kp = km + (32 * nt + ql) * 68 + 16 * ks + 8 * hi; const f32x4 a = *(const LAS f32x4*)kp, c = *(const LAS f32x4*)(kp + 4);
                const unsigned h0 = pk2(a[0], a[1]), h1 = pk2(a[2], a[3]), h2 = pk2(c[0], c[1]), h3 = pk2(c[2], c[3]);
                const unsigned l0 = pk2(a[0] - __uint_as_float(h0 << 16), a[1] - __uint_as_float(h0 & 0xffff0000u)), l1 = pk2(a[2] - __uint_as_float(h1 << 16), a[3] - __uint_as_float(h1 & 0xffff0000u));
                const unsigned l2 = pk2(c[0] - __uint_as_float(h2 << 16), c[1] - __uint_as_float(h2 & 0xffff0000u)), l3 = pk2(c[2] - __uint_as_float(h3 << 16), c[3] - __uint_as_float(h3 & 0xffff0000u));
                const bf16x8 khi = __builtin_bit_cast(bf16x8, (u32x4){h0, h1, h2, h3}), klo = __builtin_bit_cast(bf16x8, (u32x4){l0, l1, l2, l3});
#pragma unroll
                for (int qt = 0; qt < 2; ++qt) { acc[nt][qt] = __builtin_amdgcn_mfma_f32_32x32x16_bf16(khi, qf[qt][ks], acc[nt][qt], 0, 0, 0); acc[nt][qt] = __builtin_amdgcn_mfma_f32_32x32x16_bf16(klo, qf[qt][ks], acc[nt][qt], 0, 0, 0); } } } }
        float tv[2][3]; int ti[2][3];
#pragma unroll
        for (int qt = 0; qt < 2; ++qt) { float v0 = -INFINITY, v1 = -INFINITY, v2 = -INFINITY; int i0 = 0, i1 = 0, i2 = 0;
#pragma unroll
            for (int nt = 0; nt < 2; ++nt)
#pragma unroll
                for (int r = 0; r < 16; ++r) { const int n = 32 * nt + crow16(r, 0) + 4 * hi; const float g = n < own ? acc[nt][qt][r] : -INFINITY; TOP3_INS(g, n, v0, v1, v2, i0, i1, i2); }
            tv[qt][0] = v0; tv[qt][1] = v1; tv[qt][2] = v2; ti[qt][0] = i0; ti[qt][1] = i1; ti[qt][2] = i2; }
        float v0, v1, v2; int i0, i1, i2;
        v0 = hi ? tv[1][0] : tv[0][0]; v1 = hi ? tv[1][1] : tv[0][1]; v2 = hi ? tv[1][2] : tv[0][2]; i0 = hi ? ti[1][0] : ti[0][0]; i1 = hi ? ti[1][1] : ti[0][1]; i2 = hi ? ti[1][2] : ti[0][2];
#pragma unroll
        for (int k = 0; k < 3; ++k) { const auto rv = __builtin_amdgcn_permlane32_swap(__float_as_uint(tv[0][k]), __float_as_uint(tv[1][k]), false, false); const auto ri = __builtin_amdgcn_permlane32_swap((unsigned)ti[0][k], (unsigned)ti[1][k], false, false);
            const float pg = __uint_as_float(hi ? rv[0] : rv[1]); const int pn = (int)(hi ? ri[0] : ri[1]);
            TOP3_INS(pg, pn, v0, v1, v2, i0, i1, i2); }
        const int nsel = own < 3 ? own : 3;
        unsigned short* lst = Q.mlist() + (size_t)(b * NH + h) * MLIST_PER_BH;
        unsigned* cn = mcnt + (b * NH + h) * 64;
        LAS unsigned* lc = (LAS unsigned*)(F.lds + 20480); LAS unsigned* lb = lc + 64;
        if (F.tid < 64) lc[F.tid] = 0u;
        __syncthreads();
        unsigned rk[3];
#pragma unroll
        for (int j = 0; j < 3; ++j) { rk[j] = 0u; if (j < nsel) { const int n = j == 0 ? i0 : j == 1 ? i1 : i2; rk[j] = __hip_atomic_fetch_add(&lc[n], 1u, __ATOMIC_RELAXED, __HIP_MEMORY_SCOPE_WORKGROUP); } }
        __syncthreads();
        if (F.tid < 64) { const unsigned c = lc[F.tid]; lb[F.tid] = c ? atomicAdd(&cn[F.tid], c) : 0u; }
        __syncthreads();
#pragma unroll
        for (int j = 0; j < 3; ++j) { if (j < nsel) { const int n = j == 0 ? i0 : j == 1 ? i1 : i2; lst[mlist_base(n) + lb[n] + rk[j]] = (unsigned short)(t | (j << 14)); } }
        __syncthreads();
    }
}
DI void ph_moba_gate2(Frame& F, int l, int itA, int itB) {
    const Ptrs Q = get_ptrs(F);
    LAS float* km = (LAS float*)F.lds;
    unsigned* mcnt = Q.ctl() + CW_MCNT + 1024 * l;
    const int h = (itA >> 5) % NH, b = itA / (NH * 32);
    const float* kmg = Q.kmean() + (size_t)(b * NH + h) * 4096;
#pragma unroll
    for (int k = 0; k < 8; ++k) { const int idx = F.tid + 512 * k; km[(idx >> 6) * 68 + (idx & 63)] = kmg[idx]; }
    LAS unsigned* lc = (LAS unsigned*)(F.lds + 20480); LAS unsigned* lb = lc + 64;
    if (F.tid < 64) lc[F.tid] = 0u;
    __syncthreads();
    const int lane = F.lane, ql = lane & 31, hi = lane >> 5;
    int sel[2][3], tq[2], ns[2];
#pragma unroll
    for (int u = 0; u < 2; ++u) {
        const int qc = (u ? itB : itA) & 31;
        const int t = qc * 512 + F.tid; const int own = __builtin_amdgcn_readfirstlane(t >> 8);
        bf16x8 qf[2][4];
#pragma unroll
        for (int qt = 0; qt < 2; ++qt) { const bf16* qp = Q.PROJ() + ((size_t)b * SEQ + qc * 512 + F.wave * 64 + 32 * qt + ql) * DINP + C_QA + h * HD + 8 * hi;
#pragma unroll
            for (int ks = 0; ks < 4; ++ks) qf[qt][ks] = *(const bf16x8*)(qp + 16 * ks); }
        f32x16 acc[2][2];
#pragma unroll
        for (int nt = 0; nt < 2; ++nt)
#pragma unroll
            for (int qt = 0; qt < 2; ++qt)
#pragma unroll
                for (int r = 0; r < 16; ++r) acc[nt][qt][r] = 0.f;
#pragma unroll
        for (int nt = 0; nt < 2; ++nt) { if (32 * nt < own) {
#pragma unroll
            for (int ks = 0; ks < 4; ++ks) { const LAS float* kp = km + (32 * nt + ql) * 68 + 16 * ks + 8 * hi; const f32x4 a = *(const LAS f32x4*)kp, c = *(const LAS f32x4*)(kp + 4);
                const unsigned h0 = pk2(a[0], a[1]), h1 = pk2(a[2], a[3]), h2 = pk2(c[0], c[1]), h3 = pk2(c[2], c[3]);
                const unsigned l0 = pk2(a[0] - __uint_as_float(h0 << 16), a[1] - __uint_as_float(h0 & 0xffff0000u)), l1 = pk2(a[2] - __uint_as_float(h1 << 16), a[3] - __uint_as_float(h1 & 0xffff0000u));
                const unsigned l2 = pk2(c[0] - __uint_as_float(h2 << 16), c[1] - __uint_as_float(h2 & 0xffff0000u)), l3 = pk2(c[2] - __uint_as_float(h3 << 16), c[3] - __uint_as_float(h3 & 0xffff0000u));
                const bf16x8 khi = __builtin_bit_cast(bf16x8, (u32x4){h0, h1, h2, h3}), klo = __builtin_bit_cast(bf16x8, (u32x4){l0, l1, l2, l3});
#pragma unroll
                for (int qt = 0; qt < 2; ++qt) { acc[nt][qt] = __builtin_amdgcn_mfma_f32_32x32x16_bf16(khi, qf[qt][ks], acc[nt][qt], 0, 0, 0); acc[nt][qt] = __builtin_amdgcn_mfma_f32_32x32x16_bf16(klo, qf[qt][ks], acc[nt][qt], 0, 0, 0); } } } }
        float tv[2][3]; int ti[2][3];
#pragma unroll
        for (int qt = 0; qt < 2; ++qt) { float v0 = -INFINITY, v1 = -INFINITY, v2 = -INFINITY; int i0 = 0, i1 = 0, i2 = 0;
#pragma unroll
            for (int nt = 0; nt < 2; ++nt)
#pragma unroll
                for (int r = 0; r < 16; ++r) { const int n = 32 * nt + crow16(r, 0) + 4 * hi; const float g = n < own ? acc[nt][qt][r] : -INFINITY; TOP3_INS(g, n, v0, v1, v2, i0, i1, i2); }
            tv[qt][0] = v0; tv[qt][1] = v1; tv[qt][2] = v2; ti[qt][0] = i0; ti[qt][1] = i1; ti[qt][2] = i2; }
        float v0, v1, v2; int i0, i1, i2;
        v0 = hi ? tv[1][0] : tv[0][0]; v1 = hi ? tv[1][1] : tv[0][1]; v2 = hi ? tv[1][2] : tv[0][2]; i0 = hi ? ti[1][0] : ti[0][0]; i1 = hi ? ti[1][1] : ti[0][1]; i2 = hi ? ti[1][2] : ti[0][2];
#pragma unroll
        for (int k = 0; k < 3; ++k) { const auto rv = __builtin_amdgcn_permlane32_swap(__float_as_uint(tv[0][k]), __float_as_uint(tv[1][k]), false, false); const auto ri = __builtin_amdgcn_permlane32_swap((unsigned)ti[0][k], (unsigned)ti[1][k], false, false);
            const float pg = __uint_as_float(hi ? rv[0] : rv[1]); const int pn = (int)(hi ? ri[0] : ri[1]);
            TOP3_INS(pg, pn, v0, v1, v2, i0, i1, i2); }
        sel[u][0] = i0; sel[u][1] = i1; sel[u][2] = i2; tq[u] = t; ns[u] = own < 3 ? own : 3;
    }
    unsigned short* lst = Q.mlist() + (size_t)(b * NH + h) * MLIST_PER_BH;
    unsigned* cn = mcnt + (b * NH + h) * 64;
    unsigned rk[2][3];
#pragma unroll
    for (int u = 0; u < 2; ++u)
#pragma unroll
        for (int j = 0; j < 3; ++j) { rk[u][j] = 0u; if (j < ns[u]) rk[u][j] = __hip_atomic_fetch_add(&lc[sel[u][j]], 1u, __ATOMIC_RELAXED, __HIP_MEMORY_SCOPE_WORKGROUP); }
    __syncthreads();
    if (F.tid < 64) { const unsigned c = lc[F.tid]; lb[F.tid] = c ? atomicAdd(&cn[F.tid], c) : 0u; }
    __syncthreads();
#pragma unroll
    for (int u = 0; u < 2; ++u)
#pragma unroll
        for (int j = 0; j < 3; ++j) { if (j < ns[u]) { const int n = sel[u][j]; lst[mlist_base(n) + lb[n] + rk[u][j]] = (unsigned short)(tq[u] | (j << 14)); } }
    __syncthreads();
}
DI void ph_moba_attn(Frame& F, int l) {
    const Ptrs Q0 = get_ptrs(F);
    LAS unsigned char* Ks = F.lds; LAS unsigned char* Vs = F.lds + 32768; LAS unsigned char* Os = F.lds + 65536 + F.wave * 4096;
    LAS int* pre = (LAS int*)(F.lds + 65536 + 32768);
    const unsigned* mcnt0 = Q0.ctl() + CW_MCNT + 1024 * l;
    { int a0 = 0, a1 = 0;
      if (F.tid < 384) { const unsigned c0 = __hip_atomic_load(mcnt0 + 2 * F.tid, __ATOMIC_RELAXED, __HIP_MEMORY_SCOPE_AGENT), c1 = __hip_atomic_load(mcnt0 + 2 * F.tid + 1, __ATOMIC_RELAXED, __HIP_MEMORY_SCOPE_AGENT);
          a0 = 1 + (int)((c0 + 255u) >> 8); a1 = 1 + (int)((c1 + 255u) >> 8); pre[1024 + 2 * F.tid] = (int)c0; pre[1025 + 2 * F.tid] = (int)c1; }
      int sc = a0 + a1;
#pragma unroll
      for (int o = 1; o < 64; o <<= 1) { const int v = __builtin_amdgcn_ds_bpermute((F.lane - o) << 2, sc); if (F.lane >= o) sc += v; }
      if (F.lane == 63) pre[800 + F.wave] = sc;
      __syncthreads();
      int wb = 0;
      for (int w = 0; w < 8; ++w) { const int v = pre[800 + w]; if (w < F.wave) wb += v; }
      const int incl = wb + sc;
      if (F.tid < 384) { pre[2 * F.tid + 1] = incl - a1; pre[2 * F.tid + 2] = incl; }
      if (F.tid == 0) pre[0] = 0;
      __syncthreads(); }
    const int nitems = __builtin_amdgcn_readfirstlane(pre[768]);
    const float C2 = 0.125f * 1.4426950408889634f;
    constexpr int MOBA_W = 5;
    int it_lo, it_hi;
    if (F.G == 256) {
        const int v = (F.wg & 7) * 32 + (F.wg >> 3); const int tn = nitems + 128 * MOBA_W;
        const int s0 = 16 * (v >> 5) + ((v & 31) > 16 ? (v & 31) - 16 : 0), s1 = 16 * ((v + 1) >> 5) + (((v + 1) & 31) > 16 ? ((v + 1) & 31) - 16 : 0);
        it_lo = (v * tn) / 256 - MOBA_W * s0; it_hi = ((v + 1) * tn) / 256 - MOBA_W * s1; }
    else { it_lo = (int)(((long)F.wg * nitems) / F.G); it_hi = (int)(((long)(F.wg + 1) * nitems) / F.G); }
    if (it_lo < it_hi) {
#define MC_ADV(E, C, NC, CN) do { if ((C) + 1 < (NC)) { (C) = (C) + 1; } else { (E) = (E) + 1; (C) = 0; (NC) = __builtin_amdgcn_readfirstlane(pre[(E) + 1] - pre[(E)]); (CN) = __builtin_amdgcn_readfirstlane(pre[1024 + (E)]); } } while (0)
#define MC_ENTRY(E, C, CN, LQ) ((C) == 0 ? 0u : ((((C) - 1) * 256 + (LQ)) < (CN) ? (0x10000u | (unsigned)Q0.mlist()[(size_t)((E) >> 6) * MLIST_PER_BH + mlist_base((E) & 63) + ((C) - 1) * 256 + (LQ)]) : 0u))
#define MC_TJ(E, C, RAW, LQ) ((C) == 0 ? ((((E) & 63) * 256 + (LQ)) * 4 + 3) : (((RAW) & 0x10000u) ? (int)((((RAW) & 0x3fffu) << 2) | (((RAW) >> 14) & 3u)) : -1))
    int ent, chunk, nchk, cnt;
    { int lo = 0, hiE = 768;
      while (hiE - lo > 1) { const int mid = (lo + hiE) >> 1; if (pre[mid] <= it_lo) lo = mid; else hiE = mid; }
      ent = __builtin_amdgcn_readfirstlane(lo); chunk = it_lo - __builtin_amdgcn_readfirstlane(pre[ent]); nchk = __builtin_amdgcn_readfirstlane(pre[ent + 1] - pre[ent]); cnt = __builtin_amdgcn_readfirstlane(pre[1024 + ent]); }
    int ent1 = ent, chunk1 = chunk, nchk1 = nchk, cnt1 = cnt; MC_ADV(ent1, chunk1, nchk1, cnt1);
    const int wq = F.wave < 4 ? F.wave : 11 - F.wave;
    const int lq0 = wq * 32 + (F.lane & 31);
    int tj_cur = MC_TJ(ent, chunk, MC_ENTRY(ent, chunk, cnt, lq0), lq0);
    unsigned raw_nxt = (it_lo + 1 < it_hi) ? MC_ENTRY(ent1, chunk1, cnt1, lq0) : 0u;
    bf16x8 qf[4];
    { const int bh = ent >> 6; const int t = tj_cur >= 0 ? (tj_cur >> 2) : (ent & 63) * 256;
      const bf16* qp = Q0.PROJ() + ((size_t)(bh / NH) * SEQ + t) * DINP + C_QA + (bh % NH) * HD + 8 * (F.lane >> 5);
#pragma unroll
      for (int ks = 0; ks < 4; ++ks) qf[ks] = *(const bf16x8*)(qp + 16 * ks); }
    int prev_ent = -1;
    for (int it = it_lo; it < it_hi; ++it) {
        const int lane = fresh_lane();
        const int ql = lane & 31, hi = lane >> 5; const int tid = F.wave * 64 + lane;
        const Ptrs Q = get_ptrs(F);
        const int n = ent & 63, bh = ent >> 6, h = bh % NH, b = bh / NH;
        if (ent != prev_ent) { if (prev_ent >= 0) __syncthreads();
          const int r0 = tid >> 3, ch = tid & 7;
          const bf16* kp = Q.PROJ() + ((size_t)b * SEQ + (size_t)n * 256 + r0) * DINP + C_KA + h * HD + ch * 8;
          const bf16* vp = kp + (C_VA - C_KA);
          u32x4 kv[4], vv[4];
#pragma unroll
          for (int c = 0; c < 4; ++c) { kv[c] = *(const u32x4*)(kp + (size_t)64 * c * DINP); vv[c] = *(const u32x4*)(vp + (size_t)64 * c * DINP); }
#pragma unroll
          for (int c = 0; c < 4; ++c) { const int r = r0 + 64 * c; *(LAS u32x4*)(Ks + r * 128 + ((ch ^ (r & 7)) << 4)) = kv[c]; *(LAS u32x4*)(Vs + r * 128 + (ch << 4)) = vv[c]; }
          __syncthreads(); prev_ent = ent; }
        const int e0 = wq * 32 + ql;
        const bool has_next = it + 1 < it_hi;
        const int tj_nxt = has_next ? MC_TJ(ent1, chunk1, raw_nxt, e0) : -1;
        bf16x8 qn[4];
        { const int bh1 = ent1 >> 6; const int t1 = tj_nxt >= 0 ? (tj_nxt >> 2) : (ent1 & 63) * 256;
          const bf16* qp = Q.PROJ() + ((size_t)(bh1 / NH) * SEQ + t1) * DINP + C_QA + (bh1 % NH) * HD + 8 * hi;
          if (has_next) {
#pragma unroll
              for (int ks = 0; ks < 4; ++ks) qn[ks] = *(const bf16x8*)(qp + 16 * ks); }
          else {
#pragma unroll
              for (int ks = 0; ks < 4; ++ks) qn[ks] = qf[ks]; } }
        int ent2 = ent1, chunk2 = chunk1, nchk2 = nchk1, cnt2 = cnt1; MC_ADV(ent2, chunk2, nchk2, cnt2);
        const unsigned raw_nn = (it + 2 < it_hi) ? MC_ENTRY(ent2, chunk2, cnt2, e0) : 0u;
        const bool valid = tj_cur >= 0; const int t = valid ? (tj_cur >> 2) : n * 256; const int js = tj_cur & 3;
        const bool wave_work = __builtin_amdgcn_readfirstlane((int)__any((int)valid)) != 0;
        if (wave_work) {
            const float slope2 = alibi_slope(h) * 1.4426950408889634f;
            f32x16 acc[8];
            const float kst = slope2 * (1.0f / C2); const float zoffs = kst * (float)(n * 256 + 4 * hi - t);
            bf16x8 kfr[2][4];
#define MOBA_LDK(buf, kt_) do { _Pragma("unroll") for (int ks = 0; ks < 4; ++ks) { const int row = 32 * (kt_) + ql; kfr[buf][ks] = *(const LAS bf16x8*)(Ks + row * 128 + ((((2 * ks + hi)) ^ (row & 7)) << 4)); } } while (0)
            MOBA_LDK(0, 0);
            const int ktmax = chunk == 0 ? wq : 7;
#pragma unroll
            for (int kt = 0; kt < 8; ++kt) {
                if (kt < 7) MOBA_LDK((kt + 1) & 1, kt + 1);
                if (kt <= ktmax) {
                const float zk = zoffs + kst * (float)(32 * kt);
#pragma unroll
                for (int r = 0; r < 16; ++r) acc[kt][r] = __builtin_fmaf(kst, (float)(8 * (r >> 2) + (r & 3)), zk);
#pragma unroll
                for (int ks = 0; ks < 4; ++ks) acc[kt] = __builtin_amdgcn_mfma_f32_32x32x16_bf16(kfr[kt & 1][ks], qf[ks], acc[kt], 0, 0, 0);
                } else {
#pragma unroll
                for (int r = 0; r < 16; ++r) acc[kt][r] = -1e30f; }
                __builtin_amdgcn_sched_barrier(0); }
#undef MOBA_LDK
            if (chunk == 0) {
                int e0o = e0 - 4 * hi; asm volatile("" : "+v"(e0o));
#pragma unroll
                for (int kt = 0; kt < 8; ++kt) { const int dq = e0o - 32 * kt;
#pragma unroll
                    for (int r = 0; r < 16; ++r) { if (crow16(r, 0) > dq) acc[kt][r] = -1e30f; } } }
            float mxa[4] = {acc[0][0], acc[0][1], acc[0][2], acc[0][3]};
#pragma unroll
            for (int kt = 0; kt < 8; ++kt)
#pragma unroll
                for (int r = 0; r < 16; ++r) mxa[r & 3] = fmaxf(mxa[r & 3], acc[kt][r]);
            float mx = xor32_max(fmaxf(fmaxf(mxa[0], mxa[1]), fmaxf(mxa[2], mxa[3])));
            const float mz = mx * C2;
            f32x16 o0, o1;
#pragma unroll
            for (int r = 0; r < 16; ++r) { o0[r] = 0.f; o1[r] = 0.f; }
            f32x2 lsv[4] = {{0.f, 0.f}, {0.f, 0.f}, {0.f, 0.f}, {0.f, 0.f}}; const f32x2 c2v = {C2, C2}, nmz = {-mz, -mz};
            const int qrow = (lane & 15) >> 2, pp = lane & 3, g1 = (lane >> 4) & 1;
            const LAS unsigned char* vb = Vs + (4 * hi + qrow) * 128 + (16 * g1 + 4 * pp) * 2;
#pragma unroll
            for (int kt = 0; kt < 8; ++kt) { if (kt <= ktmax) {
                unsigned pk[8];
#pragma unroll
                for (int r = 0; r < 16; r += 2) { const f32x2 e_ = __builtin_elementwise_fma((f32x2){acc[kt][r], acc[kt][r + 1]}, c2v, nmz); const f32x2 p_ = {__builtin_amdgcn_exp2f(e_[0]), __builtin_amdgcn_exp2f(e_[1])}; lsv[(r >> 1) & 3] += p_; pk[r >> 1] = pk2(p_[0], p_[1]); }
#pragma unroll
                for (int s = 0; s < 2; ++s) {
                    const bf16x8 pf = __builtin_bit_cast(bf16x8, (u32x4){pk[4 * s], pk[4 * s + 1], pk[4 * s + 2], pk[4 * s + 3]});
#pragma unroll
                    for (int dt = 0; dt < 2; ++dt) {
                        const LAS unsigned char* va = vb + (32 * kt + 16 * s) * 128 + 64 * dt;
                        const s16x4 lo4 = __builtin_bit_cast(s16x4, __builtin_amdgcn_ds_read_tr16_b64_v4i16((LAS s16x4*)va));
                        const s16x4 hi4 = __builtin_bit_cast(s16x4, __builtin_amdgcn_ds_read_tr16_b64_v4i16((LAS s16x4*)(va + 8 * 128)));
                        const bf16x8 vf = (bf16x8){lo4[0], lo4[1], lo4[2], lo4[3], hi4[0], hi4[1], hi4[2], hi4[3]};
                        if (dt == 0) o0 = __builtin_amdgcn_mfma_f32_32x32x16_bf16(pf, vf, o0, 0, 0, 0); else o1 = __builtin_amdgcn_mfma_f32_32x32x16_bf16(pf, vf, o1, 0, 0, 0);
                    } } }
                __builtin_amdgcn_sched_barrier(0); }
            const f32x2 lst_ = (lsv[0] + lsv[1]) + (lsv[2] + lsv[3]); const float lsum = xor32_sum(lst_[0] + lst_[1]);
#pragma unroll
            for (int r = 0; r < 16; ++r) { const int qq = crow16(r, hi); *(LAS unsigned short*)(Os + qq * 128 + ql * 2) = (unsigned short)pk2(o0[r], 0.f); *(LAS unsigned short*)(Os + qq * 128 + (32 + ql) * 2) = (unsigned short)pk2(o1[r], 0.f); }
            const int tj = valid ? (t * 4 + js) : -1;
            __builtin_amdgcn_wave_barrier();
#pragma unroll
            for (int c = 0; c < 4; ++c) { const int qrow_ = 8 * c + (lane >> 3); const int tjq = __builtin_amdgcn_ds_bpermute(qrow_ << 2, tj);
                if (tjq >= 0) { const size_t pidx = (size_t)bh * SEQ * 4 + tjq; *(u32x4*)(Q.mpo() + pidx * 64 + (lane & 7) * 8) = *(const LAS u32x4*)(Os + qrow_ * 128 + (lane & 7) * 16); } }
            if (valid && hi == 0) { const size_t pidx = (size_t)bh * SEQ * 4 + tj; *(f32x2*)(Q.mml() + pidx * 2) = (f32x2){mz, lsum}; }
        }
        ent = ent1; chunk = chunk1; nchk = nchk1; cnt = cnt1; ent1 = ent2; chunk1 = chunk2; nchk1 = nchk2; cnt1 = cnt2;
        tj_cur = tj_nxt; raw_nxt = raw_nn;
#pragma unroll
        for (int ks = 0; ks < 4; ++ks) qf[ks] = qn[ks];
    }
#undef MC_ADV
#undef MC_ENTRY
#undef MC_TJ
    }
    __syncthreads();
}
DI void ph_moba_combine(Frame& F) {
    const Ptrs Q = get_ptrs(F);
    constexpr int NIT = BATCH * NH * SEQ * 8 / NTHR;
    int wi_lo, wi_hi;
    if (F.G == 256) { if (F.wg < 128) { wi_lo = F.wg * 20; wi_hi = wi_lo + 20; } else { wi_lo = 2560 + (F.wg - 128) * 4; wi_hi = wi_lo + 4; } }
    else { wi_lo = (int)(((long)F.wg * NIT) / F.G); wi_hi = (int)(((long)(F.wg + 1) * NIT) / F.G); }
    for (int wi = wi_lo; wi < wi_hi; wi += 4) {
        f32x2 ml[4][4]; u32x4 ov[4][4]; bool okk[4][4]; bool act[4]; int ii[4];
#pragma unroll
        for (int u = 0; u < 4; ++u) { act[u] = wi + u < wi_hi; const int i = (act[u] ? wi + u : wi) * NTHR + F.tid; ii[u] = i;
            const int sub = i & 7, qh = i >> 3, t = qh & (SEQ - 1); const int own = t >> 8, nsel = own < 3 ? own : 3; const size_t p0 = (size_t)qh * 4;
#pragma unroll
            for (int j = 0; j < 4; ++j) { const bool ok = (j == 3) || (j < nsel); okk[u][j] = ok; ml[u][j] = (f32x2){-INFINITY, 0.f}; ov[u][j] = (u32x4){0u, 0u, 0u, 0u};
                if (ok) { ml[u][j] = *(const f32x2*)(Q.mml() + (p0 + j) * 2); ov[u][j] = *(const u32x4*)(Q.mpo() + (p0 + j) * 64 + sub * 8); } } }
#pragma unroll
        for (int u = 0; u < 4; ++u) { if (!act[u]) continue; const int i = ii[u];
            const int sub = i & 7, qh = i >> 3, t = qh & (SEQ - 1), bh = qh >> 14, h = bh % NH, b = bh / NH;
            float M = -INFINITY;
#pragma unroll
            for (int j = 0; j < 4; ++j) M = fmaxf(M, ml[u][j][0]);
            float o[8], L = 0.f;
#pragma unroll
            for (int k = 0; k < 8; ++k) o[k] = 0.f;
#pragma unroll
            for (int j = 0; j < 4; ++j) { if (okk[u][j]) { const float w = __builtin_amdgcn_exp2f(ml[u][j][0] - M); L += w * ml[u][j][1]; float v[8]; unpack8(ov[u][j], v);
#pragma unroll
                    for (int k = 0; k < 8; ++k) o[k] += w * v[k]; } }
            const float inv = 1.0f / L;
            *(u32x4*)(Q.YMIX() + ((size_t)b * SEQ + t) * DM + h * HD + sub * 8) = (u32x4){pk2(o[0] * inv, o[1] * inv), pk2(o[2] * inv, o[3] * inv), pk2(o[4] * inv, o[5] * inv), pk2(o[6] * inv, o[7] * inv)}; }
    }
}
DI bf16x8 tr_frag(const LAS unsigned char* a, int second_off) {
    const s16x4 lo4 = __builtin_bit_cast(s16x4, __builtin_amdgcn_ds_read_tr16_b64_v4i16((LAS s16x4*)a));
    const s16x4 hi4 = __builtin_bit_cast(s16x4, __builtin_amdgcn_ds_read_tr16_b64_v4i16((LAS s16x4*)(a + second_off)));
    return (bf16x8){lo4[0], lo4[1], lo4[2], lo4[3], hi4[0], hi4[1], hi4[2], hi4[3]};
}
DI void ph_ret_kv2(Frame& F) {
    int it_lo_, it_hi_, it_st_; p1_range(F, it_lo_, it_hi_, it_st_);
    u32x4 pkv[4], pvv[4];
#define RKV_LOAD(IT) do { const Ptrs Q_ = get_ptrs(F); const int tid_ = F.wave * 64 + fresh_lane(); const int item = (IT) * 2 + (tid_ >> 8), b = item / (128 * NH), c = (item / NH) % 128, h = item % NH; const int tl = tid_ & 255, r = tl >> 1, hf = tl & 1; \
        const bf16* kp = Q_.PROJ() + ((size_t)b * SEQ + c * 128 + r) * DINP + C_KR + h * HD + hf * 32; const bf16* vp = kp + (C_VR - C_KR); \
        _Pragma("unroll") for (int ch = 0; ch < 4; ++ch) { pkv[ch] = *(const u32x4*)(kp + 8 * ch); pvv[ch] = *(const u32x4*)(vp + 8 * ch); } } while (0)
    if (it_lo_ < it_hi_) RKV_LOAD(it_lo_);
    for (int it = it_lo_; it < it_hi_; it += it_st_) {
        const Ptrs Q = get_ptrs(F);
        const int lane = fresh_lane(), ql = lane & 31, hi = lane >> 5; const int tid = F.wave * 64 + lane;
        const int half = F.wave >> 2, w4 = F.wave & 3;
        { const int item = it * 2 + (tid >> 8), h = item % NH;
          const int tl = tid & 255, r = tl >> 1, hf = tl & 1;
          LAS unsigned char* Kp = F.lds + (tid >> 8) * 32768; LAS unsigned char* Vp = Kp + 16384;
          const float sc = 0.125f * exp2f(ret_log2g(h) * (float)(127 - r));
#pragma unroll
          for (int ch = 0; ch < 4; ++ch) { const u32x4 kv = pkv[ch], vv = pvv[ch]; float f[8]; unpack8(kv, f);
              *(LAS u32x4*)(Kp + r * 128 + (hf * 4 + ch) * 16) = (u32x4){pk2(f[0] * sc, f[1] * sc), pk2(f[2] * sc, f[3] * sc), pk2(f[4] * sc, f[5] * sc), pk2(f[6] * sc, f[7] * sc)};
              *(LAS u32x4*)(Vp + r * 128 + (hf * 4 + ch) * 16) = vv; } }
        __syncthreads();
        if (it + it_st_ < it_hi_) RKV_LOAD(it + it_st_);
        { const int item = it * 2 + half, b = item / (128 * NH), c = (item / NH) % 128, h = item % NH;
          const int dvt = w4 >> 1, dkt = w4 & 1;
          const LAS unsigned char* Kp = F.lds + half * 32768; const LAS unsigned char* Vp = Kp + 16384;
          const int qrow = (lane & 15) >> 2, pp = lane & 3, g1 = (lane >> 4) & 1;
          const int aoff = (8 * hi + qrow) * 128 + (16 * g1 + 4 * pp) * 2;
          f32x16 acc;
#pragma unroll
          for (int r = 0; r < 16; ++r) acc[r] = 0.f;
#pragma unroll
          for (int s = 0; s < 8; ++s) { const bf16x8 va = tr_frag(Vp + aoff + s * 16 * 128 + dvt * 64, 4 * 128), kb = tr_frag(Kp + aoff + s * 16 * 128 + dkt * 64, 4 * 128);
              acc = __builtin_amdgcn_mfma_f32_32x32x16_bf16(va, kb, acc, 0, 0, 0); }
          bf16* o = Q.retkv() + (size_t)((b * 128 + c) * NH + h) * 4096 + (32 * dvt) * 64 + 32 * dkt + ql;
#pragma unroll
          for (int r = 0; r < 16; ++r) o[crow16(r, hi) * 64] = (bf16)pk2(acc[r], 0.f); }
        __syncthreads();
    }
#undef RKV_LOAD
}
DI void ph_ret_out2(Frame& F) {
    u32x4 pkv[4], pvv[4];
#define ROUT_LOAD(IT) do { const Ptrs Q_ = get_ptrs(F); const int tid_ = F.wave * 64 + fresh_lane(); const int item = (IT) * 2 + (tid_ >> 8), b = item / (128 * NH), c = (item / NH) % 128, h = item % NH; const int tl = tid_ & 255, r = tl >> 1, hf = tl & 1; \
        const bf16* kp = Q_.PROJ() + ((size_t)b * SEQ + c * 128 + r) * DINP + C_KR + h * HD + hf * 32; const bf16* vp = kp + (C_VR - C_KR); \
        _Pragma("unroll") for (int ch = 0; ch < 4; ++ch) { pkv[ch] = *(const u32x4*)(kp + 8 * ch); pvv[ch] = *(const u32x4*)(vp + 8 * ch); } } while (0)
    if (F.wg < BATCH * 128 * NH / 2) ROUT_LOAD(F.wg);
    for (int it = F.wg; it < BATCH * 128 * NH / 2; it += F.G) {
        const Ptrs Q = get_ptrs(F);
        const int lane = fresh_lane(), ql = lane & 31, hi = lane >> 5; const int tid = F.wave * 64 + lane;
        const int half = F.wave >> 2, qt = half ? 3 - (F.wave & 3) : (F.wave & 3);
        bf16x8 qf[4]; bf16x8 pfr[4][2]; u32x4 gv4[4];
        { const int item = it * 2 + half, b = item / (128 * NH), c = (item / NH) % 128, h = item % NH;
          { const bf16* gp0 = Q.PROJ() + ((size_t)b * SEQ + c * 128 + 32 * qt + (lane >> 1)) * DINP + C_GR + h * HD + (lane & 1) * 32;
#pragma unroll
            for (int k = 0; k < 4; ++k) gv4[k] = *(const u32x4*)(gp0 + 8 * k); }
          const bf16* qp = Q.PROJ() + ((size_t)b * SEQ + c * 128 + 32 * qt + ql) * DINP + C_QR + h * HD + 8 * hi;
#pragma unroll
          for (int ks = 0; ks < 4; ++ks) qf[ks] = *(const bf16x8*)(qp + 16 * ks);
          const bf16* pT = Q.retkv() + (size_t)((b * 128 + c) * NH + h) * 4096 + (size_t)ql * 64 + 8 * hi;
#pragma unroll
          for (int ks = 0; ks < 4; ++ks)
#pragma unroll
              for (int dt = 0; dt < 2; ++dt) pfr[ks][dt] = *(const bf16x8*)(pT + dt * 32 * 64 + 16 * ks); }
        { const int tl = tid & 255, r = tl >> 1, hf = tl & 1;
          LAS unsigned char* Kp = F.lds + (tid >> 8) * 32768; LAS unsigned char* Vp = Kp + 16384;
#pragma unroll
          for (int ch = 0; ch < 4; ++ch) { const u32x4 kv = pkv[ch], vv = pvv[ch];
              *(LAS u32x4*)(Kp + r * 128 + (((hf * 4 + ch) ^ (r & 7)) << 4)) = kv;
              *(LAS u32x4*)(Vp + r * 128 + (hf * 4 + ch) * 16) = vv; } }
        __syncthreads();
        if (it + F.G < BATCH * 128 * NH / 2) ROUT_LOAD(it + F.G);
        { const int item = it * 2 + half, b = item / (128 * NH), c = (item / NH) % 128, h = item % NH;
          const float lg = ret_log2g(h);
          const LAS unsigned char* Kp = F.lds + half * 32768; const LAS unsigned char* Vp = Kp + 16384;
          LAS unsigned char* Os = F.lds + 65536 + F.wave * 8192;
          const size_t row0 = (size_t)b * SEQ + c * 128;
          const int i = 32 * qt + ql;
          f32x16 o0, o1, c0, c1;
#pragma unroll
          for (int r = 0; r < 16; ++r) { o0[r] = 0.f; o1[r] = 0.f; c0[r] = 0.f; c1[r] = 0.f; }
          {
#pragma unroll
            for (int ks = 0; ks < 4; ++ks) {
#pragma unroll
                for (int dt = 0; dt < 2; ++dt) { const bf16x8 bfr = pfr[ks][dt];
                    if (dt == 0) c0 = __builtin_amdgcn_mfma_f32_32x32x16_bf16(qf[ks], bfr, c0, 0, 0, 0); else c1 = __builtin_amdgcn_mfma_f32_32x32x16_bf16(qf[ks], bfr, c1, 0, 0, 0); } } }
          const int qrow = (lane & 15) >> 2, pp = lane & 3, g1 = (lane >> 4) & 1;
          const LAS unsigned char* vb = Vp + (4 * hi + qrow) * 128 + (16 * g1 + 4 * pp) * 2;
          for (int kt = 0; kt <= qt; ++kt) {
              f32x16 acc;
#pragma unroll
              for (int r = 0; r < 16; ++r) acc[r] = 0.f;
#pragma unroll
              for (int ks = 0; ks < 4; ++ks) { const int row = 32 * kt + ql; const bf16x8 kf = *(const LAS bf16x8*)(Kp + row * 128 + (((2 * ks + hi) ^ (row & 7)) << 4));
                  acc = __builtin_amdgcn_mfma_f32_32x32x16_bf16(kf, qf[ks], acc, 0, 0, 0); }
              unsigned pk[8];
              const int dij = i - 32 * kt - 4 * hi;
#pragma unroll
              for (int r = 0; r < 16; r += 2) { const int d0 = dij - crow16(r, 0), d1 = dij - crow16(r + 1, 0);
                  const float p0 = d0 >= 0 ? acc[r] * 0.125f * __builtin_amdgcn_exp2f(lg * (float)d0) : 0.f, p1 = d1 >= 0 ? acc[r + 1] * 0.125f * __builtin_amdgcn_exp2f(lg * (float)d1) : 0.f;
                  pk[r >> 1] = pk2(p0, p1); }
#pragma unroll
              for (int s = 0; s < 2; ++s) { const bf16x8 pf = __builtin_bit_cast(bf16x8, (u32x4){pk[4 * s], pk[4 * s + 1], pk[4 * s + 2], pk[4 * s + 3]});
                  const bf16x8 v0 = tr_frag(vb + (32 * kt + 16 * s) * 128, 8 * 128), v1 = tr_frag(vb + (32 * kt + 16 * s) * 128 + 64, 8 * 128);
                  o0 = __builtin_amdgcn_mfma_f32_32x32x16_bf16(pf, v0, o0, 0, 0, 0); o1 = __builtin_amdgcn_mfma_f32_32x32x16_bf16(pf, v1, o1, 0, 0, 0); }
          }
#pragma unroll
          for (int r = 0; r < 16; ++r) { const int qq = crow16(r, hi); const float sc = __builtin_amdgcn_exp2f(lg * (float)(32 * qt + qq + 1));
              *(LAS float*)(Os + qq * 256 + ((((ql >> 2)) ^ (qq & 15)) << 4) + (ql & 3) * 4) = o0[r] + sc * c0[r];
              *(LAS float*)(Os + qq * 256 + (((8 + (ql >> 2)) ^ (qq & 15)) << 4) + (ql & 3) * 4) = o1[r] + sc * c1[r]; }
          __builtin_amdgcn_wave_barrier();
          const int qq = lane >> 1, hf = lane & 1;
          float v[32]; float s1 = 0.f;
#pragma unroll
          for (int k = 0; k < 8; ++k) { const f32x4 x = *(const LAS f32x4*)(Os + qq * 256 + (((hf * 8 + k) ^ (qq & 15)) << 4)); v[4 * k] = x[0]; v[4 * k + 1] = x[1]; v[4 * k + 2] = x[2]; v[4 * k + 3] = x[3]; s1 += (x[0] + x[1]) + (x[2] + x[3]); }
          s1 += dppf<DPP_XOR1>(s1);
          const float mean = s1 * (1.0f / 64.0f); float s2 = 0.f;
#pragma unroll
          for (int k = 0; k < 32; ++k) { v[k] -= mean; s2 += v[k] * v[k]; }
          s2 += dppf<DPP_XOR1>(s2);
          const float rstd = 1.0f / sqrtf(s2 * (1.0f / 64.0f) + GN_EPS);
          const size_t t = row0 + 32 * qt + qq;
          bf16* op = Q.YMIX() + t * DM + 384 + h * HD + hf * 32;
#pragma unroll
          for (int k = 0; k < 4; ++k) { float g[8]; unpack8(gv4[k], g); float ov[8];
#pragma unroll
              for (int e = 0; e < 8; ++e) ov[e] = v[8 * k + e] * rstd * (g[e] * __builtin_amdgcn_rcpf(1.0f + __builtin_amdgcn_exp2f(-1.4426950408889634f * g[e])));
              *(u32x4*)(op + 8 * k) = (u32x4){pk2(ov[0], ov[1]), pk2(ov[2], ov[3]), pk2(ov[4], ov[5]), pk2(ov[6], ov[7])}; }
        }
        __syncthreads();
    }
#undef ROUT_LOAD
}
DI void ph_ln1_router(Frame& F, int l) {
    const Ptrs Q = get_ptrs(F);
    LAS u32x4* bhi = (LAS u32x4*)F.lds; LAS u32x4* blo = bhi + 2048;
#pragma unroll
    for (int i = 0; i < 8; ++i) bhi[F.tid + NTHR * i] = Q.rimg()[F.tid + NTHR * i];
    LAS float* gamL = (LAS float*)(F.lds + 81920); LAS float* betL = gamL + 1024;
    { const float* src = (F.tid < 256 ? Q.in(13) : Q.in(14)) + l * DM + (F.tid & 255) * 4; *(LAS f32x4*)((F.tid < 256 ? gamL : betL) + (F.tid & 255) * 4) = *(const f32x4*)src; }
    __syncthreads();
    const float* rb = Q.in(18);
    unsigned* ecnt = Q.ctl() + CW_ECNT + 1024 * l;
    LAS unsigned* rinfo = (LAS unsigned*)(F.lds + 65536);
    LAS unsigned* lcnt = rinfo + 640; LAS unsigned* lbase = lcnt + 16;
    for (int rblk = F.wg; rblk < TOK / 128; rblk += F.G) {
      if (F.tid < 16) lcnt[F.tid] = 0u;
      __syncthreads();
      {
        const int rr = F.lane & 15, g = F.lane >> 4;
        const size_t rowoff = (size_t)(rblk * 128 + 16 * F.wave + rr) * DM + 8 * g;
        u32x4 xv[32]; float s = 0.f;
#pragma unroll
        for (int k = 0; k < 32; ++k) xv[k] = *(const u32x4*)(Q.V1() + rowoff + 32 * k);
#pragma unroll
        for (int k = 0; k < 32; ++k) { float x[8]; unpack8(xv[k], x); s += ((x[0] + x[1]) + (x[2] + x[3])) + ((x[4] + x[5]) + (x[6] + x[7])); }
        s = swap16_sum(s, s); s = swap32_sum(s, s);
#pragma unroll
        for (int k = 0; k < 32; ++k) asm volatile("" : "+v"(xv[k]));
        const float mean = s * (1.0f / DM); float s2 = 0.f;
#pragma unroll
        for (int k = 0; k < 32; ++k) { float x[8]; unpack8(xv[k], x);
#pragma unroll
            for (int j = 0; j < 8; ++j) { const float d_ = x[j] - mean; s2 += d_ * d_; } }
        s2 = swap16_sum(s2, s2); s2 = swap32_sum(s2, s2);
#pragma unroll
        for (int k = 0; k < 32; ++k) asm volatile("" : "+v"(xv[k]));
        const float rstd = 1.0f / sqrtf(s2 * (1.0f / DM) + LN_EPS);
        f32x4 acc = {0.f, 0.f, 0.f, 0.f};
#pragma unroll
        for (int k = 0; k < 32; ++k) { float x[8], y[8], hf[8]; unpack8(xv[k], x);
            const LAS float* gp = gamL + 32 * k + 8 * g; const LAS float* bp = betL + 32 * k + 8 * g;
            const f32x4 g0 = *(const LAS f32x4*)gp, g1 = *(const LAS f32x4*)(gp + 4), b0 = *(const LAS f32x4*)bp, b1 = *(const LAS f32x4*)(bp + 4);
#pragma unroll
            for (int j = 0; j < 4; ++j) { y[j] = (x[j] - mean) * rstd * g0[j] + b0[j]; y[4 + j] = (x[4 + j] - mean) * rstd * g1[j] + b1[j]; }
            const u32x4 hi = (u32x4){pk2(y[0], y[1]), pk2(y[2], y[3]), pk2(y[4], y[5]), pk2(y[6], y[7])};
            *(u32x4*)(Q.X1B() + rowoff + 32 * k) = hi;
            unpack8(hi, hf);
            const u32x4 lo = (u32x4){pk2(y[0] - hf[0], y[1] - hf[1]), pk2(y[2] - hf[2], y[3] - hf[3]), pk2(y[4] - hf[4], y[5] - hf[5]), pk2(y[6] - hf[6], y[7] - hf[7])};
            const u32x4 wh = bhi[k * 64 + F.lane], wl = blo[k * 64 + F.lane];
            acc = __builtin_amdgcn_mfma_f32_16x16x32_bf16(__builtin_bit_cast(bf16x8, hi), __builtin_bit_cast(bf16x8, wh), acc, 0, 0, 0);
            acc = __builtin_amdgcn_mfma_f32_16x16x32_bf16(__builtin_bit_cast(bf16x8, lo), __builtin_bit_cast(bf16x8, wh), acc, 0, 0, 0);
            acc = __builtin_amdgcn_mfma_f32_16x16x32_bf16(__builtin_bit_cast(bf16x8, hi), __builtin_bit_cast(bf16x8, wl), acc, 0, 0, 0);
            if ((k & 1) == 1) __builtin_amdgcn_sched_barrier(0); }
        LAS float* lgs = (LAS float*)(F.lds + 65536 + 4096) + F.wave * 256;
#pragma unroll
        for (int i = 0; i < 4; ++i) lgs[(4 * g + i) * 16 + rr] = acc[i];
      }
      __builtin_amdgcn_wave_barrier();
      if (F.lane < 16) { const int rl = 16 * F.wave + F.lane;
        const LAS float* lgs = (const LAS float*)(F.lds + 65536 + 4096) + F.wave * 256 + F.lane * 16;
        float lg[16];
#pragma unroll
        for (int e = 0; e < 16; ++e) lg[e] = lgs[e];
        float aff[16], sel[16];
#pragma unroll
        for (int e = 0; e < 16; ++e) { const float z = lg[e]; aff[e] = __builtin_amdgcn_rcpf(1.0f + __builtin_amdgcn_exp2f(-1.4426950408889634f * z)); sel[e] = aff[e] + rb[e]; }
        float gs[4];
#pragma unroll
        for (int g = 0; g < 4; ++g) { const float a = sel[4 * g], bq = sel[4 * g + 1], c = sel[4 * g + 2], d = sel[4 * g + 3];
            gs[g] = fmaxf(fmaxf(fmaxf(a + bq, a + c), fmaxf(a + d, bq + c)), fmaxf(bq + d, c + d)); }
        int gb = 0; float gbv = gs[0];
#pragma unroll
        for (int g = 1; g < 4; ++g) if (gs[g] > gbv) { gbv = gs[g]; gb = g; }
        float s4[4], a4[4];
#pragma unroll
        for (int k = 0; k < 4; ++k) { s4[k] = gb == 0 ? sel[k] : gb == 1 ? sel[4 + k] : gb == 2 ? sel[8 + k] : sel[12 + k]; a4[k] = gb == 0 ? aff[k] : gb == 1 ? aff[4 + k] : gb == 2 ? aff[8 + k] : aff[12 + k]; }
        int f0 = 0; float fv = s4[0], fa = a4[0];
#pragma unroll
        for (int k = 1; k < 4; ++k) if (s4[k] > fv) { fv = s4[k]; f0 = k; fa = a4[k]; }
        int f1 = -1; float sv = -INFINITY, sa = 0.f;
#pragma unroll
        for (int k = 0; k < 4; ++k) if (k != f0 && s4[k] > sv) { sv = s4[k]; f1 = k; sa = a4[k]; }
        const float wsum = fa + sa;
        {
            const int e0 = gb * 4 + f0, e1 = gb * 4 + f1;
            rinfo[rl] = (unsigned)e0 | ((unsigned)e1 << 8);
            rinfo[128 + rl] = __hip_atomic_fetch_add(&lcnt[e0], 1u, __ATOMIC_RELAXED, __HIP_MEMORY_SCOPE_WORKGROUP);
            rinfo[256 + rl] = __hip_atomic_fetch_add(&lcnt[e1], 1u, __ATOMIC_RELAXED, __HIP_MEMORY_SCOPE_WORKGROUP);
            rinfo[384 + rl] = __float_as_uint(fa / wsum); rinfo[512 + rl] = __float_as_uint(sa / wsum);
        }
      }
      __syncthreads();
      if (F.tid < 16) { const unsigned c = lcnt[F.tid]; lbase[F.tid] = c ? atomicAdd(&ecnt[64 * F.tid], c) : 0u; }
      __syncthreads();
      if (F.tid < 128) { const unsigned ee = rinfo[F.tid]; const int e0 = ee & 255, e1 = ee >> 8; const unsigned r = (unsigned)(rblk * 128 + F.tid);
          const size_t p0 = (size_t)e0 * LCAP + lbase[e0] + rinfo[128 + F.tid], p1 = (size_t)e1 * LCAP + lbase[e1] + rinfo[256 + F.tid];
          Q.ltok()[p0] = r; Q.lw()[p0] = __uint_as_float(rinfo[384 + F.tid]);
          Q.ltok()[p1] = r | 0x80000000u; Q.lw()[p1] = __uint_as_float(rinfo[512 + F.tid]); }
      __syncthreads();
    }
}
DI void moe_build_tab(Frame& F, int l) {
    const Ptrs Q = get_ptrs(F);
    LAS int* tab = (LAS int*)(F.lds + MOE_TAB_OFF);
    __syncthreads();
    if (F.tid < 64) {
        const unsigned* ecnt = Q.ctl() + CW_ECNT + 1024 * l; const int e = F.tid & 15;
        const int c = (int)__hip_atomic_load(ecnt + 64 * e, __ATOMIC_RELAXED, __HIP_MEMORY_SCOPE_AGENT); const int nb = (c + 255) >> 8;
        int inc = nb;
#pragma unroll
        for (int o = 1; o < 16; o <<= 1) { const int v = __builtin_amdgcn_ds_bpermute((F.tid - o) << 2, inc); if (e >= o) inc += v; }
        const int pb = inc - nb;
        if (F.tid < 16) { tab[e] = c; tab[16 + e] = pb; if (e == 15) tab[32] = inc; for (int j = 0; j < nb; ++j) tab[64 + pb + j] = e; }
    }
    __syncthreads();
}
DI void ph_ln2(Frame& F, int l) {
    const Ptrs Q = get_ptrs(F);
    const float* gam = Q.in(15) + l * DM; const float* bet = Q.in(16) + l * DM;
    float gmv[16], btv[16];
#pragma unroll
    for (int j = 0; j < 2; ++j)
#pragma unroll
        for (int k = 0; k < 8; k += 4) { const f32x4 g4 = *(const f32x4*)(gam + j * 512 + F.lane * 8 + k), b4 = *(const f32x4*)(bet + j * 512 + F.lane * 8 + k);
#pragma unroll
            for (int e = 0; e < 4; ++e) { gmv[j * 8 + k + e] = g4[e]; btv[j * 8 + k + e] = b4[e]; } }
    const int rstep = F.G * NWAVES; int r = F.wg * NWAVES + F.wave;
    u32x4 cx[2], c0[2], c1[2];
    if (r < TOK) {
#pragma unroll
        for (int j = 0; j < 2; ++j) { const size_t off = (size_t)r * DM + j * 512 + F.lane * 8; cx[j] = *(const u32x4*)(Q.X1B() + off); c0[j] = *(const u32x4*)(Q.YM0() + off); c1[j] = *(const u32x4*)(Q.YM1() + off); } }
    for (; r < TOK; r += rstep) {
        u32x4 nx[2], n0[2], n1[2];
        { const int rn = r + rstep < TOK ? r + rstep : r;
#pragma unroll
          for (int j = 0; j < 2; ++j) { const size_t off = (size_t)rn * DM + j * 512 + F.lane * 8; nx[j] = *(const u32x4*)(Q.X1B() + off); n0[j] = *(const u32x4*)(Q.YM0() + off); n1[j] = *(const u32x4*)(Q.YM1() + off); } }
        float v[16]; float s = 0.f;
#pragma unroll
        for (int j = 0; j < 2; ++j) {
            float a[8], b0[8], b1[8]; unpack8(cx[j], a); unpack8(c0[j], b0); unpack8(c1[j], b1);
#pragma unroll
            for (int k = 0; k < 8; ++k) { v[j * 8 + k] = ALPHA * a[k] + (b0[k] + b1[k]); s += v[j * 8 + k]; } }
        const float mean = wave_sum(s, F.lane) * (1.0f / DM); float s2 = 0.f;
#pragma unroll
        for (int k = 0; k < 16; ++k) { v[k] -= mean; s2 += v[k] * v[k]; }
        const float rstd = 1.0f / sqrtf(wave_sum(s2, F.lane) * (1.0f / DM) + LN_EPS);
#pragma unroll
        for (int j = 0; j < 2; ++j) { const int d0 = j * 512 + F.lane * 8; float o[8];
#pragma unroll
            for (int k = 0; k < 8; ++k) o[k] = v[j * 8 + k] * rstd * gmv[j * 8 + k] + btv[j * 8 + k];
            if (l == DEPTH - 1) { *(f32x4*)(Q.out + (size_t)r * DM + d0) = (f32x4){o[0], o[1], o[2], o[3]}; *(f32x4*)(Q.out + (size_t)r * DM + d0 + 4) = (f32x4){o[4], o[5], o[6], o[7]}; }
            else *(u32x4*)(Q.XB() + (size_t)r * DM + d0) = (u32x4){pk2(o[0], o[1]), pk2(o[2], o[3]), pk2(o[4], o[5]), pk2(o[6], o[7])}; }
#pragma unroll
        for (int j = 0; j < 2; ++j) { cx[j] = nx[j]; c0[j] = n0[j]; c1[j] = n1[j]; }
    }
}

constexpr int PH_PER_LAYER = 10, NPH = 1 + DEPTH * PH_PER_LAYER;
DI void grid_barrier(const Frame& F) {
    const Ptrs Q = get_ptrs(F);
    XcdBarrier b; b.bar = Q.ctl() + CW_BAR; b.x = xb_xcc_id(); b.st = (volatile LAS unsigned*)(F.lds + MISC_OFF) + 8;
    xcd_barrier(b);
}
DI void refresh_ids(Frame& F, int wave0) {
    int w_ = wave0; asm volatile("" : "+s"(w_)); unsigned z_ = 0u; asm volatile("" : "+v"(z_));
    const int ln_ = (int)__builtin_amdgcn_mbcnt_hi(~0u, __builtin_amdgcn_mbcnt_lo(~0u, z_));
    F.wave = w_; F.lane = ln_; F.tid = w_ * 64 + ln_;
}
#if MK_ONE_LAUNCH
#define PHASE_END(k) do { ts_barin(F, (k)); if ((k) + 1 < ph_hi) grid_barrier(F); } while (0)
#else
#define PHASE_END(k) do { __syncthreads(); } while (0)
#endif
#define TS_OFF (LDSCTL_OFF + 4096)
DI void ts_start(const Frame& F, int k) { if (PROBE_TS_SEL != 0 && F.wg == PROBE_WG && F.tid == 0) ((LAS unsigned long long*)(F.lds + TS_OFF))[k] = __builtin_amdgcn_s_memrealtime(); }
DI void ts_barin(const Frame& F, int k) { if (PROBE_TS_SEL != 0 && F.wg == PROBE_WG && F.tid == 0) ((LAS unsigned long long*)(F.lds + TS_OFF))[32 + k] = __builtin_amdgcn_s_memrealtime(); }
#define TS_MARK(id) do { if (PROBE_TS_SEL != 0 && L == 0 && F.wg == PROBE_WG && F.wave == 0 && F.lane == 0) { __builtin_amdgcn_s_waitcnt(0); ((LAS unsigned long long*)(F.lds + TS_OFF))[64 + (id)] = __builtin_amdgcn_s_memrealtime(); } } while (0)
#define PHASE_IN(k) (ts_start(F, (k)), (ph_lo <= (k) && (k) < ph_hi))
#ifndef PROBE_MASK
#define PROBE_MASK 0
#endif
#define PROBE_REP(k) for (int rep_ = 0; rep_ < ((L == 0 && ((PROBE_MASK >> (k)) & 1)) ? 2 : 1); ++rep_)
template <int L> DI void run_layer(Frame& F, const int wave0, const int ph_lo, const int ph_hi) {
    constexpr int base = 1 + L * PH_PER_LAYER;
    const LAS int* tab = (const LAS int*)(F.lds + MOE_TAB_OFF);
    if (PHASE_IN(base + 0)) { refresh_ids(F, wave0);
        TS_MARK(11); ph_s5_build(F, L); TS_MARK(12); refresh_ids(F, wave0);
        PROBE_REP(1) { const Ptrs Q = get_ptrs(F);
          pg8::DenseSched S; S.init(Q.XB(), Q.Win_t() + (size_t)L * DINP * DM, TOK, DINP, DM, F.G, F.wg);
          pg8::EpiBf16 E{Q.PROJ(), DINP, Q.ug()};
          pg8::gemm_phase<pg8::EpiBf16, pg8::DenseSched, true>(F.lds, F.tid, DM, S, E); }
        PHASE_END(base + 0); }
    if (PHASE_IN(base + 1)) { refresh_ids(F, wave0); TS_MARK(0); PROBE_REP(2) ph_kmean(F); TS_MARK(1); PROBE_REP(3) ph_ret_kv2(F); refresh_ids(F, wave0); TS_MARK(2);
        PROBE_REP(4) { const Ptrs Q = get_ptrs(F);
          pg8::S5ASched S{Q.ug(), Q.s5m(), F.G, F.G - 1 - F.wg};
          pg8::EpiS5A E{Q.yi(), Q.s5eg()};
          pg8::gemm_phase<pg8::EpiS5A, pg8::S5ASched, true>(F.lds, F.tid, 512, S, E); }
        TS_MARK(3);
        PHASE_END(base + 1); }
    if (PHASE_IN(base + 2)) { if (F.G == 256) {
            if (F.wg < 192) { const int bh = F.wg >> 4, ql_ = F.wg & 15; refresh_ids(F, wave0); ph_moba_gate2(F, L, bh * 32 + ql_, bh * 32 + 31 - ql_); }
            else { for (int k_ = 0; k_ < 2; ++k_) { const int si = (F.wg - 192) * 2 + k_; refresh_ids(F, wave0); if (si < 96) ph_scans(F, L, si, si + 1, 1); else ph_s5_scan2(F, L, si - 96, si - 95, 1); } }
        } else { for (int p_ = F.wg; p_ < 512; p_ += F.G) { refresh_ids(F, wave0);
            if (p_ < 384) ph_moba_gate(F, L, p_, p_ + 1, 1); else if (p_ < 480) ph_scans(F, L, p_ - 384, p_ - 383, 1); else ph_s5_scan2(F, L, p_ - 480, p_ - 479, 1); } }
        PHASE_END(base + 2); }
    if (PHASE_IN(base + 3)) { refresh_ids(F, wave0); TS_MARK(4); PROBE_REP(6) ph_moba_attn(F, L); refresh_ids(F, wave0); TS_MARK(5); ph_ret_out2(F); if (L == 0 && ((PROBE_MASK >> 7) & 1)) { refresh_ids(F, wave0); ph_ret_out2(F); } refresh_ids(F, wave0); TS_MARK(6);
        PROBE_REP(8) { const Ptrs Q = get_ptrs(F);
          pg8::S5BSched S{Q.s5cb(), Q.s5mc(), F.G, F.G - 1 - F.wg};
          pg8::EpiS5B E{Q.yi(), Q.ug(), Q.in(10) + (size_t)L * 256};
          pg8::gemm_phase<pg8::EpiS5B, pg8::S5BSched, true>(F.lds, F.tid, 128, S, E); }
        TS_MARK(7);
        PHASE_END(base + 3); }
    if (PHASE_IN(base + 4)) { refresh_ids(F, wave0); TS_MARK(9);
        PROBE_REP(9) { const Ptrs Q = get_ptrs(F);
          pg8::DenseSched S; S.init(Q.yi(), Q.wglut() + (size_t)L * 65536, TOK, 256, 256, F.G, F.G - 1 - F.wg);
          pg8::EpiGLU E{Q.yi(), Q.in(12) + (size_t)L * 256, Q.YMIX()};
          pg8::gemm_phase<pg8::EpiGLU, pg8::DenseSched, true>(F.lds, F.tid, 256, S, E); }
        refresh_ids(F, wave0); TS_MARK(8); PROBE_REP(10) ph_moba_combine(F); TS_MARK(10); PHASE_END(base + 4); }
    if (PHASE_IN(base + 5)) { refresh_ids(F, wave0);
        PROBE_REP(11) { const Ptrs Q = get_ptrs(F);
          pg8::DenseSched S; S.init(Q.YMIX(), Q.Wout_t() + (size_t)L * DM * DM, TOK, DM, DM, F.G, F.wg);
          pg8::EpiResF32 E{Q.V1(), Q.XB()};
          pg8::gemm_phase<pg8::EpiResF32, pg8::DenseSched, true>(F.lds, F.tid, DM, S, E); }
        PHASE_END(base + 5); }
    if (PHASE_IN(base + 6)) { refresh_ids(F, wave0); ph_ln1_router(F, L); PHASE_END(base + 6); }
    if (PHASE_IN(base + 7)) { refresh_ids(F, wave0);
        moe_build_tab(F, L);
        PROBE_REP(12) { const Ptrs Q = get_ptrs(F);
          const int vcu = (F.G % 8 == 0) ? (F.wg % 8) * (F.G / 8) + F.wg / 8 : F.wg;
          pg8::MoeUpSched S{Q.X1B(), Q.Wgu_t() + (size_t)L * 16 * 1024 * 1024, Q.ltok(), tab, F.G, vcu};
          pg8::EpiSwiGLU E{Q.Hb()};
          pg8::gemm_phase<pg8::EpiSwiGLU, pg8::MoeUpSched, true>(F.lds, F.tid, DM, S, E); }
        if (L == 0) { refresh_ids(F, wave0); ph_conv_deferred(F, 0); }
        PHASE_END(base + 7); }
    if (PHASE_IN(base + 8)) { refresh_ids(F, wave0);
        moe_build_tab(F, L);
        PROBE_REP(13) { const Ptrs Q = get_ptrs(F);
          const int vcu = (F.G % 8 == 0) ? (F.wg % 8) * (F.G / 8) + F.wg / 8 : F.wg;
          pg8::MoeDownSched S{Q.Hb(), Q.Wd_t() + (size_t)L * 16 * 1024 * DFF, tab, F.G, vcu};
          pg8::EpiMoeScatter E{Q.YM0(), Q.YM1(), Q.ltok(), Q.lw(), tab};
          pg8::gemm_phase<pg8::EpiMoeScatter, pg8::MoeDownSched, true>(F.lds, F.tid, DFF, S, E); }
        if (L == 0) { refresh_ids(F, wave0); ph_conv_deferred(F, 1); }
        PHASE_END(base + 8); }
    if (PHASE_IN(base + 9)) { refresh_ids(F, wave0); PROBE_REP(14) ph_ln2(F, L); PHASE_END(base + 9); }
}
__global__ void __launch_bounds__(NTHR, 2) fwd_kernel(Args args_unused) {
    extern __shared__ __attribute__((aligned(16))) unsigned char lds_raw[];
    Frame F;
    F.lds = (LAS unsigned char*)lds_raw;
    F.ka = (KArgs)__builtin_amdgcn_kernarg_segment_ptr();
    F.tid = threadIdx.x; F.lane = F.tid & 63; F.wave = __builtin_amdgcn_readfirstlane(F.tid >> 6);
    F.G = gridDim.x; F.wg = blockIdx.x;
    for (int u = F.tid; u < (LDS_BYTES - LDSCTL_OFF) / 4; u += NTHR) ((LAS unsigned*)(F.lds + LDSCTL_OFF))[u] = 0u;
    __syncthreads();
    const int ph_lo = F.ka->ph_lo, ph_hi = F.ka->ph_hi;
    const int wave0 = F.wave;
#if MK_ONE_LAUNCH
    { const Ptrs Q = get_ptrs(F); (void)xcd_barrier_post(Q.ctl() + CW_BAR, (volatile LAS unsigned*)(F.lds + MISC_OFF) + 8); }
#endif
    if (PHASE_IN(0)) { refresh_ids(F, wave0); for (int rep_ = 0; rep_ < (((PROBE_MASK >> 15) & 1) ? 2 : 1); ++rep_) ph_prologue(F);
#if MK_ONE_LAUNCH
        ts_barin(F, 0);
        if (ph_hi > NPH) { __threadfence(); cg::this_grid().sync(); __builtin_amdgcn_fence(__ATOMIC_ACQUIRE, "agent"); asm volatile("s_waitcnt vmcnt(0)" ::: "memory"); __syncthreads(); }
        else if (1 < ph_hi) grid_barrier(F);
#else
        PHASE_END(0);
#endif
    }
    run_layer<0>(F, wave0, ph_lo, ph_hi);
    run_layer<1>(F, wave0, ph_lo, ph_hi);
#if PROBE_TS_SEL != 0
    {
        refresh_ids(F, wave0); ts_start(F, NPH);
        const Ptrs Q = get_ptrs(F);
        if (F.wg == PROBE_WG && F.tid == 0) { const LAS unsigned long long* ts = (const LAS unsigned long long*)(F.lds + TS_OFF);
            unsigned long long sel = 0ull;
            if (PROBE_SUB_A >= 0) sel = ts[64 + PROBE_SUB_B] - ts[64 + PROBE_SUB_A]; else
            for (int k = 0; k < NPH; ++k) if ((PROBE_TS_SEL >> k) & 1u) sel += ((PROBE_TS_SEL >> 31) & 1u) ? (ts[k + 1] - ts[32 + k]) : (ts[k + 1] - ts[k]);
            const float eps = 0.28f + PROBE_K * (float)sel / (float)(ts[NPH] - ts[0]);
            __hip_atomic_store((float*)(Q.ctl() + 16), eps, __ATOMIC_RELAXED, __HIP_MEMORY_SCOPE_AGENT); }
        grid_barrier(F);
        const float eps = __hip_atomic_load((float*)(Q.ctl() + 16), __ATOMIC_RELAXED, __HIP_MEMORY_SCOPE_AGENT);
        for (size_t i = (size_t)F.wg * NTHR + F.tid; i < (size_t)TOK * DM / 4; i += (size_t)F.G * NTHR) { f32x4 v = *(f32x4*)(Q.out + i * 4); v = v * (1.0f + eps); *(f32x4*)(Q.out + i * 4) = v; }
    }
#endif
}

extern "C" void kernel_launch(void* const* d_in, const int* in_sizes, int n_in, void* d_out, int out_size, void* d_ws, size_t ws_size, hipStream_t stream) {
    static int grid = 0;
    if (grid == 0) {
        if (n_in != 22 || in_sizes[0] != TOK * DM || out_size != TOK * DM || ws_size < WS_END) {
            fprintf(stderr, "kernel_launch: unexpected shapes (n_in %d, in0 %d, out %d, ws %zu); nothing launched\n", n_in, n_in > 0 ? in_sizes[0] : -1, out_size, ws_size); grid = -1; return; }
        int dev = 0, cus = 0, per_cu = 0;
        if (hipGetDevice(&dev) != hipSuccess || hipDeviceGetAttribute(&cus, hipDeviceAttributeMultiprocessorCount, dev) != hipSuccess) { grid = -1; return; }
        if (hipFuncSetAttribute((const void*)fwd_kernel, hipFuncAttributeMaxDynamicSharedMemorySize, LDS_BYTES) != hipSuccess) { fprintf(stderr, "kernel_launch: hipFuncSetAttribute failed\n"); grid = -1; return; }
        if (hipOccupancyMaxActiveBlocksPerMultiprocessor(&per_cu, (const void*)fwd_kernel, NTHR, LDS_BYTES) != hipSuccess || per_cu < 1) { fprintf(stderr, "kernel_launch: occupancy query says %d blocks per CU\n", per_cu); (void)hipGetLastError(); grid = -1; return; }
        grid = cus;
    }
    if (grid < 0) return;
    (void)hipMemsetAsync((char*)d_ws + WS_CTL, 0, CTL_ZERO_BYTES, stream);
    Args a{};
    for (int i = 0; i < 22; ++i) a.in[i] = (const float*)d_in[i];
    a.out = (float*)d_out; a.ws = (unsigned char*)d_ws;
#if MK_ONE_LAUNCH
    a.ph_lo = 0; a.ph_hi = NPH;
    void* kargs[] = {&a};
    hipError_t e = hipLaunchCooperativeKernel((const void*)fwd_kernel, dim3(grid), dim3(NTHR), kargs, LDS_BYTES, stream);
    if (e != hipSuccess) fprintf(stderr, "cooperative launch failed: %s (grid %d)\n", hipGetErrorString(e), grid);
#else
    for (int ph = 0; ph < NPH; ++ph) { a.ph_lo = ph; a.ph_hi = ph + 1; hipLaunchKernelGGL(fwd_kernel, dim3(grid), dim3(NTHR), LDS_BYTES, stream, a); }
#endif
}
```

```cpp
#include <hip/hip_runtime.h>
#include <hip/hip_cooperative_groups.h>
#include <cstdio>
#include <cstdint>
namespace cg = cooperative_groups;

#ifndef PROBE_WG
#define PROBE_WG 0
#endif
#ifndef PROBE_K
#define PROBE_K 0.45f
#endif
#ifndef PROBE_SUB_A
#define PROBE_SUB_A -1
#define PROBE_SUB_B -1
#endif
#ifndef PROBE_TS_SEL
#define PROBE_TS_SEL 0
#endif
#ifndef S5_SIMPLE
#define S5_SIMPLE 0
#endif
#ifndef MK_ONE_LAUNCH
#define MK_ONE_LAUNCH 1
#endif

#define DI __device__ __forceinline__
#define GAS __attribute__((address_space(1)))
#define LAS __attribute__((address_space(3)))
typedef unsigned short bf16;
typedef float f32x4 __attribute__((ext_vector_type(4)));
typedef float f32x2 __attribute__((ext_vector_type(2)));
typedef unsigned u32x4 __attribute__((ext_vector_type(4)));
typedef unsigned u32x2 __attribute__((ext_vector_type(2)));
typedef short bf16x8 __attribute__((ext_vector_type(8)));

constexpr int BATCH = 2, SEQ = 16384, DM = 1024, TOK = BATCH * SEQ, DEPTH = 2;
constexpr int DIN = 2944, DINP = 3072;
constexpr int C_QA = 0, C_KA = 384, C_VA = 768, C_QR = 1152, C_KR = 1536, C_VR = 1920, C_GR = 2304, C_US = 2688;
constexpr int NH = 6, HD = 64, NKB = 64, KBLK = 256;
constexpr int NE = 16, DFF = 512, LCAP = TOK;
constexpr int MAXBLK = 288;
constexpr float ALPHA = 1.41421356237309505f;
constexpr float LN_EPS = 1e-5f, GN_EPS = 1e-6f;
constexpr int NWAVES = 8, NTHR = 512;

constexpr size_t MiB = 1u << 20;
constexpr size_t WS_CTL = 0, CTL_ZERO_BYTES = 64 * 1024;
constexpr size_t WS_SMALL = 1 * MiB;
constexpr size_t WS_WIN = 5 * MiB;
constexpr size_t WS_WOUT = 17 * MiB;
constexpr size_t WS_WGU = 21 * MiB;
constexpr size_t WS_WD = 85 * MiB;
constexpr size_t WS_XB = 117 * MiB;
constexpr size_t WS_X1B = 181 * MiB;
constexpr size_t WS_PROJ = 245 * MiB;
constexpr size_t WS_H = WS_PROJ, WS_YM0 = WS_PROJ + 68 * MiB;
constexpr size_t WS_YMIX = 437 * MiB;
constexpr size_t WS_YM1 = WS_YMIX;
constexpr size_t WS_LTOK = 501 * MiB;
constexpr size_t WS_LW = 503 * MiB;
constexpr size_t WS_END = 505 * MiB;
constexpr int SSMP_FLOATS = 235520;
constexpr int SP_APOW = 36864, SP_KT = 104448;
constexpr size_t SM_WGLUT = 2560 * 1024;
constexpr size_t SM_SSMP = 0;
constexpr size_t SM_KMEAN = 2 * SSMP_FLOATS * 4;
constexpr size_t SM_RIMG = 3 * 1024 * 1024;
constexpr size_t DO_RETKV = 0;
constexpr size_t DO_UG = 12 * MiB;
constexpr size_t DO_S5E = 24 * MiB;
constexpr size_t DO_MPO = 28 * MiB;
constexpr size_t X1_YG = 0;
constexpr size_t X1_YI = 0;
constexpr size_t X1_S5EG = 16 * MiB;
constexpr size_t X1_S5CB = 24 * MiB;
constexpr size_t X1_S5M = 50 * MiB;
constexpr size_t X1_S5MC = 62 * MiB;
constexpr size_t X1_MLIST = 32 * MiB;
constexpr size_t X1_MML = 44 * MiB;
constexpr int MLIST_PER_BH = 516096;
constexpr int CW_BAR = 4096;
constexpr int CW_ECNT = 1024;
constexpr int CW_MCNT = 8192;
constexpr int RING_BYTES = 131072, LDSCTL_OFF = RING_BYTES, MISC_OFF = LDSCTL_OFF + 320, MOE_TAB_OFF = LDSCTL_OFF + 1024;
constexpr int LDS_BYTES = 147456;

DI float bf2f(unsigned short v) { return __uint_as_float((unsigned)v << 16); }
DI unsigned f2bf(float f) { unsigned u = __float_as_uint(f); return (u + 0x7fffu + ((u >> 16) & 1u)) >> 16; }
typedef __bf16 bf16x2_t __attribute__((ext_vector_type(2)));
DI unsigned pk2(float lo, float hi) { const f32x2 v = {lo, hi}; const bf16x2_t b = __builtin_convertvector(v, bf16x2_t); return __builtin_bit_cast(unsigned, b); }
DI void unpack8(const u32x4 v, float* o) {
    o[0] = __uint_as_float(v.x << 16); o[1] = __uint_as_float(v.x & 0xffff0000u); o[2] = __uint_as_float(v.y << 16); o[3] = __uint_as_float(v.y & 0xffff0000u);
    o[4] = __uint_as_float(v.z << 16); o[5] = __uint_as_float(v.z & 0xffff0000u); o[6] = __uint_as_float(v.w << 16); o[7] = __uint_as_float(v.w & 0xffff0000u);
}
DI void sincos_acc(float a, float& sn, float& cs) {
    const double ad = (double)a; const double kd = rint(ad * 0.63661977236758134308); const int k = (int)kd;
    const float r = (float)(ad - kd * 1.57079632679489661923), z = r * r;
    const float sp = r + r * z * (-1.6666667163e-01f + z * (8.3333337680e-03f + z * (-1.9841270114e-04f + z * (2.7557314297e-06f + z * (-2.5050759689e-08f)))));
    const float cp = 1.0f - 0.5f * z + z * z * (4.1666667908e-02f + z * (-1.3888889225e-03f + z * (2.4801587642e-05f + z * (-2.7557314297e-07f + z * (2.0875723372e-09f)))));
    const int q = k & 3;
    sn = q == 0 ? sp : q == 1 ? cp : q == 2 ? -sp : -cp;
    cs = q == 0 ? cp : q == 1 ? -sp : q == 2 ? -cp : sp;
}
DI int fresh_lane() { unsigned z_ = 0u; asm volatile("" : "+v"(z_)); return (int)__builtin_amdgcn_mbcnt_hi(~0u, __builtin_amdgcn_mbcnt_lo(~0u, z_)); }
DI float xor32_max(float v) { const auto rr = __builtin_amdgcn_permlane32_swap(__float_as_uint(v), __float_as_uint(v), false, false); return fmaxf(__uint_as_float(rr[0]), __uint_as_float(rr[1])); }
DI float xor32_sum(float v) { const auto rr = __builtin_amdgcn_permlane32_swap(__float_as_uint(v), __float_as_uint(v), false, false); return __uint_as_float(rr[0]) + __uint_as_float(rr[1]); }
DI float shfl_xor_f(float v, int mask, int lane) { return __uint_as_float((unsigned)__builtin_amdgcn_ds_bpermute((lane ^ mask) << 2, (int)__float_as_uint(v))); }
template <int CTRL> DI float dppf(float v) { return __builtin_bit_cast(float, __builtin_amdgcn_update_dpp(0, __builtin_bit_cast(int, v), CTRL, 0xf, 0xf, true)); }
constexpr int DPP_XOR1 = 0xB1, DPP_XOR2 = 0x4E, DPP_HALF_MIRROR = 0x141, DPP_MIRROR = 0x140, DPP_ROR8 = 0x128;
DI float swap16_sum(float a, float b) { const auto r = __builtin_amdgcn_permlane16_swap(__float_as_uint(a), __float_as_uint(b), false, false); return __uint_as_float(r[0]) + __uint_as_float(r[1]); }
DI float swap32_sum(float a, float b) { const auto r = __builtin_amdgcn_permlane32_swap(__float_as_uint(a), __float_as_uint(b), false, false); return __uint_as_float(r[0]) + __uint_as_float(r[1]); }
DI float wave_sum(float v, int lane) {
    (void)lane;
    v += dppf<DPP_XOR1>(v); v += dppf<DPP_XOR2>(v); v += dppf<DPP_HALF_MIRROR>(v); v += dppf<DPP_MIRROR>(v);
    v = swap16_sum(v, v); v = swap32_sum(v, v);
    return v;
}
DI float ret_log2g(int h) {
    return h == 0 ? -0.04580368961312479f : h == 1 ? -0.02272007650008353f : h == 2 ? -0.011315313227834146f : h == 3 ? -0.005646563141142063f : h == 4 ? -0.0028205190623786626f : -0.0014095702546713536f;
}
DI float alibi_slope(int h) {
    return h == 0 ? 0.3968502629920499f : h == 1 ? 0.15749013123685915f : h == 2 ? 0.0625f : h == 3 ? 0.024803141437003122f : h == 4 ? 0.009843133202303695f : 0.00390625f;
}

namespace pg8 {
#define PG8_LAS __attribute__((address_space(3)))
typedef unsigned short bf16_t;
constexpr int BM = 256, BK = 64, HALF = 128, HTB = HALF * BK * 2, STAGE_BYTES = 8 * HTB, NXCD = 8, WGM = 8;
__host__ __device__ __forceinline__ int lds_byte(int r, int c) { const int st = (r >> 4) * 2 + (c >> 5), rr = r & 15, cc = c & 31, ob = rr * 64 + cc * 2; return st * 1024 + (ob ^ (((ob >> 9) & 1) << 5)); }
__host__ __device__ __forceinline__ void stage_rc(int b, int& R, int& C) { const int st = b / 1024, sb = b % 1024, swz = sb ^ (((sb >> 9) & 1) << 5); R = (st >> 1) * 16 + swz / 64; C = (st & 1) * 32 + (swz % 64) / 2; }
__host__ __device__ __forceinline__ int perm32(int rho) { const int n = rho >> 4, i = rho & 15; return 8 * (i >> 2) + 4 * n + (i & 3); }

struct Unit { int pm, pn, e, jb; };

template <class Epi, class Sched, bool ALIGN_EPI>
__device__ __forceinline__ void gemm_phase(PG8_LAS unsigned char* lds, const int tid, const int K, const Sched& S, const Epi& E) {
    const int wid = __builtin_amdgcn_readfirstlane(tid >> 6), lane = tid & 63, wr = wid >> 2, wc = wid & 3, fr = lane & 15, fq = lane >> 4;
    const int nt = K / BK;
    unsigned voffB[2];
#pragma unroll
    for (int i = 0; i < 2; ++i) { int R, C; stage_rc(tid * 16 + i * 8192, R, C); const int Rb = Epi::PERM ? ((R & ~31) + perm32(R & 31)) : R; voffB[i] = (unsigned)(Rb * K + C) * 2u; }
    const size_t kstepA = S.kstep(), kstepB = (size_t)(BK * 2);
    const size_t hstep = (size_t)HALF * K * 2;
    const unsigned ldsw = (unsigned)wid * 1024u;
    const int aoff = lds_byte(wr * 64 + fr, fq * 8), boff = lds_byte(wc * 32 + fr, fq * 8);
#define PG8_SA(b, h) (((b) * 2 + (h)) * HTB)
#define PG8_SB(b, h) ((4 + (b) * 2 + (h)) * HTB)
#define PG8_STAGE(bufoff, gbase, voff) do { _Pragma("unroll") for (int _i = 0; _i < 2; ++_i) \
        __builtin_amdgcn_global_load_lds((const unsigned*)((const char*)(gbase) + (voff)[_i]), (PG8_LAS unsigned*)(lds + (bufoff) + ldsw + _i * 8192), 16, 0, 0); } while (0)
#define PG8_LDA(dst, b, h) do { _Pragma("unroll") for (int m = 0; m < 4; ++m) _Pragma("unroll") for (int k = 0; k < 2; ++k) dst[m][k] = *(const PG8_LAS bf16x8*)(lds + PG8_SA(b, h) + aoff + m * 2048 + k * 1024); } while (0)
#define PG8_LDB(dst, b, h) do { _Pragma("unroll") for (int n = 0; n < 2; ++n) _Pragma("unroll") for (int k = 0; k < 2; ++k) dst[n][k] = *(const PG8_LAS bf16x8*)(lds + PG8_SB(b, h) + boff + n * 2048 + k * 1024); } while (0)
#define PG8_MMA(ai, bj, At, Bt) do { __builtin_amdgcn_s_setprio(1); _Pragma("unroll") for (int m = 0; m < 4; ++m) _Pragma("unroll") for (int n = 0; n < 2; ++n) _Pragma("unroll") for (int k = 0; k < 2; ++k) \
        acc[ai][bj][m][n] = __builtin_amdgcn_mfma_f32_16x16x32_bf16(Bt[n][k], At[m][k], acc[ai][bj][m][n], 0, 0, 0); __builtin_amdgcn_s_setprio(0); } while (0)
#define PG8_WAIT_V(n) asm volatile("s_waitcnt vmcnt(" #n ")" ::: "memory")
#define PG8_WAIT_L(n) asm volatile("s_waitcnt lgkmcnt(" #n ")" ::: "memory")
#define PG8_BAR __builtin_amdgcn_s_barrier()
#define PG8_SCHED __builtin_amdgcn_sched_barrier(0)
    Unit cur, nxt; int ui = 0;
    if (!S.next(0, cur)) return;
    f32x4 acc[2][2][4][2];
#pragma unroll
    for (int a = 0; a < 2; ++a)
#pragma unroll
        for (int b = 0; b < 2; ++b)
#pragma unroll
            for (int m = 0; m < 4; ++m)
#pragma unroll
                for (int n = 0; n < 2; ++n) acc[a][b][m][n] = (f32x4){0.f, 0.f, 0.f, 0.f};
    bf16x8 At[4][2], B0[2][2], B1[2][2];
    const char* cA; const char* cB; unsigned vA[2][2];
    S.addr(cur, tid, cA, vA, cB);
    PG8_STAGE(PG8_SB(0, 0), cB, voffB); PG8_STAGE(PG8_SB(0, 1), cB + hstep, voffB); PG8_STAGE(PG8_SA(0, 0), cA, vA[0]); PG8_STAGE(PG8_SA(0, 1), cA, vA[1]);
    if (wr == 1) PG8_BAR;
    PG8_WAIT_V(2); PG8_BAR;
    PG8_STAGE(PG8_SB(1, 0), cB + kstepB, voffB); PG8_STAGE(PG8_SA(1, 0), cA + kstepA, vA[0]); PG8_STAGE(PG8_SB(1, 1), cB + hstep + kstepB, voffB);
    PG8_WAIT_V(6); PG8_BAR;
    unsigned raw1[2][2] = {{0u, 0u}, {0u, 0u}};
    if constexpr (Sched::A_VARIES) { Unit n1; if (S.next(1, n1)) S.fetch(n1, tid, raw1); }
    for (;;) {
        const bool has_next = S.next(ui + 1, nxt);
        const char* nA = cA; const char* nB = cB; unsigned nvA[2][2] = {{vA[0][0], vA[0][1]}, {vA[1][0], vA[1][1]}};
        if (has_next) { if constexpr (Sched::A_VARIES) { S.ptrs(nxt, nA, nB); S.finish(tid, raw1, nvA); Unit n2; if (S.next(ui + 2, n2)) S.fetch(n2, tid, raw1); }
                        else { unsigned dummy[2][2]; S.addr(nxt, tid, nA, dummy, nB); } }
        typename Epi::Pre pre; E.prefetch(cur, wr, wc, fr, fq, pre);
        for (int t = 0; t < nt; t += 2) {
            const bool last = (t == nt - 2);
            const char* a1 = cA + (size_t)(t + 1) * kstepA;
            const char* a2 = last ? nA : cA + (size_t)(t + 2) * kstepA; const char* b2 = last ? nB : cB + (size_t)(t + 2) * kstepB;
            const char* a3 = a2 + kstepA; const char* b3 = b2 + kstepB;
            unsigned xA0[2], xA1[2];
            if constexpr (Sched::A_VARIES) { xA0[0] = last ? nvA[0][0] : vA[0][0]; xA0[1] = last ? nvA[0][1] : vA[0][1]; xA1[0] = last ? nvA[1][0] : vA[1][0]; xA1[1] = last ? nvA[1][1] : vA[1][1]; }
            else { xA0[0] = vA[0][0]; xA0[1] = vA[0][1]; xA1[0] = vA[1][0]; xA1[1] = vA[1][1]; }
            PG8_LDB(B0, 0, 0); PG8_LDB(B1, 0, 1); PG8_SCHED; PG8_LDA(At, 0, 0); PG8_STAGE(PG8_SA(1, 1), a1, vA[1]);
            PG8_WAIT_V(8); PG8_WAIT_L(0); PG8_BAR; PG8_MMA(0, 0, At, B0); PG8_MMA(0, 1, At, B1); PG8_BAR; PG8_SCHED;
            PG8_LDA(At, 0, 1); PG8_STAGE(PG8_SB(0, 0), b2, voffB); PG8_STAGE(PG8_SB(0, 1), b2 + hstep, voffB); PG8_STAGE(PG8_SA(0, 0), a2, xA0);
            PG8_WAIT_V(8); PG8_WAIT_L(0); PG8_BAR; PG8_MMA(1, 0, At, B0); PG8_MMA(1, 1, At, B1); PG8_BAR; PG8_SCHED;
            PG8_LDB(B0, 1, 0); PG8_LDB(B1, 1, 1); PG8_SCHED; PG8_LDA(At, 1, 0); PG8_STAGE(PG8_SA(0, 1), a2, xA1);
            PG8_WAIT_V(8); PG8_WAIT_L(0); PG8_BAR; PG8_MMA(0, 0, At, B0); PG8_MMA(0, 1, At, B1); PG8_BAR; PG8_SCHED;
            PG8_LDA(At, 1, 1); PG8_STAGE(PG8_SB(1, 0), b3, voffB); PG8_STAGE(PG8_SB(1, 1), b3 + hstep, voffB); PG8_STAGE(PG8_SA(1, 0), a3, xA0);
            PG8_WAIT_V(8); PG8_WAIT_L(0); PG8_BAR; PG8_MMA(1, 0, At, B0); PG8_MMA(1, 1, At, B1); PG8_BAR; PG8_SCHED;
        }
        if constexpr (ALIGN_EPI) { if (wr == 0) PG8_BAR; }
        E(acc, cur, wr, wc, fr, fq, pre);
        if (!has_next) break;
#pragma unroll
        for (int a = 0; a < 2; ++a)
#pragma unroll
            for (int b = 0; b < 2; ++b)
#pragma unroll
                for (int m = 0; m < 4; ++m)
#pragma unroll
                    for (int n = 0; n < 2; ++n) acc[a][b][m][n] = (f32x4){0.f, 0.f, 0.f, 0.f};
        cur = nxt; cA = nA; cB = nB; if constexpr (Sched::A_VARIES) { vA[0][0] = nvA[0][0]; vA[0][1] = nvA[0][1]; vA[1][0] = nvA[1][0]; vA[1][1] = nvA[1][1]; } ++ui;
        if constexpr (ALIGN_EPI) { if (wr == 1) PG8_BAR; }
    }
    PG8_WAIT_V(0);
    if constexpr (!ALIGN_EPI) { if (wr == 0) PG8_BAR; }
    PG8_BAR;
#undef PG8_SA
#undef PG8_SB
#undef PG8_STAGE
#undef PG8_LDA
#undef PG8_LDB
#undef PG8_MMA
#undef PG8_WAIT_V
#undef PG8_WAIT_L
#undef PG8_BAR
#undef PG8_SCHED
}

struct DenseSched {
    static constexpr bool A_VARIES = false;
    __device__ __forceinline__ size_t kstep() const { return (size_t)(BK * 2); }
    const bf16_t* A; const bf16_t* Bt; int K; int nM, nN, nwg, G, c;
    __device__ void init(const bf16_t* A_, const bf16_t* Bt_, int M, int N, int K_, int G_, int c_) { A = A_; Bt = Bt_; K = K_; nM = M / BM; nN = N / BM; nwg = nM * nN; G = G_; c = c_; }
    __device__ __forceinline__ bool next(int i, Unit& u) const {
        const long L = (long)i * G + c; if (L >= nwg) return false;
        int wgid = (int)L; { const int q = nwg / NXCD, r = nwg % NXCD, xcd = wgid % NXCD, off = wgid / NXCD; wgid = (xcd < r ? xcd * (q + 1) : r * (q + 1) + (xcd - r) * q) + off; }
        const int nig = WGM * nN, gid = wgid / nig, fm = gid * WGM, gsz = (nM - fm) < WGM ? (nM - fm) : WGM;
        u.pm = __builtin_amdgcn_readfirstlane(fm + ((wgid % nig) % gsz)); u.pn = __builtin_amdgcn_readfirstlane((wgid % nig) / gsz); u.e = 0; u.jb = 0; return true;
    }
    __device__ __forceinline__ void addr(const Unit& u, int tid, const char*& a, unsigned (&vA)[2][2], const char*& b) const {
        asm volatile("" : "+v"(tid));
        a = (const char*)A + (size_t)u.pm * BM * K * 2; b = (const char*)Bt + (size_t)u.pn * BM * K * 2;
#pragma unroll
        for (int i = 0; i < 2; ++i) { int R, C; stage_rc(tid * 16 + i * 8192, R, C);
#pragma unroll
            for (int h = 0; h < 2; ++h) vA[h][i] = (unsigned)((h * HALF + R) * K + C) * 2u; }
    }
};
struct MoeUpSched {
    static constexpr bool A_VARIES = true;
    __device__ __forceinline__ size_t kstep() const { return (size_t)(BK * 2); }
    const bf16_t* X; const bf16_t* W; const unsigned* ltok; const PG8_LAS int* tab; int G, c;
    __device__ __forceinline__ bool next(int i, Unit& u) const {
        const int id = i * G + c; const int nb = __builtin_amdgcn_readfirstlane(tab[32]); if (id >= nb * 4) return false;
        const int blk = id >> 2; u.pm = blk; u.pn = id & 3; u.e = __builtin_amdgcn_readfirstlane(tab[64 + blk]); u.jb = blk - __builtin_amdgcn_readfirstlane(tab[16 + u.e]); return true;
    }
    __device__ __forceinline__ void addr(const Unit& u, int tid, const char*& a, unsigned (&vA)[2][2], const char*& b) const {
        asm volatile("" : "+v"(tid));
        a = (const char*)X; b = (const char*)W + ((size_t)u.e * 1024 + (size_t)u.pn * BM) * 1024 * 2;
        const int cnt = __builtin_amdgcn_readfirstlane(tab[u.e]); const unsigned* lt = ltok + (size_t)u.e * LCAP + u.jb * 256;
#pragma unroll
        for (int i = 0; i < 2; ++i) { int R, C; stage_rc(tid * 16 + i * 8192, R, C);
#pragma unroll
            for (int h = 0; h < 2; ++h) { const int r = h * HALF + R; const bool ok = (u.jb * 256 + r) < cnt; const unsigned tk = ok ? (lt[r] & 0x7fffffffu) : 0u; vA[h][i] = (tk * 1024u + (unsigned)C) * 2u; } }
    }
    __device__ __forceinline__ void ptrs(const Unit& u, const char*& a, const char*& b) const { a = (const char*)X; b = (const char*)W + ((size_t)u.e * 1024 + (size_t)u.pn * BM) * 1024 * 2; }
    __device__ __forceinline__ void fetch(const Unit& u, int tid, unsigned (&raw)[2][2]) const {
        asm volatile("" : "+v"(tid));
        const int cnt = __builtin_amdgcn_readfirstlane(tab[u.e]); const unsigned* lt = ltok + (size_t)u.e * LCAP + u.jb * 256;
#pragma unroll
        for (int i = 0; i < 2; ++i) { int R, C; stage_rc(tid * 16 + i * 8192, R, C);
#pragma unroll
            for (int h = 0; h < 2; ++h) { const int r = h * HALF + R; const bool ok = (u.jb * 256 + r) < cnt; raw[h][i] = ok ? (lt[r] & 0x7fffffffu) : 0u; } }
    }
    __device__ __forceinline__ void finish(int tid, const unsigned (&raw)[2][2], unsigned (&vA)[2][2]) const {
        asm volatile("" : "+v"(tid));
#pragma unroll
        for (int i = 0; i < 2; ++i) { int R, C; stage_rc(tid * 16 + i * 8192, R, C);
#pragma unroll
            for (int h = 0; h < 2; ++h) vA[h][i] = (raw[h][i] * 1024u + (unsigned)C) * 2u; }
    }
};
struct MoeDownSched {
    static constexpr bool A_VARIES = false;
    __device__ __forceinline__ size_t kstep() const { return (size_t)(BK * 2); }
    const bf16_t* Hb; const bf16_t* W; const PG8_LAS int* tab; int G, c;
    __device__ __forceinline__ bool next(int i, Unit& u) const {
        const int id = i * G + c; const int nb = __builtin_amdgcn_readfirstlane(tab[32]); if (id >= nb * 4) return false;
        const int blk = id >> 2; u.pm = blk; u.pn = id & 3; u.e = __builtin_amdgcn_readfirstlane(tab[64 + blk]); u.jb = blk - __builtin_amdgcn_readfirstlane(tab[16 + u.e]); return true;
    }
    __device__ __forceinline__ void addr(const Unit& u, int tid, const char*& a, unsigned (&vA)[2][2], const char*& b) const {
        asm volatile("" : "+v"(tid));
        a = (const char*)Hb + (size_t)u.pm * BM * DFF * 2; b = (const char*)W + ((size_t)u.e * 1024 + (size_t)u.pn * BM) * DFF * 2;
#pragma unroll
        for (int i = 0; i < 2; ++i) { int R, C; stage_rc(tid * 16 + i * 8192, R, C);
#pragma unroll
            for (int h = 0; h < 2; ++h) vA[h][i] = (unsigned)((h * HALF + R) * DFF + C) * 2u; }
    }
};

struct EpiBf16 {
    static constexpr bool PERM = true;
    struct Pre {}; __device__ __forceinline__ void prefetch(const Unit&, int, int, int, int, Pre&) const {}
    bf16_t* O; int ldc; bf16_t* UG;
    __device__ __forceinline__ void operator()(const f32x4 (&acc)[2][2][4][2], const Unit& u, int wr, int wc, int fr, int fq, const Pre& pre) const { (void)pre;
        asm volatile("" : "+v"(fr), "+v"(fq));
        const int row0 = u.pm * BM + wr * 64 + fr; const int col0 = u.pn * BM + wc * 32 + 8 * fq;
#pragma unroll
        for (int ai = 0; ai < 2; ++ai)
#pragma unroll
            for (int m = 0; m < 4; ++m) { bf16_t* rowp = O + (size_t)(row0 + ai * HALF + m * 16) * ldc + col0;
#pragma unroll
                for (int bj = 0; bj < 2; ++bj) { const f32x4 v0 = acc[ai][bj][m][0], v1 = acc[ai][bj][m][1];
                    u32x4 w; w.x = pk2(v0[0], v0[1]); w.y = pk2(v0[2], v0[3]); w.z = pk2(v1[0], v1[1]); w.w = pk2(v1[2], v1[3]);
                    const int col = col0 + bj * HALF;
                    if (col >= C_US) { if (col < DIN) *(u32x4*)(UG + ((size_t)((col - C_US) >> 4) * TOK + (size_t)(row0 + ai * HALF + m * 16)) * 16 + ((col - C_US) & 15)) = w; }
                    else *(u32x4*)(rowp + bj * HALF) = w; } }
    }
};
struct EpiResF32 {
    static constexpr bool PERM = true;
    struct Pre { u32x4 x0[4][2]; };
    __device__ __forceinline__ void prefetch(const Unit& u, int wr, int wc, int fr, int fq, Pre& pre) const {
        const int row0 = u.pm * BM + wr * 64 + fr; const int col0 = u.pn * BM + wc * 32 + 8 * fq;
#pragma unroll
        for (int m = 0; m < 4; ++m)
#pragma unroll
            for (int bj = 0; bj < 2; ++bj) pre.x0[m][bj] = *(const u32x4*)(XBp + (size_t)(row0 + m * 16) * DM + col0 + bj * HALF);
    }
    bf16_t* V; const bf16_t* XBp;
    __device__ __forceinline__ void operator()(const f32x4 (&acc)[2][2][4][2], const Unit& u, int wr, int wc, int fr, int fq, const Pre& pre) const { (void)pre;
        asm volatile("" : "+v"(fr), "+v"(fq));
        const int row0 = u.pm * BM + wr * 64 + fr; const int col0 = u.pn * BM + wc * 32 + 8 * fq;
#pragma unroll
        for (int ai = 0; ai < 2; ++ai) {
            u32x4 xbv[4][2];
#pragma unroll
            for (int m = 0; m < 4; ++m)
#pragma unroll
                for (int bj = 0; bj < 2; ++bj) xbv[m][bj] = ai == 0 ? pre.x0[m][bj] : *(const u32x4*)(XBp + (size_t)(row0 + ai * HALF + m * 16) * DM + col0 + bj * HALF);
#pragma unroll
            for (int m = 0; m < 4; ++m)
#pragma unroll
                for (int bj = 0; bj < 2; ++bj) { float x[8]; unpack8(xbv[m][bj], x); const f32x4 a0 = acc[ai][bj][m][0], a1 = acc[ai][bj][m][1];
                    *(u32x4*)(V + (size_t)(row0 + ai * HALF + m * 16) * DM + col0 + bj * HALF) = (u32x4){pk2(ALPHA * x[0] + a0[0], ALPHA * x[1] + a0[1]), pk2(ALPHA * x[2] + a0[2], ALPHA * x[3] + a0[3]),
                                                                                                    pk2(ALPHA * x[4] + a1[0], ALPHA * x[5] + a1[1]), pk2(ALPHA * x[6] + a1[2], ALPHA * x[7] + a1[3])}; } }
    }
};
__device__ __forceinline__ float silu_f(float x) { return x * __builtin_amdgcn_rcpf(1.0f + __builtin_amdgcn_exp2f(-1.4426950408889634f * x)); }
struct EpiSwiGLU {
    static constexpr bool PERM = true;
    struct Pre {}; __device__ __forceinline__ void prefetch(const Unit&, int, int, int, int, Pre&) const {}
    bf16_t* Hb;
    __device__ __forceinline__ void operator()(const f32x4 (&acc)[2][2][4][2], const Unit& u, int wr, int wc, int fr, int fq, const Pre& pre) const { (void)pre;
        asm volatile("" : "+v"(fr), "+v"(fq));
        const int row0 = u.pm * BM + wr * 64 + fr; const int col0 = u.pn * HALF + wc * 32 + 8 * fq;
#pragma unroll
        for (int ai = 0; ai < 2; ++ai)
#pragma unroll
            for (int m = 0; m < 4; ++m) { bf16_t* p = Hb + (size_t)(row0 + ai * HALF + m * 16) * DFF + col0;
                const f32x4 g0 = acc[ai][0][m][0], g1 = acc[ai][0][m][1], u0 = acc[ai][1][m][0], u1 = acc[ai][1][m][1];
                u32x4 w; w.x = pk2(silu_f(g0[0]) * u0[0], silu_f(g0[1]) * u0[1]); w.y = pk2(silu_f(g0[2]) * u0[2], silu_f(g0[3]) * u0[3]);
                w.z = pk2(silu_f(g1[0]) * u1[0], silu_f(g1[1]) * u1[1]); w.w = pk2(silu_f(g1[2]) * u1[2], silu_f(g1[3]) * u1[3]);
                *(u32x4*)p = w; }
    }
};
struct EpiMoeScatter {
    static constexpr bool PERM = true;
    struct Pre { unsigned tkv[2][4]; float wv[2][4]; };
    __device__ __forceinline__ void prefetch(const Unit& u, int wr, int wc, int fr, int fq, Pre& pre) const { (void)wc; (void)fq;
        const int cnt = __builtin_amdgcn_readfirstlane(tab[u.e]); const size_t lbase = (size_t)u.e * LCAP + (size_t)u.jb * 256;
#pragma unroll
        for (int ai = 0; ai < 2; ++ai)
#pragma unroll
            for (int m = 0; m < 4; ++m) { const int r = ai * HALF + wr * 64 + m * 16 + fr; const bool ok = u.jb * 256 + r < cnt; pre.tkv[ai][m] = ok ? ltok[lbase + r] : 0u; pre.wv[ai][m] = ok ? lw[lbase + r] : 0.f; }
    }
    bf16_t* YM0; bf16_t* YM1; const unsigned* ltok; const float* lw; const PG8_LAS int* tab;
    __device__ __forceinline__ void operator()(const f32x4 (&acc)[2][2][4][2], const Unit& u, int wr, int wc, int fr, int fq, const Pre& pre) const { (void)pre;
        asm volatile("" : "+v"(fr), "+v"(fq));
        const int cnt = __builtin_amdgcn_readfirstlane(tab[u.e]); const int col0 = u.pn * BM + wc * 32 + 8 * fq;
        const size_t lbase = (size_t)u.e * LCAP + (size_t)u.jb * 256;
#pragma unroll
        for (int ai = 0; ai < 2; ++ai)
#pragma unroll
            for (int m = 0; m < 4; ++m) { const int r = ai * HALF + wr * 64 + m * 16 + fr;
                if (u.jb * 256 + r < cnt) {
                    const unsigned tk = pre.tkv[ai][m]; const float w = pre.wv[ai][m];
                    bf16_t* p = ((tk >> 31) ? YM1 : YM0) + (size_t)(tk & 0x7fffffffu) * DM + col0;
#pragma unroll
                    for (int bj = 0; bj < 2; ++bj) { const f32x4 v0 = acc[ai][bj][m][0], v1 = acc[ai][bj][m][1];
                        u32x4 o; o.x = pk2(w * v0[0], w * v0[1]); o.y = pk2(w * v0[2], w * v0[3]); o.z = pk2(w * v1[0], w * v1[1]); o.w = pk2(w * v1[2], w * v1[3]);
                        *(u32x4*)(p + bj * HALF) = o; } } }
    }
};

struct S5ASched {
    static constexpr bool A_VARIES = false;
    const bf16_t* UGp; const bf16_t* Mg; int G, c;
    __device__ __forceinline__ size_t kstep() const { return (size_t)(BK * 2); }
    __device__ __forceinline__ bool next(int i, Unit& u) const { const int id = i * G + c; if (id >= 192) return false; const int e_ = id / 12, rem = id - 12 * e_, pm_ = rem / 3; u.e = __builtin_amdgcn_readfirstlane(e_); u.pm = __builtin_amdgcn_readfirstlane(pm_); u.pn = __builtin_amdgcn_readfirstlane(rem - 3 * pm_); u.jb = 0; return true; }
    __device__ __forceinline__ void addr(const Unit& u, int tid, const char*& a, unsigned (&vA)[2][2], const char*& b) const {
        asm volatile("" : "+v"(tid));
        a = (const char*)UGp + ((size_t)u.e * TOK * 16 + (size_t)u.pm * BM * 512) * 2; b = (const char*)Mg + ((size_t)u.e * 768 + (size_t)u.pn * BM) * 512 * 2;
#pragma unroll
        for (int i = 0; i < 2; ++i) { int R, C; stage_rc(tid * 16 + i * 8192, R, C);
#pragma unroll
            for (int h = 0; h < 2; ++h) vA[h][i] = (unsigned)((h * HALF + R) * 512 + C) * 2u; }
    }
};
struct S5BSched {
    static constexpr bool A_VARIES = false;
    const bf16_t* CB; const bf16_t* MC; int G, c;
    __device__ __forceinline__ size_t kstep() const { return (size_t)(BK * 2); }
    __device__ __forceinline__ bool next(int i, Unit& u) const { const int id = __builtin_amdgcn_readfirstlane(i * G + c); if (id >= 128) return false; u.e = id >> 3; u.pm = (id & 7) >> 1; u.pn = id & 1; u.jb = 0; return true; }
    __device__ __forceinline__ void addr(const Unit& u, int tid, const char*& a, unsigned (&vA)[2][2], const char*& b) const {
        asm volatile("" : "+v"(tid));
        a = (const char*)CB + ((size_t)u.e * 1024 + (size_t)u.pm * BM) * 128 * 2; b = (const char*)MC + ((size_t)u.e * 512 + (size_t)u.pn * BM) * 128 * 2;
#pragma unroll
        for (int i = 0; i < 2; ++i) { int R, C; stage_rc(tid * 16 + i * 8192, R, C);
#pragma unroll
            for (int h = 0; h < 2; ++h) vA[h][i] = (unsigned)((h * HALF + R) * 128 + C) * 2u; }
    }
};
struct EpiS5A {
    static constexpr bool PERM = true;
    struct Pre {}; __device__ __forceinline__ void prefetch(const Unit&, int, int, int, int, Pre&) const {}
    bf16_t* YI; float* EG;
    __device__ __forceinline__ void operator()(const f32x4 (&acc)[2][2][4][2], const Unit& u, int wr, int wc, int fr, int fq, const Pre& pre) const { (void)pre;
        asm volatile("" : "+v"(fr), "+v"(fq));
        const int row0 = u.pm * BM + wr * 64 + fr;
#pragma unroll
        for (int ai = 0; ai < 2; ++ai)
#pragma unroll
            for (int m = 0; m < 4; ++m) { const int q = row0 + ai * HALF + m * 16;
                if (u.pn < 2) {
#pragma unroll
                    for (int bj = 0; bj < 2; ++bj) { const int tc = u.pn * BM + bj * HALF + wc * 32 + 8 * fq; const f32x4 v0 = acc[ai][bj][m][0], v1 = acc[ai][bj][m][1];
                        u32x4 w; w.x = pk2(v0[0], v0[1]); w.y = pk2(v0[2], v0[3]); w.z = pk2(v1[0], v1[1]); w.w = pk2(v1[2], v1[3]);
                        *(u32x4*)(YI + ((size_t)q * 32 + (tc >> 4)) * 256 + u.e * 16 + (tc & 15)) = w; }
                } else { float* ep = EG + ((size_t)u.e * 1024 + q) * 128 + wc * 32 + 8 * fq; *(f32x4*)ep = acc[ai][0][m][0]; *(f32x4*)(ep + 4) = acc[ai][0][m][1]; } }
    }
};
__device__ __forceinline__ float gelu_tanh_f(float v) { const float z = 0.7978845608028654f * (v + 0.044715f * v * v * v); const float e = __builtin_amdgcn_exp2f(2.8853900817779268f * z); return 0.5f * v * (2.0f - 2.0f * __builtin_amdgcn_rcpf(e + 1.0f)); }
struct EpiS5B {
    static constexpr bool PERM = true;
    struct Pre {}; __device__ __forceinline__ void prefetch(const Unit&, int, int, int, int, Pre&) const {}
    bf16_t* YI; const bf16_t* UGp; const float* dsk;
    __device__ __forceinline__ void operator()(const f32x4 (&acc)[2][2][4][2], const Unit& u, int wr, int wc, int fr, int fq, const Pre& pre) const { (void)pre;
        asm volatile("" : "+v"(fr), "+v"(fq));
        const int row0 = u.pm * BM + wr * 64 + fr;
        const int chl = u.e * 16 + 8 * (fq & 1);
        const f32x4 d0 = *(const f32x4*)(dsk + chl), d1 = *(const f32x4*)(dsk + chl + 4);
#pragma unroll
        for (int aim = 0; aim < 4; ++aim) { const int ai = aim >> 1, m0 = (aim & 1) * 2;
            u32x4 yvv[4][2], uvv[4][2];
#pragma unroll
            for (int m = m0; m < m0 + 2; ++m) { const int q = row0 + ai * HALF + m * 16;
#pragma unroll
                for (int bj = 0; bj < 2; ++bj) { const int tc = u.pn * BM + bj * HALF + wc * 32 + 8 * fq; const size_t tok = (size_t)q * 32 + (tc >> 4); const int ch = u.e * 16 + (tc & 15);
                    yvv[m][bj] = *(const u32x4*)(YI + tok * 256 + ch); uvv[m][bj] = *(const u32x4*)(UGp + ((size_t)u.e * TOK + tok) * 16 + (tc & 15)); } }
#pragma unroll
            for (int m = m0; m < m0 + 2; ++m) { const int q = row0 + ai * HALF + m * 16;
#pragma unroll
                for (int bj = 0; bj < 2; ++bj) { const int tc = u.pn * BM + bj * HALF + wc * 32 + 8 * fq; const size_t tok = (size_t)q * 32 + (tc >> 4); const int ch = u.e * 16 + (tc & 15);
                    bf16_t* yp = YI + tok * 256 + ch; const u32x4 yv = yvv[m][bj], uv = uvv[m][bj];
                    const f32x4 v0 = acc[ai][bj][m][0], v1 = acc[ai][bj][m][1];
                    float y[8], uu[8]; unpack8(yv, y); unpack8(uv, uu);
                    float o[8];
#pragma unroll
                    for (int k = 0; k < 4; ++k) { o[k] = gelu_tanh_f(v0[k] + y[k] + d0[k] * uu[k]); o[4 + k] = gelu_tanh_f(v1[k] + y[4 + k] + d1[k] * uu[4 + k]); }
                    *(u32x4*)yp = (u32x4){pk2(o[0], o[1]), pk2(o[2], o[3]), pk2(o[4], o[5]), pk2(o[6], o[7])}; } } }
    }
};
struct EpiGLU {
    static constexpr bool PERM = true;
    struct Pre {}; __device__ __forceinline__ void prefetch(const Unit&, int, int, int, int, Pre&) const {}
    const bf16_t* YG; const float* bg; bf16_t* YMIXp;
    __device__ __forceinline__ void operator()(const f32x4 (&acc)[2][2][4][2], const Unit& u, int wr, int wc, int fr, int fq, const Pre& pre) const { (void)pre;
        asm volatile("" : "+v"(fr), "+v"(fq));
        const int row0 = u.pm * BM + wr * 64 + fr;
        f32x4 bb0[2], bb1[2];
#pragma unroll
        for (int bj = 0; bj < 2; ++bj) { const int col = bj * HALF + wc * 32 + 8 * fq; bb0[bj] = *(const f32x4*)(bg + col); bb1[bj] = *(const f32x4*)(bg + col + 4); }
#pragma unroll
        for (int ai = 0; ai < 2; ++ai) {
            u32x4 ygv[2][4][2];
#pragma unroll
            for (int m = 0; m < 4; ++m)
#pragma unroll
                for (int bj = 0; bj < 2; ++bj) ygv[ai][m][bj] = *(const u32x4*)(YG + (size_t)(row0 + ai * HALF + m * 16) * 256 + bj * HALF + wc * 32 + 8 * fq);
#pragma unroll
            for (int m = 0; m < 4; ++m) { const size_t row = (size_t)(row0 + ai * HALF + m * 16);
#pragma unroll
                for (int bj = 0; bj < 2; ++bj) { const int col = bj * HALF + wc * 32 + 8 * fq; const u32x4 yv = ygv[ai][m][bj];
                    const f32x4 b0 = bb0[bj], b1 = bb1[bj]; const f32x4 v0 = acc[ai][bj][m][0], v1 = acc[ai][bj][m][1];
                    float y[8]; unpack8(yv, y); float o[8];
#pragma unroll
                    for (int k = 0; k < 4; ++k) { o[k] = y[k] * __builtin_amdgcn_rcpf(1.0f + __builtin_amdgcn_exp2f(-1.4426950408889634f * (v0[k] + b0[k]))); o[4 + k] = y[4 + k] * __builtin_amdgcn_rcpf(1.0f + __builtin_amdgcn_exp2f(-1.4426950408889634f * (v1[k] + b1[k]))); }
                    *(u32x4*)(YMIXp + row * DM + 768 + col) = (u32x4){pk2(o[0], o[1]), pk2(o[2], o[3]), pk2(o[4], o[5]), pk2(o[6], o[7])}; } } }
    }
};
}

#define XB_TMO      128
#define XB_XCNT(j)  (256  + 64 * (j))
#define XB_XSUB(j)  (1280 + 64 * (j))
#define XB_XGEN(j)  (2304 + 64 * (j))
#define XB_TOP      3328
#define XB_TOPGEN   3392
#define XCD_BAR_WORDS 3456
#define XB_SPIN_CAP (1u << 22)
DI unsigned xb_ld(unsigned* p)              { return __hip_atomic_load(p, __ATOMIC_RELAXED, __HIP_MEMORY_SCOPE_AGENT); }
DI unsigned xb_add(unsigned* p, unsigned v) { return __hip_atomic_fetch_add(p, v, __ATOMIC_RELAXED, __HIP_MEMORY_SCOPE_AGENT); }
DI unsigned xb_xcc_id() { return (unsigned)__builtin_amdgcn_s_getreg((3 << 11) | 20) & 0xFu; }
#define XB_SPIN(cond, bar) do { unsigned _sp = 0; while (cond) { __builtin_amdgcn_s_sleep(1); \
    if ((++_sp & 255u) == 0u) { if (xb_ld(&(bar)[XB_TMO])) break; if (_sp > XB_SPIN_CAP) { atomicAdd(&(bar)[XB_TMO], 1u); break; } } } } while (0)
struct XcdBarrier { unsigned* bar; unsigned x; volatile LAS unsigned* st; };
DI XcdBarrier xcd_barrier_post(unsigned* bar, volatile LAS unsigned* st) {
    XcdBarrier b; b.bar = bar; b.x = xb_xcc_id(); b.st = st;
    if (threadIdx.x == 0) (void)xb_add(&bar[XB_XCNT(b.x)], 1u);
    return b;
}
DI void xcd_barrier_complete(unsigned* bar, unsigned x, unsigned& nloc, unsigned& nx) {
    const unsigned G = gridDim.x * gridDim.y * gridDim.z;
    unsigned sum, cnt, mine, sp = 0u;
    for (;;) {
        sum = 0u; cnt = 0u; mine = 0u;
#pragma unroll
        for (unsigned j = 0; j < 16; ++j) { const unsigned c = xb_ld(&bar[XB_XCNT(j)]); sum += c; cnt += (c > 0u) ? 1u : 0u; mine = (j == x) ? c : mine; }
        if (sum == G) break;
        __builtin_amdgcn_s_sleep(1);
        if ((++sp & 255u) == 0u) { if (xb_ld(&bar[XB_TMO])) break; if (sp > XB_SPIN_CAP) { atomicAdd(&bar[XB_TMO], 1u); break; } }
    }
    nloc = mine > 0u ? mine : 1u; nx = cnt > 0u ? cnt : 1u;
}
DI void xcd_barrier(const XcdBarrier& b) {
    asm volatile("s_waitcnt vmcnt(0)" ::: "memory");
    __syncthreads();
    if (threadIdx.x == 0) {
        unsigned* bar = b.bar;
        __builtin_amdgcn_s_waitcnt(0);
        unsigned nloc = b.st[0], nx = b.st[1];
        if (nloc == 0u) { xcd_barrier_complete(bar, b.x, nloc, nx); b.st[0] = nloc; b.st[1] = nx; }
        const unsigned old = xb_add(&bar[XB_XSUB(b.x)], 1u);
        const unsigned gen = old / nloc;
        if (old + 1u == (gen + 1u) * nloc) {
            __builtin_amdgcn_fence(__ATOMIC_RELEASE, "agent");
            asm volatile("s_waitcnt vmcnt(0)" ::: "memory");
            const unsigned og = xb_add(&bar[XB_TOP], 1u);
            const unsigned tg = og / nx;
            if (og + 1u == (tg + 1u) * nx) xb_add(&bar[XB_TOPGEN], 1u);
            else XB_SPIN(xb_ld(&bar[XB_TOPGEN]) == tg, bar);
            __builtin_amdgcn_fence(__ATOMIC_ACQUIRE, "agent");
            xb_add(&bar[XB_XGEN(b.x)], 1u);
            asm volatile("s_waitcnt vmcnt(0)" ::: "memory");
        } else {
            XB_SPIN(xb_ld(&bar[XB_XGEN(b.x)]) == gen, bar);
            __builtin_amdgcn_fence(__ATOMIC_ACQUIRE, "agent");
            asm volatile("s_waitcnt vmcnt(0)" ::: "memory");
        }
    }
    __syncthreads();
}

struct Args { const float* in[22]; float* out; unsigned char* ws; int ph_lo, ph_hi; };
typedef const __attribute__((address_space(4))) Args* KArgs;
struct Frame {
    LAS unsigned char* lds;
    KArgs ka;
    int tid, lane, wave, wg, G;
};
struct Ptrs {
    KArgs a; unsigned char* ws; float* out;
    DI const float* in(int k) const { return a->in[k]; }
    DI unsigned* ctl() const { return (unsigned*)(ws + WS_CTL); }
    DI bf16* Win_t() const { return (bf16*)(ws + WS_WIN); }
    DI bf16* Wout_t() const { return (bf16*)(ws + WS_WOUT); }
    DI bf16* Wgu_t() const { return (bf16*)(ws + WS_WGU); }
    DI bf16* Wd_t() const { return (bf16*)(ws + WS_WD); }
    DI bf16* XB() const { return (bf16*)(ws + WS_XB); }
    DI bf16* X1B() const { return (bf16*)(ws + WS_X1B); }
    DI bf16* PROJ() const { return (bf16*)(ws + WS_PROJ); }
    DI bf16* YMIX() const { return (bf16*)(ws + WS_YMIX); }
    DI bf16* Hb() const { return (bf16*)(ws + WS_H); }
    DI bf16* YM0() const { return (bf16*)(ws + WS_YM0); }
    DI bf16* YM1() const { return (bf16*)(ws + WS_YM1); }
    DI unsigned* ltok() const { return (unsigned*)(ws + WS_LTOK); }
    DI float* lw() const { return (float*)(ws + WS_LW); }
    DI float* small() const { return (float*)(ws + WS_SMALL); }
    DI float* kmean() const { return (float*)(ws + WS_SMALL + SM_KMEAN); }
    DI bf16* retkv() const { return (bf16*)((unsigned char*)out + DO_RETKV); }
    DI bf16* ug() const { return (bf16*)((unsigned char*)out + DO_UG); }
    DI float* s5e() const { return (float*)((unsigned char*)out + DO_S5E); }
    DI float* yg() const { return (float*)(ws + WS_X1B + X1_YG); }
    DI bf16* yi() const { return (bf16*)(ws + WS_X1B + X1_YI); }
    DI float* s5eg() const { return (float*)(ws + WS_X1B + X1_S5EG); }
    DI bf16* s5cb() const { return (bf16*)(ws + WS_X1B + X1_S5CB); }
    DI bf16* s5m() const { return (bf16*)(ws + WS_X1B + X1_S5M); }
    DI bf16* s5mc() const { return (bf16*)(ws + WS_X1B + X1_S5MC); }
    DI bf16* wglut() const { return (bf16*)(ws + WS_SMALL + SM_WGLUT); }
    DI u32x4* rimg() const { return (u32x4*)(ws + WS_SMALL + SM_RIMG); }
    DI unsigned short* mlist() const { return (unsigned short*)(ws + WS_X1B + X1_MLIST); }
    DI float* mml() const { return (float*)(ws + WS_X1B + X1_MML); }
    DI bf16* mpo() const { return (bf16*)((unsigned char*)out + DO_MPO); }
    DI bf16* V1() const { return (bf16*)out; }
};
DI Ptrs get_ptrs(const Frame& F) { KArgs a = F.ka; asm volatile("" : "+s"(a)); Ptrs P; P.a = a; P.ws = a->ws; P.out = a->out; return P; }

DI void transpose_item(const float* W, int K, int N, bf16* WT, int dst_row0, LAS float* scr, int k0, int n0, int lane) {
    f32x4 ld[8];
#pragma unroll
    for (int i = 0; i < 8; ++i) ld[i] = *(const f32x4*)(W + (size_t)(k0 + 8 * i + (lane >> 3)) * N + n0 + (lane & 7) * 4);
#pragma unroll
    for (int i = 0; i < 8; ++i) { LAS float* d = scr + (8 * i + (lane >> 3)) * 33 + (lane & 7) * 4; d[0] = ld[i][0]; d[1] = ld[i][1]; d[2] = ld[i][2]; d[3] = ld[i][3]; }
    asm volatile("s_waitcnt lgkmcnt(0)" ::: "memory");
    const int c = lane & 7;
#pragma unroll
    for (int j = 0; j < 4; ++j) { const int n = (lane >> 3) + 8 * j; const LAS float* s = scr + (8 * c) * 33 + n;
        u32x4 o; o.x = pk2(s[0 * 33], s[1 * 33]); o.y = pk2(s[2 * 33], s[3 * 33]); o.z = pk2(s[4 * 33], s[5 * 33]); o.w = pk2(s[6 * 33], s[7 * 33]);
        *(u32x4*)(WT + (size_t)(dst_row0 + n) * K + k0 + 8 * c) = o; }
    asm volatile("s_waitcnt lgkmcnt(0)" ::: "memory");
}
#define TS_MARKP(id) do { if (PROBE_TS_SEL != 0 && F.wg == PROBE_WG && F.wave == 0 && F.lane == 0) { __builtin_amdgcn_s_waitcnt(0); ((LAS unsigned long long*)(F.lds + LDSCTL_OFF + 4096))[64 + (id)] = __builtin_amdgcn_s_memrealtime(); } } while (0)
DI void conv_moe_item(const Ptrs& Q, int l, int idx, LAS float* scr, int lane) {
    if (idx < 8192) { const int sg = idx >> 12, rr = idx & 4095, le = l * 16 + (rr >> 8), q = rr & 255, kb = q >> 4, nb = q & 15; const int n0 = 32 * nb;
        const float* W = (sg ? Q.in(20) : Q.in(19)) + (size_t)le * DM * DFF;
        transpose_item(W, DM, DFF, Q.Wgu_t() + (size_t)le * 1024 * 1024, 256 * (n0 >> 7) + 128 * sg + (n0 & 127), scr, 64 * kb, n0, lane); }
    else { const int rr = idx - 8192, le = l * 16 + (rr >> 8), q = rr & 255, kb = q >> 5, nb = q & 31;
        transpose_item(Q.in(21) + (size_t)le * DFF * DM, DFF, DM, Q.Wd_t() + (size_t)le * 1024 * DFF, 32 * nb, scr, 64 * kb, 32 * nb, lane); }
}
constexpr int MOE_CONV_ITEMS = 12288;
DI void ph_conv_deferred(Frame& F, int half) {
    const Ptrs Q = get_ptrs(F);
    LAS float* scr = (LAS float*)(F.lds + F.wave * 16384);
    int slot, nslots;
    if (F.G == 256) { const int vcu = (F.wg & 7) * 32 + (F.wg >> 3); if (vcu < 96) return; slot = (vcu - 96) * NWAVES + F.wave; nslots = 160 * NWAVES; }
    else { slot = F.wg * NWAVES + F.wave; nslots = F.G * NWAVES; }
    for (int i = slot; i < MOE_CONV_ITEMS / 2; i += nslots) conv_moe_item(Q, 1, half * (MOE_CONV_ITEMS / 2) + i, scr, F.lane);
}
DI void ph_prologue(Frame& F) {
    const Ptrs Q = get_ptrs(F);
    TS_MARKP(11);
    LAS float* scr = (LAS float*)(F.lds + F.wave * 16384);
    const int gw = F.wg * NWAVES + F.wave, NGW = F.G * NWAVES;
    constexpr int I_IN = 16 * 92;
    constexpr int I_OUT = 16 * 32;
    constexpr int N_IN = 2 * I_IN, N_OUT = 2 * I_OUT, N_GLU = 2 * 32;
    constexpr int NITEMS = N_IN + N_OUT + N_GLU + MOE_CONV_ITEMS;
    for (int it = gw; it < NITEMS; it += NGW) {
        int r = it;
        if (r < N_IN) { const int l = r / I_IN, q = r % I_IN, kb = q / 92, nb = q % 92;
            transpose_item(Q.in(1) + (size_t)l * DM * DIN, DM, DIN, Q.Win_t() + (size_t)l * DINP * DM, 32 * nb, scr, 64 * kb, 32 * nb, F.lane); continue; }
        r -= N_IN;
        if (r < N_OUT) { const int l = r / I_OUT, q = r % I_OUT, kb = q / 32, nb = q % 32;
            transpose_item(Q.in(2) + (size_t)l * DM * DM, DM, DM, Q.Wout_t() + (size_t)l * DM * DM, 32 * nb, scr, 64 * kb, 32 * nb, F.lane); continue; }
        r -= N_OUT;
        if (r < N_GLU) { const int l = r / 32, q = r % 32, kb = q / 8, nb = q % 8;
            transpose_item(Q.in(11) + (size_t)l * 65536, 256, 256, Q.wglut() + (size_t)l * 65536, 32 * nb, scr, 64 * kb, 32 * nb, F.lane); continue; }
        r -= N_GLU;
        conv_moe_item(Q, 0, r, scr, F.lane);
    }
    TS_MARKP(12);
    const int gt = F.wg * NTHR + F.tid, NGT = F.G * NTHR;
    for (int i = gt; i < 2 * 128 * DM / 8; i += NGT) { const int l = i / (128 * DM / 8), q = i % (128 * DM / 8);
        *(u32x4*)(Q.Win_t() + (size_t)l * DINP * DM + (size_t)DIN * DM + (size_t)q * 8) = (u32x4){0u, 0u, 0u, 0u}; }
    for (int idx = gt; idx < 2048; idx += NGT) { const int s_ = idx >> 6, ln = idx & 63; const float* wp = Q.in(17) + (size_t)(32 * s_ + 8 * (ln >> 4)) * 16 + (ln & 15);
        float w[8], hf[8];
#pragma unroll
        for (int j = 0; j < 8; ++j) w[j] = wp[16 * j];
        const u32x4 h = (u32x4){pk2(w[0], w[1]), pk2(w[2], w[3]), pk2(w[4], w[5]), pk2(w[6], w[7])}; unpack8(h, hf);
        Q.rimg()[idx] = h; Q.rimg()[2048 + idx] = (u32x4){pk2(w[0] - hf[0], w[1] - hf[1]), pk2(w[2] - hf[2], w[3] - hf[3]), pk2(w[4] - hf[4], w[5] - hf[5]), pk2(w[6] - hf[6], w[7] - hf[7])}; }
    for (int i = gt; i < TOK * DM / 8; i += NGT) { const f32x4 a = *(const f32x4*)(Q.in(0) + (size_t)i * 8), b = *(const f32x4*)(Q.in(0) + (size_t)i * 8 + 4);
        u32x4 o; o.x = pk2(a[0], a[1]); o.y = pk2(a[2], a[3]); o.z = pk2(b[0], b[1]); o.w = pk2(b[2], b[3]); *(u32x4*)(Q.XB() + (size_t)i * 8) = o; }
    TS_MARKP(13);
    for (int i = gt; i < 2 * 1024 * 51; i += NGT) { const int e = i % 51, lgn = i / 51, l = lgn >> 10, gn = lgn & 1023, g = gn >> 6;
        float* P = Q.small() + (size_t)l * SSMP_FLOATS;
        const float lr = fminf(Q.in(3)[l * 1024 + gn], -1e-4f), li = Q.in(4)[l * 1024 + gn], dt = expf(Q.in(5)[l * 16 + g]);
        if (e < 35) {
            const float tau = e <= 32 ? (float)e : (e == 33 ? 1.0f : 128.0f);
            float sn_, cs_; sincos_acc(tau * (li * dt), sn_, cs_); const float mg = expf(tau * (lr * dt));
            float* dst = e <= 32 ? P + SP_APOW + (gn * 33 + e) * 2 : (e == 33 ? P + gn * 2 : P + 2048 + gn * 2);
            dst[0] = mg * cs_; dst[1] = mg * sn_;
        } else { const int c = e - 35;
            float sn_, cs_; sincos_acc(li * dt, sn_, cs_);
            const float mag = expf(lr * dt), ar = mag * cs_, ai = mag * sn_;
            const float den = lr * lr + li * li, zr = ar - 1.0f, zi = ai;
            const float fr = (zr * lr + zi * li) / den, fi = (zi * lr - zr * li) / den;
            const float br = Q.in(6)[(size_t)l * 16384 + gn * 16 + c], bi = Q.in(7)[(size_t)l * 16384 + gn * 16 + c];
            P[4096 + (gn * 16 + c) * 2] = fr * br - fi * bi; P[4096 + (gn * 16 + c) * 2 + 1] = fr * bi + fi * br; } }
    TS_MARKP(14);
    __syncthreads();
    { LAS float* w = (LAS float*)F.lds;
      for (int it = F.wg; it < 2 * 16 * 32; it += F.G) { const int tau = it & 31, g = (it >> 5) & 15, l = it >> 9;
        for (int k = 0; k < 2; ++k) { const int idx = F.tid + 512 * k, n = idx >> 4, cp = idx & 15, gn = g * 64 + n;
            const float lr = fminf(Q.in(3)[l * 1024 + gn], -1e-4f), li = Q.in(4)[l * 1024 + gn], dt = expf(Q.in(5)[l * 16 + g]);
            float sn_, cs_; sincos_acc(li * dt, sn_, cs_);
            const float mag = expf(lr * dt), ar = mag * cs_, ai = mag * sn_;
            const float den = lr * lr + li * li, zr = ar - 1.0f, zi = ai;
            const float fr = (zr * lr + zi * li) / den, fi = (zi * lr - zr * li) / den;
            const float br = Q.in(6)[(size_t)l * 16384 + gn * 16 + cp], bi = Q.in(7)[(size_t)l * 16384 + gn * 16 + cp];
            const float bbr = fr * br - fi * bi, bbi = fr * bi + fi * br;
            float sn2, cs2; sincos_acc((float)tau * (li * dt), sn2, cs2);
            const float mg = expf((float)tau * (lr * dt)), pr = mg * cs2, pi = mg * sn2;
            w[idx * 2] = pr * bbr - pi * bbi; w[idx * 2 + 1] = pr * bbi + pi * bbr; }
        __syncthreads();
        if (F.tid < 256) { const int c = F.tid >> 4, cp = F.tid & 15; float acc = 0.f;
            const float* cr = Q.in(8) + (size_t)l * 16384 + (g * 16 + c) * 64; const float* ci = Q.in(9) + (size_t)l * 16384 + (g * 16 + c) * 64;
#pragma unroll 16
            for (int n = 0; n < 64; ++n) acc += cr[n] * w[(n * 16 + cp) * 2] - ci[n] * w[(n * 16 + cp) * 2 + 1];
            (Q.small() + (size_t)l * SSMP_FLOATS)[SP_KT + ((g * 32 + tau) * 16 + c) * 16 + cp] = acc; }
        __syncthreads(); } }
    TS_MARKP(15);
}

DI void p1_range(const Frame& F, int& lo, int& hi, int& step) { if (F.G == 256) { step = 1; if (F.wg < 64) { lo = F.wg * 6; hi = lo + 6; } else { lo = 384 + (F.wg - 64) * 2; hi = lo + 2; } } else { lo = F.wg; hi = 768; step = F.G; } }
DI void ph_kmean(Frame& F) {
    const Ptrs Q = get_ptrs(F);
    LAS float* red = (LAS float*)F.lds;
    int it_lo_, it_hi_, it_st_; p1_range(F, it_lo_, it_hi_, it_st_);
    for (int it = it_lo_; it < it_hi_; it += it_st_) {
        const int b = it / (NH * NKB), h = (it / NKB) % NH, n = it % NKB;
        const bf16* p = Q.PROJ() + (size_t)(b * SEQ + n * KBLK + (F.tid >> 3)) * DINP + C_KA + h * HD + 8 * (F.tid & 7);
        u32x4 v[4];
#pragma unroll
        for (int j = 0; j < 4; ++j) v[j] = *(const u32x4*)(p + (size_t)64 * j * DINP);
        float s[8];
#pragma unroll
        for (int k = 0; k < 8; ++k) s[k] = 0.f;
#pragma unroll
        for (int j = 0; j < 4; ++j) { float x[8]; unpack8(v[j], x);
#pragma unroll
            for (int k = 0; k < 8; ++k) s[k] += x[k]; }
#pragma unroll
        for (int k = 0; k < 8; ++k) { s[k] += dppf<DPP_ROR8>(s[k]); s[k] = swap16_sum(s[k], s[k]); s[k] = swap32_sum(s[k], s[k]); }
        if (F.lane < 8) {
#pragma unroll
            for (int k = 0; k < 8; ++k) red[F.wave * 64 + 8 * F.lane + k] = s[k]; }
        __syncthreads();
        if (F.tid < 64) { float t = 0.f; for (int w = 0; w < 8; ++w) t += red[w * 64 + F.tid]; Q.kmean()[(size_t)((b * NH + h) * NKB + n) * HD + F.tid] = t * (1.0f / 256.0f); }
        __syncthreads();
    }
}
template <int MODE> DI void load_tile128(Frame& F, const bf16* src, LAS float* dst, float log2g) {
    const int row = F.tid >> 2, c0 = (F.tid & 3) * 16;
    const u32x4 a = *(const u32x4*)(src + (size_t)row * DINP + c0), b = *(const u32x4*)(src + (size_t)row * DINP + c0 + 8);
    float v[16]; unpack8(a, v); unpack8(b, v + 8);
    float sc = 1.0f; if (MODE == 1) sc = 0.125f; if (MODE == 2) sc = 0.125f * exp2f(log2g * (float)(127 - row));
#pragma unroll
    for (int k = 0; k < 16; k += 4) *(LAS f32x4*)(dst + row * 64 + c0 + k) = (f32x4){v[k] * sc, v[k + 1] * sc, v[k + 2] * sc, v[k + 3] * sc};
}
DI void ph_ret_kv(Frame& F) {
    const Ptrs Q = get_ptrs(F);
    LAS float* Ks = (LAS float*)F.lds; LAS float* Vs = Ks + 8192;
    for (int it = F.wg; it < BATCH * 128 * NH; it += F.G) {
        const int b = it / (128 * NH), c = (it / NH) % 128, h = it % NH;
        const float lg = ret_log2g(h);
        const bf16* base = Q.PROJ() + (size_t)(b * SEQ + c * 128) * DINP + h * HD;
        load_tile128<2>(F, base + C_KR, Ks, lg); load_tile128<0>(F, base + C_VR, Vs, lg);
        __syncthreads();
        float* o = (float*)Q.retkv() + (size_t)((b * 128 + c) * NH + h) * 4096;
        for (int i = 0; i < 8; ++i) { const int idx = F.tid + 512 * i, dk = idx >> 6, dv = idx & 63; float acc = 0.f;
            for (int j = 0; j < 128; ++j) acc += Ks[j * 64 + dk] * Vs[j * 64 + dv];
            o[idx] = acc; }
        __syncthreads();
    }
}
DI void ph_scans(Frame& F, int l, int blk_lo, int blk_hi, int blk_step) {
    const Ptrs Q = get_ptrs(F);
    const int gt = F.wg * NTHR + F.tid, NGT = F.G * NTHR;
    for (int blk = blk_lo; blk < blk_hi; blk += blk_step) { const int i = blk * NTHR + F.tid; const int e = i & 4095, h = (i >> 12) % NH, b = i / (NH * 4096);
        const float d128 = exp2f(ret_log2g(h) * 128.0f); float st = 0.f;
        bf16* p = Q.retkv() + (size_t)(b * 128 * NH + h) * 4096 + e;
        for (int cb = 0; cb < 128; cb += 16) { float t[16];
#pragma unroll
            for (int c = 0; c < 16; ++c) t[c] = bf2f(p[(size_t)(cb + c) * NH * 4096]);
#pragma unroll
            for (int c = 0; c < 16; ++c) { p[(size_t)(cb + c) * NH * 4096] = (bf16)pk2(st, 0.f); st = st * d128 + t[c]; } } }
    const float* P = Q.small() + (size_t)l * SSMP_FLOATS;
    for (int i = gt; i < (S5_SIMPLE ? BATCH * 16 * 64 : 0); i += NGT) { const int n = i & 63, g = (i >> 6) & 15, b = i >> 10;
        const float ar = P[2048 + (g * 64 + n) * 2], ai = P[2048 + (g * 64 + n) * 2 + 1]; float sr = 0.f, si = 0.f;
        float* p = Q.s5e() + ((size_t)((b * 16 + g) * 128) * 64 + n) * 2;
        for (int cb = 0; cb < 128; cb += 16) { f32x2 t[16];
#pragma unroll
            for (int c = 0; c < 16; ++c) t[c] = *(const f32x2*)(p + (size_t)(cb + c) * 128);
#pragma unroll
            for (int c = 0; c < 16; ++c) { *(f32x2*)(p + (size_t)(cb + c) * 128) = (f32x2){sr, si};
                const float nr = ar * sr - ai * si + t[c][0], ni = ar * si + ai * sr + t[c][1]; sr = nr; si = ni; } } }
}
DI void ph_s5_build(Frame& F, int l) {
    const Ptrs Q = get_ptrs(F);
    const float* P = Q.small() + (size_t)l * SSMP_FLOATS;
    const int gt = F.wg * NTHR + F.tid, NGT = F.G * NTHR;
    for (int i = gt; i < 16 * 768 * 64; i += NGT) { const int k8 = i & 63, row = (i >> 6) % 768, g = i / (768 * 64); const int sidx = k8 >> 1, c0 = (k8 & 1) * 8;
        float v[8];
#pragma unroll
        for (int j = 0; j < 8; ++j) v[j] = 0.f;
        if (row < 512) { const int t = row >> 4, c = row & 15; if (t >= sidx) { const float* kt = P + SP_KT + ((g * 32 + (t - sidx)) * 16 + c) * 16 + c0;
#pragma unroll
                for (int j = 0; j < 8; ++j) v[j] = kt[j]; } }
        else if (row < 640) { const int ri = (row - 512) >> 6, n = (row - 512) & 63; const float pr = P[SP_APOW + ((g * 64 + n) * 33 + (31 - sidx)) * 2], pi = P[SP_APOW + ((g * 64 + n) * 33 + (31 - sidx)) * 2 + 1];
#pragma unroll
            for (int j = 0; j < 8; ++j) { const float br = P[4096 + ((g * 64 + n) * 16 + c0 + j) * 2], bi = P[4096 + ((g * 64 + n) * 16 + c0 + j) * 2 + 1]; v[j] = ri == 0 ? (pr * br - pi * bi) : (pr * bi + pi * br); } }
        *(u32x4*)(Q.s5m() + (size_t)i * 8) = (u32x4){pk2(v[0], v[1]), pk2(v[2], v[3]), pk2(v[4], v[5]), pk2(v[6], v[7])}; }
    const float* cre = Q.in(8) + (size_t)l * 16384; const float* cim = Q.in(9) + (size_t)l * 16384;
    for (int i = gt; i < 16 * 512 * 16; i += NGT) { const int n8 = i & 15, row = (i >> 4) & 511, g = i >> 13; const int t = row >> 4, c = row & 15, ri = n8 >> 3, n0 = (n8 & 7) * 8;
        float v[8];
#pragma unroll
        for (int j = 0; j < 8; ++j) { const int n = n0 + j; const float cr = cre[(g * 16 + c) * 64 + n], ci = cim[(g * 16 + c) * 64 + n];
            const float pr = P[SP_APOW + ((g * 64 + n) * 33 + (t + 1)) * 2], pi = P[SP_APOW + ((g * 64 + n) * 33 + (t + 1)) * 2 + 1];
            v[j] = ri == 0 ? (cr * pr - ci * pi) : -(cr * pi + ci * pr); }
        *(u32x4*)(Q.s5mc() + (size_t)i * 8) = (u32x4){pk2(v[0], v[1]), pk2(v[2], v[3]), pk2(v[4], v[5]), pk2(v[6], v[7])}; }
}
DI void ph_s5_scan2(Frame& F, int l, int it_lo, int it_hi, int it_step) {
    const Ptrs Q = get_ptrs(F);
    const float* P = Q.small() + (size_t)l * SSMP_FLOATS;
    LAS float* sg = (LAS float*)F.lds;
    for (int it = it_lo; it < it_hi; it += it_step) { const int g = it >> 1, b = it & 1; const int n = F.tid & 63, seg = F.tid >> 6;
        const float ar = P[SP_APOW + ((g * 64 + n) * 33 + 32) * 2], ai = P[SP_APOW + ((g * 64 + n) * 33 + 32) * 2 + 1];
        const size_t base = ((size_t)g * 1024 + (size_t)b * 512 + (size_t)seg * 64) * 128 + n;
        const float* e = Q.s5eg() + base; bf16* cb = Q.s5cb() + base;
        float pr[64], pi[64];
        float sr = 0.f, si = 0.f;
#pragma unroll
        for (int c0 = 0; c0 < 64; c0 += 16) { float tr[16], ti[16];
#pragma unroll
            for (int c = 0; c < 16; ++c) { tr[c] = e[(size_t)(c0 + c) * 128]; ti[c] = e[(size_t)(c0 + c) * 128 + 64]; }
#pragma unroll
            for (int c = 0; c < 16; ++c) { pr[c0 + c] = sr; pi[c0 + c] = si; const float nr = ar * sr - ai * si + tr[c], ni = ar * si + ai * sr + ti[c]; sr = nr; si = ni; } }
        sg[(seg * 64 + n) * 2] = sr; sg[(seg * 64 + n) * 2 + 1] = si;
        float mr = ar, mi = ai;
#pragma unroll
        for (int k = 0; k < 6; ++k) { const float nr = mr * mr - mi * mi, ni = 2.0f * mr * mi; mr = nr; mi = ni; }
        __syncthreads();
        float cr = 0.f, ci = 0.f;
        for (int s2 = 0; s2 < seg; ++s2) { const float er = sg[(s2 * 64 + n) * 2], ei = sg[(s2 * 64 + n) * 2 + 1]; const float nr = mr * cr - mi * ci + er, ni = mr * ci + mi * cr + ei; cr = nr; ci = ni; }
#pragma unroll
        for (int c = 0; c < 64; ++c) { cb[(size_t)c * 128] = (bf16)f2bf(pr[c] + cr); cb[(size_t)c * 128 + 64] = (bf16)f2bf(pi[c] + ci);
            const float nr = ar * cr - ai * ci, ni = ar * ci + ai * cr; cr = nr; ci = ni; }
        __syncthreads();
    }
}
DI void ph_ret_out(Frame& F) {
    const Ptrs Q = get_ptrs(F);
    LAS float* Ks = (LAS float*)F.lds; LAS float* Vs = Ks + 8192; LAS float* Ps = Vs + 8192;
    for (int it = F.wg; it < BATCH * 128 * NH; it += F.G) {
        const int tid_ = F.wave * 64 + fresh_lane(); const int i = tid_ >> 2, dq = tid_ & 3;
        const int b = it / (128 * NH), c = (it / NH) % 128, h = it % NH;
        const float lg = ret_log2g(h);
        const size_t row0 = (size_t)(b * SEQ + c * 128);
        const bf16* base = Q.PROJ() + row0 * DINP + h * HD;
        load_tile128<1>(F, base + C_KR, Ks, lg); load_tile128<0>(F, base + C_VR, Vs, lg);
        const float* pv = (const float*)Q.retkv() + (size_t)((b * 128 + c) * NH + h) * 4096;
        for (int k = 0; k < 8; ++k) Ps[F.tid + 512 * k] = pv[F.tid + 512 * k];
        float q[64];
        { const bf16* qp = base + (size_t)i * DINP + C_QR;
#pragma unroll
          for (int k = 0; k < 8; ++k) { const u32x4 a = *(const u32x4*)(qp + 8 * k); unpack8(a, q + 8 * k); } }
        __syncthreads();
        float acc[16];
#pragma unroll
        for (int e = 0; e < 16; ++e) acc[e] = 0.f;
        for (int j = 0; j <= i; ++j) {
            float s = 0.f;
#pragma unroll
            for (int d = 0; d < 64; d += 4) { const f32x4 kk = *(const LAS f32x4*)(Ks + j * 64 + d); s += q[d] * kk[0] + q[d + 1] * kk[1] + q[d + 2] * kk[2] + q[d + 3] * kk[3]; }
            s *= exp2f(lg * (float)(i - j));
#pragma unroll
            for (int e = 0; e < 16; e += 4) { const f32x4 vv = *(const LAS f32x4*)(Vs + j * 64 + dq * 16 + e); acc[e] += s * vv[0]; acc[e + 1] += s * vv[1]; acc[e + 2] += s * vv[2]; acc[e + 3] += s * vv[3]; }
        }
        const float xi = exp2f(lg * (float)(i + 1));
#pragma unroll
        for (int dk = 0; dk < 64; ++dk) { const float qd = q[dk] * xi;
#pragma unroll
            for (int e = 0; e < 16; e += 4) { const f32x4 pp = *(const LAS f32x4*)(Ps + dk * 64 + dq * 16 + e); acc[e] += qd * pp[0]; acc[e + 1] += qd * pp[1]; acc[e + 2] += qd * pp[2]; acc[e + 3] += qd * pp[3]; } }
        float s1 = 0.f;
#pragma unroll
        for (int e = 0; e < 16; ++e) s1 += acc[e];
        s1 += dppf<DPP_XOR1>(s1); s1 += dppf<DPP_XOR2>(s1);
        const float mean = s1 * (1.0f / 64.0f); float s2 = 0.f;
#pragma unroll
        for (int e = 0; e < 16; ++e) { acc[e] -= mean; s2 += acc[e] * acc[e]; }
        s2 += dppf<DPP_XOR1>(s2); s2 += dppf<DPP_XOR2>(s2);
        const float rstd = 1.0f / sqrtf(s2 * (1.0f / 64.0f) + GN_EPS);
        const bf16* gp = base + (size_t)i * DINP + C_GR + dq * 16;
        float gv[16]; { const u32x4 a = *(const u32x4*)gp, bb = *(const u32x4*)(gp + 8); unpack8(a, gv); unpack8(bb, gv + 8); }
        float ov[16];
#pragma unroll
        for (int e = 0; e < 16; ++e) { const float g = gv[e]; ov[e] = acc[e] * rstd * (g / (1.0f + expf(-g))); }
        bf16* op = Q.YMIX() + (row0 + i) * DM + 384 + h * HD + dq * 16;
        *(u32x4*)op = (u32x4){pk2(ov[0], ov[1]), pk2(ov[2], ov[3]), pk2(ov[4], ov[5]), pk2(ov[6], ov[7])};
        *(u32x4*)(op + 8) = (u32x4){pk2(ov[8], ov[9]), pk2(ov[10], ov[11]), pk2(ov[12], ov[13]), pk2(ov[14], ov[15])};
        __syncthreads();
    }
}
DI void s5_load_u(const bf16* up, float* u) { const u32x4 a = *(const u32x4*)up, b = *(const u32x4*)(up + 8); unpack8(a, u); unpack8(b, u + 8); }
DI void ph_s5_local(Frame& F, int l) {
    const Ptrs Q = get_ptrs(F);
    const float* P = Q.small() + (size_t)l * SSMP_FLOATS;
    for (int it = F.wg * NWAVES + F.wave; it < BATCH * 16 * 128; it += F.G * NWAVES) {
        const int ch = it & 127, g = (it >> 7) & 15, b = it >> 11; const int n = F.lane;
        const float ar = P[(g * 64 + n) * 2], ai = P[(g * 64 + n) * 2 + 1];
        float bbr[16], bbi[16];
#pragma unroll
        for (int c = 0; c < 16; ++c) { bbr[c] = P[4096 + ((g * 64 + n) * 16 + c) * 2]; bbi[c] = P[4096 + ((g * 64 + n) * 16 + c) * 2 + 1]; }
        float hr = 0.f, hi = 0.f;
        const bf16* up = Q.PROJ() + (size_t)(b * SEQ + ch * 128) * DINP + C_US + g * 16;
        for (int s = 0; s < 128; ++s) { float u[16]; s5_load_u(up + (size_t)s * DINP, u); float xr = 0.f, xi = 0.f;
#pragma unroll
            for (int c = 0; c < 16; ++c) { xr += bbr[c] * u[c]; xi += bbi[c] * u[c]; }
            const float nr = ar * hr - ai * hi + xr, ni = ar * hi + ai * hr + xi; hr = nr; hi = ni; }
        float* e = Q.s5e() + ((size_t)((b * 16 + g) * 128 + ch) * 64 + n) * 2; e[0] = hr; e[1] = hi;
    }
}
DI float gelu_tanh(float v) { const float z = 0.7978845608028654f * (v + 0.044715f * v * v * v); const float t = 1.0f - 2.0f / (expf(2.0f * z) + 1.0f); return 0.5f * v * (1.0f + t); }
DI void ph_s5_out(Frame& F, int l) {
    const Ptrs Q = get_ptrs(F);
    const float* P = Q.small() + (size_t)l * SSMP_FLOATS;
    LAS float* Cre = (LAS float*)F.lds; LAS float* Cim = Cre + 16 * 65;
    LAS float* hre = Cim + 16 * 65 + F.wave * (2 * 16 * 65); LAS float* him = hre + 16 * 65;
    const float* cre_g = Q.in(8) + (size_t)l * 16384; const float* cim_g = Q.in(9) + (size_t)l * 16384; const float* dsk = Q.in(10) + (size_t)l * 256;
    for (int it = F.wg; it < BATCH * 16 * 16; it += F.G) {
        const int cgp = it & 15, g = (it >> 4) & 15, b = it >> 8; const int ch = cgp * 8 + F.wave; const int n = F.lane;
        for (int idx = F.tid; idx < 1024; idx += NTHR) { const int c = idx >> 6, nn = idx & 63; Cre[c * 65 + nn] = cre_g[(g * 16 + c) * 64 + nn]; Cim[c * 65 + nn] = cim_g[(g * 16 + c) * 64 + nn]; }
        __syncthreads();
        const float ar = P[(g * 64 + n) * 2], ai = P[(g * 64 + n) * 2 + 1];
        float bbr[16], bbi[16];
#pragma unroll
        for (int c = 0; c < 16; ++c) { bbr[c] = P[4096 + ((g * 64 + n) * 16 + c) * 2]; bbi[c] = P[4096 + ((g * 64 + n) * 16 + c) * 2 + 1]; }
        const float* e = Q.s5e() + ((size_t)((b * 16 + g) * 128 + ch) * 64 + n) * 2;
        float hr = e[0], hi = e[1];
        const size_t row0 = (size_t)(b * SEQ + ch * 128);
        const bf16* up = Q.PROJ() + row0 * DINP + C_US + g * 16;
        const int tl = F.lane >> 2, cq = F.lane & 3;
        for (int blk = 0; blk < 8; ++blk) {
            for (int s = 0; s < 16; ++s) { float u[16]; s5_load_u(up + (size_t)(blk * 16 + s) * DINP, u); float xr = 0.f, xi = 0.f;
#pragma unroll
                for (int c = 0; c < 16; ++c) { xr += bbr[c] * u[c]; xi += bbi[c] * u[c]; }
                const float nr = ar * hr - ai * hi + xr, ni = ar * hi + ai * hr + xi; hr = nr; hi = ni;
                hre[s * 65 + n] = hr; him[s * 65 + n] = hi; }
            __builtin_amdgcn_wave_barrier();
            float y[4] = {0.f, 0.f, 0.f, 0.f};
            for (int n2 = 0; n2 < 64; ++n2) { const float a = hre[tl * 65 + n2], bq = him[tl * 65 + n2];
#pragma unroll
                for (int k = 0; k < 4; ++k) y[k] += a * Cre[(4 * cq + k) * 65 + n2] - bq * Cim[(4 * cq + k) * 65 + n2]; }
            __builtin_amdgcn_wave_barrier();
            const size_t t = row0 + blk * 16 + tl;
            const u32x2 uu = *(const u32x2*)(Q.PROJ() + t * DINP + C_US + g * 16 + 4 * cq);
            const float u0 = __uint_as_float(uu.x << 16), u1 = __uint_as_float(uu.x & 0xffff0000u), u2 = __uint_as_float(uu.y << 16), u3 = __uint_as_float(uu.y & 0xffff0000u);
            f32x4 o; o[0] = gelu_tanh(y[0] + dsk[g * 16 + 4 * cq] * u0); o[1] = gelu_tanh(y[1] + dsk[g * 16 + 4 * cq + 1] * u1);
            o[2] = gelu_tanh(y[2] + dsk[g * 16 + 4 * cq + 2] * u2); o[3] = gelu_tanh(y[3] + dsk[g * 16 + 4 * cq + 3] * u3);
            *(f32x4*)(Q.yg() + t * 256 + g * 16 + 4 * cq) = o;
        }
        __syncthreads();
    }
}
DI void ph_s5_glu(Frame& F, int l) {
    const Ptrs Q = get_ptrs(F);
    LAS float* ys = (LAS float*)F.lds;
    const float* W = Q.in(11) + (size_t)l * 65536; const float* bg = Q.in(12) + (size_t)l * 256;
    const int j = F.tid & 255, half = F.tid >> 8;
    for (int it = F.wg; it < TOK / 64; it += F.G) {
        const float* src = Q.yg() + (size_t)it * 64 * 256;
        for (int k = 0; k < 8; ++k) { const int idx = (F.tid + 512 * k) * 4; *(LAS f32x4*)(ys + idx) = *(const f32x4*)(src + idx); }
        __syncthreads();
        float acc[32];
        const float b0 = bg[j];
#pragma unroll
        for (int tk = 0; tk < 32; ++tk) acc[tk] = b0;
        for (int i = 0; i < 256; i += 4) { const float w0 = W[(i) * 256 + j], w1 = W[(i + 1) * 256 + j], w2 = W[(i + 2) * 256 + j], w3 = W[(i + 3) * 256 + j];
#pragma unroll
            for (int tk = 0; tk < 32; ++tk) { const f32x4 yv = *(const LAS f32x4*)(ys + (half * 32 + tk) * 256 + i); acc[tk] += yv[0] * w0 + yv[1] * w1 + yv[2] * w2 + yv[3] * w3; } }
#pragma unroll
        for (int tk = 0; tk < 32; ++tk) { const float yv = ys[(half * 32 + tk) * 256 + j]; const float o = yv / (1.0f + expf(-acc[tk]));
            Q.YMIX()[((size_t)it * 64 + half * 32 + tk) * DM + 768 + j] = (bf16)f2bf(o); }
        __syncthreads();
    }
}
DI void ph_moba_simple(Frame& F) {
    const Ptrs Q = get_ptrs(F);
    LAS float* km = (LAS float*)F.lds;
    for (int it = F.wg; it < BATCH * NH * 32; it += F.G) {
        const int qc = it & 31, h = (it >> 5) % NH, b = it / (NH * 32);
        const float* kmg = Q.kmean() + (size_t)(b * NH + h) * 4096;
        for (int k = 0; k < 8; ++k) km[F.tid + 512 * k] = kmg[F.tid + 512 * k];
        __syncthreads();
        const int t = qc * 512 + F.tid; const int own = t >> 8; const size_t row = (size_t)b * SEQ + t;
        float q[64];
        { const bf16* qp = Q.PROJ() + row * DINP + C_QA + h * HD;
#pragma unroll
          for (int k = 0; k < 8; ++k) { const u32x4 a = *(const u32x4*)(qp + 8 * k); unpack8(a, q + 8 * k); } }
        float v0 = -INFINITY, v1 = -INFINITY, v2 = -INFINITY; int i0 = 0, i1 = 0, i2 = 0;
        for (int n = 0; n < own; ++n) { float g = 0.f;
#pragma unroll
            for (int d = 0; d < 64; d += 4) { const f32x4 kk = *(const LAS f32x4*)(km + n * 64 + d); g += q[d] * kk[0] + q[d + 1] * kk[1] + q[d + 2] * kk[2] + q[d + 3] * kk[3]; }
            if (g > v0) { v2 = v1; i2 = i1; v1 = v0; i1 = i0; v0 = g; i0 = n; } else if (g > v1) { v2 = v1; i2 = i1; v1 = g; i1 = n; } else if (g > v2) { v2 = g; i2 = n; } }
        const int nsel = own < 3 ? own : 3;
        const float slope = alibi_slope(h);
        float m = -INFINITY, lsum = 0.f; float o[64];
#pragma unroll
        for (int d = 0; d < 64; ++d) o[d] = 0.f;
        for (int p = 0; p < 4; ++p) {
            if (p < 3 && p >= nsel) continue;
            const int blk = p == 0 ? i0 : p == 1 ? i1 : p == 2 ? i2 : own;
            const int kend = p == 3 ? (t & 255) : 255;
            const bf16* kp = Q.PROJ() + ((size_t)b * SEQ + (size_t)blk * 256) * DINP + h * HD;
            for (int s = 0; s <= kend; ++s) {
                float kv[64];
#pragma unroll
                for (int k = 0; k < 8; ++k) { const u32x4 a = *(const u32x4*)(kp + (size_t)s * DINP + C_KA + 8 * k); unpack8(a, kv + 8 * k); }
                float dot = 0.f;
#pragma unroll
                for (int d = 0; d < 64; ++d) dot += q[d] * kv[d];
                const float sc = dot * 0.125f - slope * (float)(t - (blk * 256 + s));
                if (sc > m) { const float corr = expf(m - sc); lsum *= corr;
#pragma unroll
                    for (int d = 0; d < 64; ++d) o[d] *= corr;
                    m = sc; }
                const float pw = expf(sc - m); lsum += pw;
#pragma unroll
                for (int k = 0; k < 8; ++k) { const u32x4 a = *(const u32x4*)(kp + (size_t)s * DINP + C_VA + 8 * k); unpack8(a, kv + 8 * k); }
#pragma unroll
                for (int d = 0; d < 64; ++d) o[d] += pw * kv[d];
            }
        }
        const float inv = 1.0f / lsum;
        bf16* op = Q.YMIX() + row * DM + h * HD;
#pragma unroll
        for (int k = 0; k < 8; ++k) *(u32x4*)(op + 8 * k) = (u32x4){pk2(o[8 * k] * inv, o[8 * k + 1] * inv), pk2(o[8 * k + 2] * inv, o[8 * k + 3] * inv), pk2(o[8 * k + 4] * inv, o[8 * k + 5] * inv), pk2(o[8 * k + 6] * inv, o[8 * k + 7] * inv)};
        __syncthreads();
    }
}

typedef float f32x16 __attribute__((ext_vector_type(16)));
typedef short s16x4 __attribute__((ext_vector_type(4)));
DI int crow16(int r, int hi) { return (r & 3) + 8 * (r >> 2) + 4 * hi; }
DI int mlist_base(int n) { return 256 * (63 * n - (n * (n - 1)) / 2); }
#define TOP3_INS(G, N, V0, V1, V2, I0, I1, I2) do { const float g_ = (G); const int n_ = (N); \
    if (g_ > V0) { V2 = V1; I2 = I1; V1 = V0; I1 = I0; V0 = g_; I0 = n_; } else if (g_ > V1) { V2 = V1; I2 = I1; V1 = g_; I1 = n_; } else if (g_ > V2) { V2 = g_; I2 = n_; } } while (0)
DI void ph_moba_gate(Frame& F, int l, int it_lo, int it_hi, int it_step) {
    const Ptrs Q = get_ptrs(F);
    LAS float* km = (LAS float*)F.lds;
    unsigned* mcnt = Q.ctl() + CW_MCNT + 1024 * l;
    for (int it = it_lo; it < it_hi; it += it_step) {
        const int qc = it & 31, h = (it >> 5) % NH, b = it / (NH * 32);
        const float* kmg = Q.kmean() + (size_t)(b * NH + h) * 4096;
        for (int k = 0; k < 8; ++k) { const int idx = F.tid + 512 * k; km[(idx >> 6) * 68 + (idx & 63)] = kmg[idx]; }
        const int lane = F.lane, ql = lane & 31, hi = lane >> 5;
        const int t = qc * 512 + F.tid; const int own = __builtin_amdgcn_readfirstlane(t >> 8);
        bf16x8 qf[2][4];
#pragma unroll
        for (int qt = 0; qt < 2; ++qt) { const bf16* qp = Q.PROJ() + ((size_t)b * SEQ + qc * 512 + F.wave * 64 + 32 * qt + ql) * DINP + C_QA + h * HD + 8 * hi;
#pragma unroll
            for (int ks = 0; ks < 4; ++ks) qf[qt][ks] = *(const bf16x8*)(qp + 16 * ks); }
        __syncthreads();
        f32x16 acc[2][2];
#pragma unroll
        for (int nt = 0; nt < 2; ++nt)
#pragma unroll
            for (int qt = 0; qt < 2; ++qt)
#pragma unroll
                for (int r = 0; r < 16; ++r) acc[nt][qt][r] = 0.f;
#pragma unroll
        for (int nt = 0; nt < 2; ++nt) { if (32 * nt < own) {
#pragma unroll
            for (int ks = 0; ks < 4; ++ks) { const LAS float* kp = km + (32 * nt + ql) * 68 + 16 * ks + 8 * hi; const f32x4 a = *(const LAS f32x4*)kp, c = *(const LAS f32x4*)(kp + 4);
                const unsigned h0 = pk2(a[0], a[1]), h1 = pk2(a[2], a[3]), h2 = pk2(c[0], c[1]), h3 = pk2(c[2], c[3]);
                const unsigned l0 = pk2(a[0] - __uint_as_float(h0 << 16), a[1] - __uint_as_float(h0 & 0xffff0000u)), l1 = pk2(a[2] - __uint_as_float(h1 << 16), a[3] - __uint_as_float(h1 & 0xffff0000u));
                const unsigned l2 = pk2(c[0] - __uint_as_float(h2 << 16), c[1] - __uint_as_float(h2 & 0xffff0000u)), l3 = pk2(c[2] - __uint_as_float(h3 << 16), c[3] - __uint_as_float(h3 & 0xffff0000u));
                const bf16x8 khi = __builtin_bit_cast(bf16x8, (u32x4){h0, h1, h2, h3}), klo = __builtin_bit_cast(bf16x8, (u32x4){l0, l1, l2, l3});
#pragma unroll
                for (int qt = 0; qt < 2; ++qt) { acc[nt][qt] = __builtin_amdgcn_mfma_f32_32x32x16_bf16(khi, qf[qt][ks], acc[nt][qt], 0, 0, 0); acc[nt][qt] = __builtin_amdgcn_mfma_f32_32x32x16_bf16(klo, qf[qt][ks], acc[nt][qt], 0, 0, 0); } } } }
        float tv[2][3]; int ti[2][3];
#pragma unroll
        for (int qt = 0; qt < 2; ++qt) { float v0 = -INFINITY, v1 = -INFINITY, v2 = -INFINITY; int i0 = 0, i1 = 0, i2 = 0;
#pragma unroll
            for (int nt = 0; nt < 2; ++nt)
#pragma unroll
                for (int r = 0; r < 16; ++r) { const int n = 32 * nt + crow16(r, 0) + 4 * hi; const float g = n < own ? acc[nt][qt][r] : -INFINITY; TOP3_INS(g, n, v0, v1, v2, i0, i1, i2); }
            tv[qt][0] = v0; tv[qt][1] = v1; tv[qt][2] = v2; ti[qt][0] = i0; ti[qt][1] = i1; ti[qt][2] = i2; }
        float v0, v1, v2; int i0, i1, i2;
        v0 = hi ? tv[1][0] : tv[0][0]; v1 = hi ? tv[1][1] : tv[0][1]; v2 = hi ? tv[1][2] : tv[0][2]; i0 = hi ? ti[1][0] : ti[0][0]; i1 = hi ? ti[1][1] : ti[0][1]; i2 = hi ? ti[1][2] : ti[0][2];
#pragma unroll
        for (int k = 0; k < 3; ++k) { const auto rv = __builtin_amdgcn_permlane32_swap(__float_as_uint(tv[0][k]), __float_as_uint(tv[1][k]), false, false); const auto ri = __builtin_amdgcn_permlane32_swap((unsigned)ti[0][k], (unsigned)ti[1][k], false, false);
            const float pg = __uint_as_float(hi ? rv[0] : rv[1]); const int pn = (int)(hi ? ri[0] : ri[1]);
            TOP3_INS(pg, pn, v0, v1, v2, i0, i1, i2); }
        const int nsel = own < 3 ? own : 3;
        unsigned short* lst = Q.mlist() + (size_t)(b * NH + h) * MLIST_PER_BH;
        unsigned* cn = mcnt + (b * NH + h) * 64;
        LAS unsigned* lc = (LAS unsigned*)(F.lds + 20480); LAS unsigned* lb = lc + 64;
        if (F.tid < 64) lc[F.tid] = 0u;
        __syncthreads();
        unsigned rk[3];
#pragma unroll
        for (int j = 0; j < 3; ++j) { rk[j] = 0u; if (j < nsel) { const int n = j == 0 ? i0 : j == 1 ? i1 : i2; rk[j] = __hip_atomic_fetch_add(&lc[n], 1u, __ATOMIC_RELAXED, __HIP_MEMORY_SCOPE_WORKGROUP); } }
        __syncthreads();
        if (F.tid < 64) { const unsigned c = lc[F.tid]; lb[F.tid] = c ? atomicAdd(&cn[F.tid], c) : 0u; }
        __syncthreads();
#pragma unroll
        for (int j = 0; j < 3; ++j) { if (j < nsel) { const int n = j == 0 ? i0 : j == 1 ? i1 : i2; lst[mlist_base(n) + lb[n] + rk[j]] = (unsigned short)(t | (j << 14)); } }
        __syncthreads();
    }
}
DI void ph_moba_gate2(Frame& F, int l, int itA, int itB) {
    const Ptrs Q = get_ptrs(F);
    LAS float* km = (LAS float*)F.lds;
    unsigned* mcnt = Q.ctl() + CW_MCNT + 1024 * l;
    const int h = (itA >> 5) % NH, b = itA / (NH * 32);
    const float* kmg = Q.kmean() + (size_t)(b * NH + h) * 4096;
#pragma unroll
    for (int k = 0; k < 8; ++k) { const int idx = F.tid + 512 * k; km[(idx >> 6) * 68 + (idx & 63)] = kmg[idx]; }
    LAS unsigned* lc = (LAS unsigned*)(F.lds + 20480); LAS unsigned* lb = lc + 64;
    if (F.tid < 64) lc[F.tid] = 0u;
    __syncthreads();
    const int lane = F.lane, ql = lane & 31, hi = lane >> 5;
    int sel[2][3], tq[2], ns[2];
#pragma unroll
    for (int u = 0; u < 2; ++u) {
        const int qc = (u ? itB : itA) & 31;
        const int t = qc * 512 + F.tid; const int own = __builtin_amdgcn_readfirstlane(t >> 8);
        bf16x8 qf[2][4];
#pragma unroll
        for (int qt = 0; qt < 2; ++qt) { const bf16* qp = Q.PROJ() + ((size_t)b * SEQ + qc * 512 + F.wave * 64 + 32 * qt + ql) * DINP + C_QA + h * HD + 8 * hi;
#pragma unroll
            for (int ks = 0; ks < 4; ++ks) qf[qt][ks] = *(const bf16x8*)(qp + 16 * ks); }
        f32x16 acc[2][2];
#pragma unroll
        for (int nt = 0; nt < 2; ++nt)
#pragma unroll
            for (int qt = 0; qt < 2; ++qt)
#pragma unroll
                for (int r = 0; r < 16; ++r) acc[nt][qt][r] = 0.f;
#pragma unroll
        for (int nt = 0; nt < 2; ++nt) { if (32 * nt < own) {
#pragma unroll
            for (int ks = 0; ks < 4; ++ks) { const LAS float* kp = km + (32 * nt + ql) * 68 + 16 * ks + 8 * hi; const f32x4 a = *(const LAS f32x4*)kp, c = *(const LAS f32x4*)(kp + 4);
                const unsigned h0 = pk2(a[0], a[1]), h1 = pk2(a[2], a[3]), h2 = pk2(c[0], c[1]), h3 = pk2(c[2], c[3]);
                const unsigned l0 = pk2(a[0] - __uint_as_float(h0 << 16), a[1] - __uint_as_float(h0 & 0xffff0000u)), l1 = pk2(a[2] - __uint_as_float(h1 << 16), a[3] - __uint_as_float(h1 & 0xffff0000u));
                const unsigned l2 = pk2(c[0] - __uint_as_float(h2 << 16), c[1] - __uint_as_float(h2 & 0xffff0000u)), l3 = pk2(c[2] - __uint_as_float(h3 << 16), c[3] - __uint_as_float(h3 & 0xffff0000u));
                const bf16x8 khi = __builtin_bit_cast(bf16x8, (u32x4){h0, h1, h2, h3}), klo = __builtin_bit_cast(bf16x8, (u32x4){l0, l1, l2, l3});
#pragma unroll
                for (int qt = 0; qt < 2; ++qt) { acc[nt][qt] = __builtin_amdgcn_mfma_f32_32x32x16_bf16(khi, qf[qt][ks], acc[nt][qt], 0, 0, 0); acc[nt][qt] = __builtin_amdgcn_mfma_f32_32x32x16_bf16(klo, qf[qt][ks], acc[nt][qt], 0, 0, 0); } } } }
        float tv[2][3]; int ti[2][3];
#pragma unroll
        for (int qt = 0; qt < 2; ++qt) { float v0 = -INFINITY, v1 = -INFINITY, v2 = -INFINITY; int i0 = 0, i1 = 0, i2 = 0;
#pragma unroll
            for (int nt = 0; nt < 2; ++nt)
#pragma unroll
                for (int r = 0; r < 16; ++r) { const int n = 32 * nt + crow16(r, 0) + 4 * hi; const float g = n < own ? acc[nt][qt][r] : -INFINITY; TOP3_INS(g, n, v0, v1, v2, i0, i1, i2); }
            tv[qt][0] = v0; tv[qt][1] = v1; tv[qt][2] = v2; ti[qt][0] = i0; ti[qt][1] = i1; ti[qt][2] = i2; }
        float v0, v1, v2; int i0, i1, i2;
        v0 = hi ? tv[1][0] : tv[0][0]; v1 = hi ? tv[1][1] : tv[0][1]; v2 = hi ? tv[1][2] : tv[0][2]; i0 = hi ? ti[1][0] : ti[0][0]; i1 = hi ? ti[1][1] : ti[0][1]; i2 = hi ? ti[1][2] : ti[0][2];
#pragma unroll
        for (int k = 0; k < 3; ++k) { const auto rv = __builtin_amdgcn_permlane32_swap(__float_as_uint(tv[0][k]), __float_as_uint(tv[1][k]), false, false); const auto ri = __builtin_amdgcn_permlane32_swap((unsigned)ti[0][k], (unsigned)ti[1][k], false, false);
            const float pg = __uint_as_float(hi ? rv[0] : rv[1]); const int pn = (int)(hi ? ri[0] : ri[1]);
            TOP3_INS(pg, pn, v0, v1, v2, i0, i1, i2); }
        sel[u][0] = i0; sel[u][1] = i1; sel[u][2] = i2; tq[u] = t; ns[u] = own < 3 ? own : 3;
    }
    unsigned short* lst = Q.mlist() + (size_t)(b * NH + h) * MLIST_PER_BH;
    unsigned* cn = mcnt + (b * NH + h) * 64;
    unsigned rk[2][3];
#pragma unroll
    for (int u = 0; u < 2; ++u)
#pragma unroll
        for (int j = 0; j < 3; ++j) { rk[u][j] = 0u; if (j < ns[u]) rk[u][j] = __hip_atomic_fetch_add(&lc[sel[u][j]], 1u, __ATOMIC_RELAXED, __HIP_MEMORY_SCOPE_WORKGROUP); }
    __syncthreads();
    if (F.tid < 64) { const unsigned c = lc[F.tid]; lb[F.tid] = c ? atomicAdd(&cn[F.tid], c) : 0u; }
    __syncthreads();
#pragma unroll
    for (int u = 0; u < 2; ++u)
#pragma unroll
        for (int j = 0; j < 3; ++j) { if (j < ns[u]) { const int n = sel[u][j]; lst[mlist_base(n) + lb[n] + rk[u][j]] = (unsigned short)(tq[u] | (j << 14)); } }
    __syncthreads();
}
DI void ph_moba_attn(Frame& F, int l) {
    const Ptrs Q0 = get_ptrs(F);
    LAS unsigned char* Ks = F.lds; LAS unsigned char* Vs = F.lds + 32768; LAS unsigned char* Os = F.lds + 65536 + F.wave * 4096;
    LAS int* pre = (LAS int*)(F.lds + 65536 + 32768);
    const unsigned* mcnt0 = Q0.ctl() + CW_MCNT + 1024 * l;
    { int a0 = 0, a1 = 0;
      if (F.tid < 384) { const unsigned c0 = __hip_atomic_load(mcnt0 + 2 * F.tid, __ATOMIC_RELAXED, __HIP_MEMORY_SCOPE_AGENT), c1 = __hip_atomic_load(mcnt0 + 2 * F.tid + 1, __ATOMIC_RELAXED, __HIP_MEMORY_SCOPE_AGENT);
          a0 = 1 + (int)((c0 + 255u) >> 8); a1 = 1 + (int)((c1 + 255u) >> 8); pre[1024 + 2 * F.tid] = (int)c0; pre[1025 + 2 * F.tid] = (int)c1; }
      int sc = a0 + a1;
#pragma unroll
      for (int o = 1; o < 64; o <<= 1) { const int v = __builtin_amdgcn_ds_bpermute((F.lane - o) << 2, sc); if (F.lane >= o) sc += v; }
      if (F.lane == 63) pre[800 + F.wave] = sc;
      __syncthreads();
      int wb = 0;
      for (int w = 0; w < 8; ++w) { const int v = pre[800 + w]; if (w < F.wave) wb += v; }
      const int incl = wb + sc;
      if (F.tid < 384) { pre[2 * F.tid + 1] = incl - a1; pre[2 * F.tid + 2] = incl; }
      if (F.tid == 0) pre[0] = 0;
      __syncthreads(); }
    const int nitems = __builtin_amdgcn_readfirstlane(pre[768]);
    const float C2 = 0.125f * 1.4426950408889634f;
    constexpr int MOBA_W = 5;
    int it_lo, it_hi;
    if (F.G == 256) {
        const int v = (F.wg & 7) * 32 + (F.wg >> 3); const int tn = nitems + 128 * MOBA_W;
        const int s0 = 16 * (v >> 5) + ((v & 31) > 16 ? (v & 31) - 16 : 0), s1 = 16 * ((v + 1) >> 5) + (((v + 1) & 31) > 16 ? ((v + 1) & 31) - 16 : 0);
        it_lo = (v * tn) / 256 - MOBA_W * s0; it_hi = ((v + 1) * tn) / 256 - MOBA_W * s1; }
    else { it_lo = (int)(((long)F.wg * nitems) / F.G); it_hi = (int)(((long)(F.wg + 1) * nitems) / F.G); }
    if (it_lo < it_hi) {
#define MC_ADV(E, C, NC, CN) do { if ((C) + 1 < (NC)) { (C) = (C) + 1; } else { (E) = (E) + 1; (C) = 0; (NC) = __builtin_amdgcn_readfirstlane(pre[(E) + 1] - pre[(E)]); (CN) = __builtin_amdgcn_readfirstlane(pre[1024 + (E)]); } } while (0)
#define MC_ENTRY(E, C, CN, LQ) ((C) == 0 ? 0u : ((((C) - 1) * 256 + (LQ)) < (CN) ? (0x10000u | (unsigned)Q0.mlist()[(size_t)((E) >> 6) * MLIST_PER_BH + mlist_base((E) & 63) + ((C) - 1) * 256 + (LQ)]) : 0u))
#define MC_TJ(E, C, RAW, LQ) ((C) == 0 ? ((((E) & 63) * 256 + (LQ)) * 4 + 3) : (((RAW) & 0x10000u) ? (int)((((RAW) & 0x3fffu) << 2) | (((RAW) >> 14) & 3u)) : -1))
    int ent, chunk, nchk, cnt;
    { int lo = 0, hiE = 768;
      while (hiE - lo > 1) { const int mid = (lo + hiE) >> 1; if (pre[mid] <= it_lo) lo = mid; else hiE = mid; }
      ent = __builtin_amdgcn_readfirstlane(lo); chunk = it_lo - __builtin_amdgcn_readfirstlane(pre[ent]); nchk = __builtin_amdgcn_readfirstlane(pre[ent + 1] - pre[ent]); cnt = __builtin_amdgcn_readfirstlane(pre[1024 + ent]); }
    int ent1 = ent, chunk1 = chunk, nchk1 = nchk, cnt1 = cnt; MC_ADV(ent1, chunk1, nchk1, cnt1);
    const int wq = F.wave < 4 ? F.wave : 11 - F.wave;
    const int lq0 = wq * 32 + (F.lane & 31);
    int tj_cur = MC_TJ(ent, chunk, MC_ENTRY(ent, chunk, cnt, lq0), lq0);
    unsigned raw_nxt = (it_lo + 1 < it_hi) ? MC_ENTRY(ent1, chunk1, cnt1, lq0) : 0u;
    bf16x8 qf[4];
    { const int bh = ent >> 6; const int t = tj_cur >= 0 ? (tj_cur >> 2) : (ent & 63) * 256;
      const bf16* qp = Q0.PROJ() + ((size_t)(bh / NH) * SEQ + t) * DINP + C_QA + (bh % NH) * HD + 8 * (F.lane >> 5);
#pragma unroll
      for (int ks = 0; ks < 4; ++ks) qf[ks] = *(const bf16x8*)(qp + 16 * ks); }
    int prev_ent = -1;
    for (int it = it_lo; it < it_hi; ++it) {
        const int lane = fresh_lane();
        const int ql = lane & 31, hi = lane >> 5; const int tid = F.wave * 64 + lane;
        const Ptrs Q = get_ptrs(F);
        const int n = ent & 63, bh = ent >> 6, h = bh % NH, b = bh / NH;
        if (ent != prev_ent) { if (prev_ent >= 0) __syncthreads();
          const int r0 = tid >> 3, ch = tid & 7;
          const bf16* kp = Q.PROJ() + ((size_t)b * SEQ + (size_t)n * 256 + r0) * DINP + C_KA + h * HD + ch * 8;
          const bf16* vp = kp + (C_VA - C_KA);
          u32x4 kv[4], vv[4];
#pragma unroll
          for (int c = 0; c < 4; ++c) { kv[c] = *(const u32x4*)(kp + (size_t)64 * c * DINP); vv[c] = *(const u32x4*)(vp + (size_t)64 * c * DINP); }
#pragma unroll
          for (int c = 0; c < 4; ++c) { const int r = r0 + 64 * c; *(LAS u32x4*)(Ks + r * 128 + ((ch ^ (r & 7)) << 4)) = kv[c]; *(LAS u32x4*)(Vs + r * 128 + (ch << 4)) = vv[c]; }
          __syncthreads(); prev_ent = ent; }
        const int e0 = wq * 32 + ql;
        const bool has_next = it + 1 < it_hi;
        const int tj_nxt = has_next ? MC_TJ(ent1, chunk1, raw_nxt, e0) : -1;
        bf16x8 qn[4];
        { const int bh1 = ent1 >> 6; const int t1 = tj_nxt >= 0 ? (tj_nxt >> 2) : (ent1 & 63) * 256;
          const bf16* qp = Q.PROJ() + ((size_t)(bh1 / NH) * SEQ + t1) * DINP + C_QA + (bh1 % NH) * HD + 8 * hi;
          if (has_next) {
#pragma unroll
              for (int ks = 0; ks < 4; ++ks) qn[ks] = *(const bf16x8*)(qp + 16 * ks); }
          else {
#pragma unroll
              for (int ks = 0; ks < 4; ++ks) qn[ks] = qf[ks]; } }
        int ent2 = ent1, chunk2 = chunk1, nchk2 = nchk1, cnt2 = cnt1; MC_ADV(ent2, chunk2, nchk2, cnt2);
        const unsigned raw_nn = (it + 2 < it_hi) ? MC_ENTRY(ent2, chunk2, cnt2, e0) : 0u;
        const bool valid = tj_cur >= 0; const int t = valid ? (tj_cur >> 2) : n * 256; const int js = tj_cur & 3;
        const bool wave_work = __builtin_amdgcn_readfirstlane((int)__any((int)valid)) != 0;
        if (wave_work) {
            const float slope2 = alibi_slope(h) * 1.4426950408889634f;
            f32x16 acc[8];
            const float kst = slope2 * (1.0f / C2); const float zoffs = kst * (float)(n * 256 + 4 * hi - t);
            bf16x8 kfr[2][4];
#define MOBA_LDK(buf, kt_) do { _Pragma("unroll") for (int ks = 0; ks < 4; ++ks) { const int row = 32 * (kt_) + ql; kfr[buf][ks] = *(const LAS bf16x8*)(Ks + row * 128 + ((((2 * ks + hi)) ^ (row & 7)) << 4)); } } while (0)
            MOBA_LDK(0, 0);
            const int ktmax = chunk == 0 ? wq : 7;
#pragma unroll
            for (int kt = 0; kt < 8; ++kt) {
                if (kt < 7) MOBA_LDK((kt + 1) & 1, kt + 1);
                if (kt <= ktmax) {
                const float zk = zoffs + kst * (float)(32 * kt);
#pragma unroll
                for (int r = 0; r < 16; ++r) acc[kt][r] = __builtin_fmaf(kst, (float)(8 * (r >> 2) + (r & 3)), zk);
#pragma unroll
                for (int ks = 0; ks < 4; ++ks) acc[kt] = __builtin_amdgcn_mfma_f32_32x32x16_bf16(kfr[kt & 1][ks], qf[ks], acc[kt], 0, 0, 0);
                } else {
#pragma unroll
                for (int r = 0; r < 16; ++r) acc[kt][r] = -1e30f; }
                __builtin_amdgcn_sched_barrier(0); }
#undef MOBA_LDK
            if (chunk == 0) {
                int e0o = e0 - 4 * hi; asm volatile("" : "+v"(e0o));
#pragma unroll
                for (int kt = 0; kt < 8; ++kt) { const int dq = e0o - 32 * kt;
#pragma unroll
                    for (int r = 0; r < 16; ++r) { if (crow16(r, 0) > dq) acc[kt][r] = -1e30f; } } }
            float mxa[4] = {acc[0][0], acc[0][1], acc[0][2], acc[0][3]};
#pragma unroll
            for (int kt = 0; kt < 8; ++kt)
#pragma unroll
                for (int r = 0; r < 16; ++r) mxa[r & 3] = fmaxf(mxa[r & 3], acc[kt][r]);
            float mx = xor32_max(fmaxf(fmaxf(mxa[0], mxa[1]), fmaxf(mxa[2], mxa[3])));
            const float mz = mx * C2;
            f32x16 o0, o1;
#pragma unroll
            for (int r = 0; r < 16; ++r) { o0[r] = 0.f; o1[r] = 0.f; }
            f32x2 lsv[4] = {{0.f, 0.f}, {0.f, 0.f}, {0.f, 0.f}, {0.f, 0.f}}; const f32x2 c2v = {C2, C2}, nmz = {-mz, -mz};
            const int qrow = (lane & 15) >> 2, pp = lane & 3, g1 = (lane >> 4) & 1;
            const LAS unsigned char* vb = Vs + (4 * hi + qrow) * 128 + (16 * g1 + 4 * pp) * 2;
#pragma unroll
            for (int kt = 0; kt < 8; ++kt) { if (kt <= ktmax) {
                unsigned pk[8];
#pragma unroll
                for (int r = 0; r < 16; r += 2) { const f32x2 e_ = __builtin_elementwise_fma((f32x2){acc[kt][r], acc[kt][r + 1]}, c2v, nmz); const f32x2 p_ = {__builtin_amdgcn_exp2f(e_[0]), __builtin_amdgcn_exp2f(e_[1])}; lsv[(r >> 1) & 3] += p_; pk[r >> 1] = pk2(p_[0], p_[1]); }
#pragma unroll
                for (int s = 0; s < 2; ++s) {
                    const bf16x8 pf = __builtin_bit_cast(bf16x8, (u32x4){pk[4 * s], pk[4 * s + 1], pk[4 * s + 2], pk[4 * s + 3]});
#pragma unroll
                    for (int dt = 0; dt < 2; ++dt) {
                        const LAS unsigned char* va = vb + (32 * kt + 16 * s) * 128 + 64 * dt;
                        const s16x4 lo4 = __builtin_bit_cast(s16x4, __builtin_amdgcn_ds_read_tr16_b64_v4i16((LAS s16x4*)va));
                        const s16x4 hi4 = __builtin_bit_cast(s16x4, __builtin_amdgcn_ds_read_tr16_b64_v4i16((LAS s16x4*)(va + 8 * 128)));
                        const bf16x8 vf = (bf16x8){lo4[0], lo4[1], lo4[2], lo4[3], hi4[0], hi4[1], hi4[2], hi4[3]};
                        if (dt == 0) o0 = __builtin_amdgcn_mfma_f32_32x32x16_bf16(pf, vf, o0, 0, 0, 0); else o1 = __builtin_amdgcn_mfma_f32_32x32x16_bf16(pf, vf, o1, 0, 0, 0);
                    } } }
                __builtin_amdgcn_sched_barrier(0); }
            const f32x2 lst_ = (lsv[0] + lsv[1]) + (lsv[2] + lsv[3]); const float lsum = xor32_sum(lst_[0] + lst_[1]);
#pragma unroll
            for (int r = 0; r < 16; ++r) { const int qq = crow16(r, hi); *(LAS unsigned short*)(Os + qq * 128 + ql * 2) = (unsigned short)pk2(o0[r], 0.f); *(LAS unsigned short*)(Os + qq * 128 + (32 + ql) * 2) = (unsigned short)pk2(o1[r], 0.f); }
            const int tj = valid ? (t * 4 + js) : -1;
            __builtin_amdgcn_wave_barrier();
#pragma unroll
            for (int c = 0; c < 4; ++c) { const int qrow_ = 8 * c + (lane >> 3); const int tjq = __builtin_amdgcn_ds_bpermute(qrow_ << 2, tj);
                if (tjq >= 0) { const size_t pidx = (size_t)bh * SEQ * 4 + tjq; *(u32x4*)(Q.mpo() + pidx * 64 + (lane & 7) * 8) = *(const LAS u32x4*)(Os + qrow_ * 128 + (lane & 7) * 16); } }
            if (valid && hi == 0) { const size_t pidx = (size_t)bh * SEQ * 4 + tj; *(f32x2*)(Q.mml() + pidx * 2) = (f32x2){mz, lsum}; }
        }
        ent = ent1; chunk = chunk1; nchk = nchk1; cnt = cnt1; ent1 = ent2; chunk1 = chunk2; nchk1 = nchk2; cnt1 = cnt2;
        tj_cur = tj_nxt; raw_nxt = raw_nn;
#pragma unroll
        for (int ks = 0; ks < 4; ++ks) qf[ks] = qn[ks];
    }
#undef MC_ADV
#undef MC_ENTRY
#undef MC_TJ
    }
    __syncthreads();
}
DI void ph_moba_combine(Frame& F) {
    const Ptrs Q = get_ptrs(F);
    constexpr int NIT = BATCH * NH * SEQ * 8 / NTHR;
    int wi_lo, wi_hi;
    if (F.G == 256) { if (F.wg < 128) { wi_lo = F.wg * 20; wi_hi = wi_lo + 20; } else { wi_lo = 2560 + (F.wg - 128) * 4; wi_hi = wi_lo + 4; } }
    else { wi_lo = (int)(((long)F.wg * NIT) / F.G); wi_hi = (int)(((long)(F.wg + 1) * NIT) / F.G); }
    for (int wi = wi_lo; wi < wi_hi; wi += 4) {
        f32x2 ml[4][4]; u32x4 ov[4][4]; bool okk[4][4]; bool act[4]; int ii[4];
#pragma unroll
        for (int u = 0; u < 4; ++u) { act[u] = wi + u < wi_hi; const int i = (act[u] ? wi + u : wi) * NTHR + F.tid; ii[u] = i;
            const int sub = i & 7, qh = i >> 3, t = qh & (SEQ - 1); const int own = t >> 8, nsel = own < 3 ? own : 3; const size_t p0 = (size_t)qh * 4;
#pragma unroll
            for (int j = 0; j < 4; ++j) { const bool ok = (j == 3) || (j < nsel); okk[u][j] = ok; ml[u][j] = (f32x2){-INFINITY, 0.f}; ov[u][j] = (u32x4){0u, 0u, 0u, 0u};
                if (ok) { ml[u][j] = *(const f32x2*)(Q.mml() + (p0 + j) * 2); ov[u][j] = *(const u32x4*)(Q.mpo() + (p0 + j) * 64 + sub * 8); } } }
#pragma unroll
        for (int u = 0; u < 4; ++u) { if (!act[u]) continue; const int i = ii[u];
            const int sub = i & 7, qh = i >> 3, t = qh & (SEQ - 1), bh = qh >> 14, h = bh % NH, b = bh / NH;
            float M = -INFINITY;
#pragma unroll
            for (int j = 0; j < 4; ++j) M = fmaxf(M, ml[u][j][0]);
            float o[8], L = 0.f;
#pragma unroll
            for (int k = 0; k < 8; ++k) o[k] = 0.f;
#pragma unroll
            for (int j = 0; j < 4; ++j) { if (okk[u][j]) { const float w = __builtin_amdgcn_exp2f(ml[u][j][0] - M); L += w * ml[u][j][1]; float v[8]; unpack8(ov[u][j], v);
#pragma unroll
                    for (int k = 0; k < 8; ++k) o[k] += w * v[k]; } }
            const float inv = 1.0f / L;
            *(u32x4*)(Q.YMIX() + ((size_t)b * SEQ + t) * DM + h * HD + sub * 8) = (u32x4){pk2(o[0] * inv, o[1] * inv), pk2(o[2] * inv, o[3] * inv), pk2(o[4] * inv, o[5] * inv), pk2(o[6] * inv, o[7] * inv)}; }
    }
}
DI bf16x8 tr_frag(const LAS unsigned char* a, int second_off) {
    const s16x4 lo4 = __builtin_bit_cast(s16x4, __builtin_amdgcn_ds_read_tr16_b64_v4i16((LAS s16x4*)a));
    const s16x4 hi4 = __builtin_bit_cast(s16x4, __builtin_amdgcn_ds_read_tr16_b64_v4i16((LAS s16x4*)(a + second_off)));
    return (bf16x8){lo4[0], lo4[1], lo4[2], lo4[3], hi4[0], hi4[1], hi4[2], hi4[3]};
}
DI void ph_ret_kv2(Frame& F) {
    int it_lo_, it_hi_, it_st_; p1_range(F, it_lo_, it_hi_, it_st_);
    u32x4 pkv[4], pvv[4];
#define RKV_LOAD(IT) do { const Ptrs Q_ = get_ptrs(F); const int tid_ = F.wave * 64 + fresh_lane(); const int item = (IT) * 2 + (tid_ >> 8), b = item / (128 * NH), c = (item / NH) % 128, h = item % NH; const int tl = tid_ & 255, r = tl >> 1, hf = tl & 1; \
        const bf16* kp = Q_.PROJ() + ((size_t)b * SEQ + c * 128 + r) * DINP + C_KR + h * HD + hf * 32; const bf16* vp = kp + (C_VR - C_KR); \
        _Pragma("unroll") for (int ch = 0; ch < 4; ++ch) { pkv[ch] = *(const u32x4*)(kp + 8 * ch); pvv[ch] = *(const u32x4*)(vp + 8 * ch); } } while (0)
    if (it_lo_ < it_hi_) RKV_LOAD(it_lo_);
    for (int it = it_lo_; it < it_hi_; it += it_st_) {
        const Ptrs Q = get_ptrs(F);
        const int lane = fresh_lane(), ql = lane & 31, hi = lane >> 5; const int tid = F.wave * 64 + lane;
        const int half = F.wave >> 2, w4 = F.wave & 3;
        { const int item = it * 2 + (tid >> 8), h = item % NH;
          const int tl = tid & 255, r = tl >> 1, hf = tl & 1;
          LAS unsigned char* Kp = F.lds + (tid >> 8) * 32768; LAS unsigned char* Vp = Kp + 16384;
          const float sc = 0.125f * exp2f(ret_log2g(h) * (float)(127 - r));
#pragma unroll
          for (int ch = 0; ch < 4; ++ch) { const u32x4 kv = pkv[ch], vv = pvv[ch]; float f[8]; unpack8(kv, f);
              *(LAS u32x4*)(Kp + r * 128 + (hf * 4 + ch) * 16) = (u32x4){pk2(f[0] * sc, f[1] * sc), pk2(f[2] * sc, f[3] * sc), pk2(f[4] * sc, f[5] * sc), pk2(f[6] * sc, f[7] * sc)};
              *(LAS u32x4*)(Vp + r * 128 + (hf * 4 + ch) * 16) = vv; } }
        __syncthreads();
        if (it + it_st_ < it_hi_) RKV_LOAD(it + it_st_);
        { const int item = it * 2 + half, b = item / (128 * NH), c = (item / NH) % 128, h = item % NH;
          const int dvt = w4 >> 1, dkt = w4 & 1;
          const LAS unsigned char* Kp = F.lds + half * 32768; const LAS unsigned char* Vp = Kp + 16384;
          const int qrow = (lane & 15) >> 2, pp = lane & 3, g1 = (lane >> 4) & 1;
          const int aoff = (8 * hi + qrow) * 128 + (16 * g1 + 4 * pp) * 2;
          f32x16 acc;
#pragma unroll
          for (int r = 0; r < 16; ++r) acc[r] = 0.f;
#pragma unroll
          for (int s = 0; s < 8; ++s) { const bf16x8 va = tr_frag(Vp + aoff + s * 16 * 128 + dvt * 64, 4 * 128), kb = tr_frag(Kp + aoff + s * 16 * 128 + dkt * 64, 4 * 128);
              acc = __builtin_amdgcn_mfma_f32_32x32x16_bf16(va, kb, acc, 0, 0, 0); }
          bf16* o = Q.retkv() + (size_t)((b * 128 + c) * NH + h) * 4096 + (32 * dvt) * 64 + 32 * dkt + ql;
#pragma unroll
          for (int r = 0; r < 16; ++r) o[crow16(r, hi) * 64] = (bf16)pk2(acc[r], 0.f); }
        __syncthreads();
    }
#undef RKV_LOAD
}
DI void ph_ret_out2(Frame& F) {
    u32x4 pkv[4], pvv[4];
#define ROUT_LOAD(IT) do { const Ptrs Q_ = get_ptrs(F); const int tid_ = F.wave * 64 + fresh_lane(); const int item = (IT) * 2 + (tid_ >> 8), b = item / (128 * NH), c = (item / NH) % 128, h = item % NH; const int tl = tid_ & 255, r = tl >> 1, hf = tl & 1; \
        const bf16* kp = Q_.PROJ() + ((size_t)b * SEQ + c * 128 + r) * DINP + C_KR + h * HD + hf * 32; const bf16* vp = kp + (C_VR - C_KR); \
        _Pragma("unroll") for (int ch = 0; ch < 4; ++ch) { pkv[ch] = *(const u32x4*)(kp + 8 * ch); pvv[ch] = *(const u32x4*)(vp + 8 * ch); } } while (0)
    if (F.wg < BATCH * 128 * NH / 2) ROUT_LOAD(F.wg);
    for (int it = F.wg; it < BATCH * 128 * NH / 2; it += F.G) {
        const Ptrs Q = get_ptrs(F);
        const int lane = fresh_lane(), ql = lane & 31, hi = lane >> 5; const int tid = F.wave * 64 + lane;
        const int half = F.wave >> 2, qt = half ? 3 - (F.wave & 3) : (F.wave & 3);
        bf16x8 qf[4]; bf16x8 pfr[4][2]; u32x4 gv4[4];
        { const int item = it * 2 + half, b = item / (128 * NH), c = (item / NH) % 128, h = item % NH;
          { const bf16* gp0 = Q.PROJ() + ((size_t)b * SEQ + c * 128 + 32 * qt + (lane >> 1)) * DINP + C_GR + h * HD + (lane & 1) * 32;
#pragma unroll
            for (int k = 0; k < 4; ++k) gv4[k] = *(const u32x4*)(gp0 + 8 * k); }
          const bf16* qp = Q.PROJ() + ((size_t)b * SEQ + c * 128 + 32 * qt + ql) * DINP + C_QR + h * HD + 8 * hi;
#pragma unroll
          for (int ks = 0; ks < 4; ++ks) qf[ks] = *(const bf16x8*)(qp + 16 * ks);
          const bf16* pT = Q.retkv() + (size_t)((b * 128 + c) * NH + h) * 4096 + (size_t)ql * 64 + 8 * hi;
#pragma unroll
          for (int ks = 0; ks < 4; ++ks)
#pragma unroll
              for (int dt = 0; dt < 2; ++dt) pfr[ks][dt] = *(const bf16x8*)(pT + dt * 32 * 64 + 16 * ks); }
        { const int tl = tid & 255, r = tl >> 1, hf = tl & 1;
          LAS unsigned char* Kp = F.lds + (tid >> 8) * 32768; LAS unsigned char* Vp = Kp + 16384;
#pragma unroll
          for (int ch = 0; ch < 4; ++ch) { const u32x4 kv = pkv[ch], vv = pvv[ch];
              *(LAS u32x4*)(Kp + r * 128 + (((hf * 4 + ch) ^ (r & 7)) << 4)) = kv;
              *(LAS u32x4*)(Vp + r * 128 + (hf * 4 + ch) * 16) = vv; } }
        __syncthreads();
        if (it + F.G < BATCH * 128 * NH / 2) ROUT_LOAD(it + F.G);
        { const int item = it * 2 + half, b = item / (128 * NH), c = (item / NH) % 128, h = item % NH;
          const float lg = ret_log2g(h);
          const LAS unsigned char* Kp = F.lds + half * 32768; const LAS unsigned char* Vp = Kp + 16384;
          LAS unsigned char* Os = F.lds + 65536 + F.wave * 8192;
          const size_t row0 = (size_t)b * SEQ + c * 128;
          const int i = 32 * qt + ql;
          f32x16 o0, o1, c0, c1;
#pragma unroll
          for (int r = 0; r < 16; ++r) { o0[r] = 0.f; o1[r] = 0.f; c0[r] = 0.f; c1[r] = 0.f; }
          {
#pragma unroll
            for (int ks = 0; ks < 4; ++ks) {
#pragma unroll
                for (int dt = 0; dt < 2; ++dt) { const bf16x8 bfr = pfr[ks][dt];
                    if (dt == 0) c0 = __builtin_amdgcn_mfma_f32_32x32x16_bf16(qf[ks], bfr, c0, 0, 0, 0); else c1 = __builtin_amdgcn_mfma_f32_32x32x16_bf16(qf[ks], bfr, c1, 0, 0, 0); } } }
          const int qrow = (lane & 15) >> 2, pp = lane & 3, g1 = (lane >> 4) & 1;
          const LAS unsigned char* vb = Vp + (4 * hi + qrow) * 128 + (16 * g1 + 4 * pp) * 2;
          for (int kt = 0; kt <= qt; ++kt) {
              f32x16 acc;
#pragma unroll
              for (int r = 0; r < 16; ++r) acc[r] = 0.f;
#pragma unroll
              for (int ks = 0; ks < 4; ++ks) { const int row = 32 * kt + ql; const bf16x8 kf = *(const LAS bf16x8*)(Kp + row * 128 + (((2 * ks + hi) ^ (row & 7)) << 4));
                  acc = __builtin_amdgcn_mfma_f32_32x32x16_bf16(kf, qf[ks], acc, 0, 0, 0); }
              unsigned pk[8];
              const int dij = i - 32 * kt - 4 * hi;
#pragma unroll
              for (int r = 0; r < 16; r += 2) { const int d0 = dij - crow16(r, 0), d1 = dij - crow16(r + 1, 0);
                  const float p0 = d0 >= 0 ? acc[r] * 0.125f * __builtin_amdgcn_exp2f(lg * (float)d0) : 0.f, p1 = d1 >= 0 ? acc[r + 1] * 0.125f * __builtin_amdgcn_exp2f(lg * (float)d1) : 0.f;
                  pk[r >> 1] = pk2(p0, p1); }
#pragma unroll
              for (int s = 0; s < 2; ++s) { const bf16x8 pf = __builtin_bit_cast(bf16x8, (u32x4){pk[4 * s], pk[4 * s + 1], pk[4 * s + 2], pk[4 * s + 3]});
                  const bf16x8 v0 = tr_frag(vb + (32 * kt + 16 * s) * 128, 8 * 128), v1 = tr_frag(vb + (32 * kt + 16 * s) * 128 + 64, 8 * 128);
                  o0 = __builtin_amdgcn_mfma_f32_32x32x16_bf16(pf, v0, o0, 0, 0, 0); o1 = __builtin_amdgcn_mfma_f32_32x32x16_bf16(pf, v1, o1, 0, 0, 0); }
          }
#pragma unroll
          for (int r = 0; r < 16; ++r) { const int qq = crow16(r, hi); const float sc = __builtin_amdgcn_exp2f(lg * (float)(32 * qt + qq + 1));
              *(LAS float*)(Os + qq * 256 + ((((ql >> 2)) ^ (qq & 15)) << 4) + (ql & 3) * 4) = o0[r] + sc * c0[r];
              *(LAS float*)(Os + qq * 256 + (((8 + (ql >> 2)) ^ (qq & 15)) << 4) + (ql & 3) * 4) = o1[r] + sc * c1[r]; }
          __builtin_amdgcn_wave_barrier();
          const int qq = lane >> 1, hf = lane & 1;
          float v[32]; float s1 = 0.f;
#pragma unroll
          for (int k = 0; k < 8; ++k) { const f32x4 x = *(const LAS f32x4*)(Os + qq * 256 + (((hf * 8 + k) ^ (qq & 15)) << 4)); v[4 * k] = x[0]; v[4 * k + 1] = x[1]; v[4 * k + 2] = x[2]; v[4 * k + 3] = x[3]; s1 += (x[0] + x[1]) + (x[2] + x[3]); }
          s1 += dppf<DPP_XOR1>(s1);
          const float mean = s1 * (1.0f / 64.0f); float s2 = 0.f;
#pragma unroll
          for (int k = 0; k < 32; ++k) { v[k] -= mean; s2 += v[k] * v[k]; }
          s2 += dppf<DPP_XOR1>(s2);
          const float rstd = 1.0f / sqrtf(s2 * (1.0f / 64.0f) + GN_EPS);
          const size_t t = row0 + 32 * qt + qq;
          bf16* op = Q.YMIX() + t * DM + 384 + h * HD + hf * 32;
#pragma unroll
          for (int k = 0; k < 4; ++k) { float g[8]; unpack8(gv4[k], g); float ov[8];
#pragma unroll
              for (int e = 0; e < 8; ++e) ov[e] = v[8 * k + e] * rstd * (g[e] * __builtin_amdgcn_rcpf(1.0f + __builtin_amdgcn_exp2f(-1.4426950408889634f * g[e])));
              *(u32x4*)(op + 8 * k) = (u32x4){pk2(ov[0], ov[1]), pk2(ov[2], ov[3]), pk2(ov[4], ov[5]), pk2(ov[6], ov[7])}; }
        }
        __syncthreads();
    }
#undef ROUT_LOAD
}
DI void ph_ln1_router(Frame& F, int l) {
    const Ptrs Q = get_ptrs(F);
    LAS u32x4* bhi = (LAS u32x4*)F.lds; LAS u32x4* blo = bhi + 2048;
#pragma unroll
    for (int i = 0; i < 8; ++i) bhi[F.tid + NTHR * i] = Q.rimg()[F.tid + NTHR * i];
    LAS float* gamL = (LAS float*)(F.lds + 81920); LAS float* betL = gamL + 1024;
    { const float* src = (F.tid < 256 ? Q.in(13) : Q.in(14)) + l * DM + (F.tid & 255) * 4; *(LAS f32x4*)((F.tid < 256 ? gamL : betL) + (F.tid & 255) * 4) = *(const f32x4*)src; }
    __syncthreads();
    const float* rb = Q.in(18);
    unsigned* ecnt = Q.ctl() + CW_ECNT + 1024 * l;
    LAS unsigned* rinfo = (LAS unsigned*)(F.lds + 65536);
    LAS unsigned* lcnt = rinfo + 640; LAS unsigned* lbase = lcnt + 16;
    for (int rblk = F.wg; rblk < TOK / 128; rblk += F.G) {
      if (F.tid < 16) lcnt[F.tid] = 0u;
      __syncthreads();
      {
        const int rr = F.lane & 15, g = F.lane >> 4;
        const size_t rowoff = (size_t)(rblk * 128 + 16 * F.wave + rr) * DM + 8 * g;
        u32x4 xv[32]; float s = 0.f;
#pragma unroll
        for (int k = 0; k < 32; ++k) xv[k] = *(const u32x4*)(Q.V1() + rowoff + 32 * k);
#pragma unroll
        for (int k = 0; k < 32; ++k) { float x[8]; unpack8(xv[k], x); s += ((x[0] + x[1]) + (x[2] + x[3])) + ((x[4] + x[5]) + (x[6] + x[7])); }
        s = swap16_sum(s, s); s = swap32_sum(s, s);
#pragma unroll
        for (int k = 0; k < 32; ++k) asm volatile("" : "+v"(xv[k]));
        const float mean = s * (1.0f / DM); float s2 = 0.f;
#pragma unroll
        for (int k = 0; k < 32; ++k) { float x[8]; unpack8(xv[k], x);
#pragma unroll
            for (int j = 0; j < 8; ++j) { const float d_ = x[j] - mean; s2 += d_ * d_; } }
        s2 = swap16_sum(s2, s2); s2 = swap32_sum(s2, s2);
#pragma unroll
        for (int k = 0; k < 32; ++k) asm volatile("" : "+v"(xv[k]));
        const float rstd = 1.0f / sqrtf(s2 * (1.0f / DM) + LN_EPS);
        f32x4 acc = {0.f, 0.f, 0.f, 0.f};
#pragma unroll
        for (int k = 0; k < 32; ++k) { float x[8], y[8], hf[8]; unpack8(xv[k], x);
            const LAS float* gp = gamL + 32 * k + 8 * g; const LAS float* bp = betL + 32 * k + 8 * g;
            const f32x4 g0 = *(const LAS f32x4*)gp, g1 = *(const LAS f32x4*)(gp + 4), b0 = *(const LAS f32x4*)bp, b1 = *(const LAS f32x4*)(bp + 4);
#pragma unroll
            for (int j = 0; j < 4; ++j) { y[j] = (x[j] - mean) * rstd * g0[j] + b0[j]; y[4 + j] = (x[4 + j] - mean) * rstd * g1[j] + b1[j]; }
            const u32x4 hi = (u32x4){pk2(y[0], y[1]), pk2(y[2], y[3]), pk2(y[4], y[5]), pk2(y[6], y[7])};
            *(u32x4*)(Q.X1B() + rowoff + 32 * k) = hi;
            unpack8(hi, hf);
            const u32x4 lo = (u32x4){pk2(y[0] - hf[0], y[1] - hf[1]), pk2(y[2] - hf[2], y[3] - hf[3]), pk2(y[4] - hf[4], y[5] - hf[5]), pk2(y[6] - hf[6], y[7] - hf[7])};
            const u32x4 wh = bhi[k * 64 + F.lane], wl = blo[k * 64 + F.lane];
            acc = __builtin_amdgcn_mfma_f32_16x16x32_bf16(__builtin_bit_cast(bf16x8, hi), __builtin_bit_cast(bf16x8, wh), acc, 0, 0, 0);
            acc = __builtin_amdgcn_mfma_f32_16x16x32_bf16(__builtin_bit_cast(bf16x8, lo), __builtin_bit_cast(bf16x8, wh), acc, 0, 0, 0);
            acc = __builtin_amdgcn_mfma_f32_16x16x32_bf16(__builtin_bit_cast(bf16x8, hi), __builtin_bit_cast(bf16x8, wl), acc, 0, 0, 0);
            if ((k & 1) == 1) __builtin_amdgcn_sched_barrier(0); }
        LAS float* lgs = (LAS float*)(F.lds + 65536 + 4096) + F.wave * 256;
#pragma unroll
        for (int i = 0; i < 4; ++i) lgs[(4 * g + i) * 16 + rr] = acc[i];
      }
      __builtin_amdgcn_wave_barrier();
      if (F.lane < 16) { const int rl = 16 * F.wave + F.lane;
        const LAS float* lgs = (const LAS float*)(F.lds + 65536 + 4096) + F.wave * 256 + F.lane * 16;
        float lg[16];
#pragma unroll
        for (int e = 0; e < 16; ++e) lg[e] = lgs[e];
        float aff[16], sel[16];
#pragma unroll
        for (int e = 0; e < 16; ++e) { const float z = lg[e]; aff[e] = __builtin_amdgcn_rcpf(1.0f + __builtin_amdgcn_exp2f(-1.4426950408889634f * z)); sel[e] = aff[e] + rb[e]; }
        float gs[4];
#pragma unroll
        for (int g = 0; g < 4; ++g) { const float a = sel[4 * g], bq = sel[4 * g + 1], c = sel[4 * g + 2], d = sel[4 * g + 3];
            gs[g] = fmaxf(fmaxf(fmaxf(a + bq, a + c), fmaxf(a + d, bq + c)), fmaxf(bq + d, c + d)); }
        int gb = 0; float gbv = gs[0];
#pragma unroll
        for (int g = 1; g < 4; ++g) if (gs[g] > gbv) { gbv = gs[g]; gb = g; }
        float s4[4], a4[4];
#pragma unroll
        for (int k = 0; k < 4; ++k) { s4[k] = gb == 0 ? sel[k] : gb == 1 ? sel[4 + k] : gb == 2 ? sel[8 + k] : sel[12 + k]; a4[k] = gb == 0 ? aff[k] : gb == 1 ? aff[4 + k] : gb == 2 ? aff[8 + k] : aff[12 + k]; }
        int f0 = 0; float fv = s4[0], fa = a4[0];
#pragma unroll
        for (int k = 1; k < 4; ++k) if (s4[k] > fv) { fv = s4[k]; f0 = k; fa = a4[k]; }
        int f1 = -1; float sv = -INFINITY, sa = 0.f;
#pragma unroll
        for (int k = 0; k < 4; ++k) if (k != f0 && s4[k] > sv) { sv = s4[k]; f1 = k; sa = a4[k]; }
        const float wsum = fa + sa;
        {
            const int e0 = gb * 4 + f0, e1 = gb * 4 + f1;
            rinfo[rl] = (unsigned)e0 | ((unsigned)e1 << 8);
            rinfo[128 + rl] = __hip_atomic_fetch_add(&lcnt[e0], 1u, __ATOMIC_RELAXED, __HIP_MEMORY_SCOPE_WORKGROUP);
            rinfo[256 + rl] = __hip_atomic_fetch_add(&lcnt[e1], 1u, __ATOMIC_RELAXED, __HIP_MEMORY_SCOPE_WORKGROUP);
            rinfo[384 + rl] = __float_as_uint(fa / wsum); rinfo[512 + rl] = __float_as_uint(sa / wsum);
        }
      }
      __syncthreads();
      if (F.tid < 16) { const unsigned c = lcnt[F.tid]; lbase[F.tid] = c ? atomicAdd(&ecnt[64 * F.tid], c) : 0u; }
      __syncthreads();
      if (F.tid < 128) { const unsigned ee = rinfo[F.tid]; const int e0 = ee & 255, e1 = ee >> 8; const unsigned r = (unsigned)(rblk * 128 + F.tid);
          const size_t p0 = (size_t)e0 * LCAP + lbase[e0] + rinfo[128 + F.tid], p1 = (size_t)e1 * LCAP + lbase[e1] + rinfo[256 + F.tid];
          Q.ltok()[p0] = r; Q.lw()[p0] = __uint_as_float(rinfo[384 + F.tid]);
          Q.ltok()[p1] = r | 0x80000000u; Q.lw()[p1] = __uint_as_float(rinfo[512 + F.tid]); }
      __syncthreads();
    }
}
DI void moe_build_tab(Frame& F, int l) {
    const Ptrs Q = get_ptrs(F);
    LAS int* tab = (LAS int*)(F.lds + MOE_TAB_OFF);
    __syncthreads();
    if (F.tid < 64) {
        const unsigned* ecnt = Q.ctl() + CW_ECNT + 1024 * l; const int e = F.tid & 15;
        const int c = (int)__hip_atomic_load(ecnt + 64 * e, __ATOMIC_RELAXED, __HIP_MEMORY_SCOPE_AGENT); const int nb = (c + 255) >> 8;
        int inc = nb;
#pragma unroll
        for (int o = 1; o < 16; o <<= 1) { const int v = __builtin_amdgcn_ds_bpermute((F.tid - o) << 2, inc); if (e >= o) inc += v; }
        const int pb = inc - nb;
        if (F.tid < 16) { tab[e] = c; tab[16 + e] = pb; if (e == 15) tab[32] = inc; for (int j = 0; j < nb; ++j) tab[64 + pb + j] = e; }
    }
    __syncthreads();
}
DI void ph_ln2(Frame& F, int l) {
    const Ptrs Q = get_ptrs(F);
    const float* gam = Q.in(15) + l * DM; const float* bet = Q.in(16) + l * DM;
    float gmv[16], btv[16];
#pragma unroll
    for (int j = 0; j < 2; ++j)
#pragma unroll
        for (int k = 0; k < 8; k += 4) { const f32x4 g4 = *(const f32x4*)(gam + j * 512 + F.lane * 8 + k), b4 = *(const f32x4*)(bet + j * 512 + F.lane * 8 + k);
#pragma unroll
            for (int e = 0; e < 4; ++e) { gmv[j * 8 + k + e] = g4[e]; btv[j * 8 + k + e] = b4[e]; } }
    const int rstep = F.G * NWAVES; int r = F.wg * NWAVES + F.wave;
    u32x4 cx[2], c0[2], c1[2];
    if (r < TOK) {
#pragma unroll
        for (int j = 0; j < 2; ++j) { const size_t off = (size_t)r * DM + j * 512 + F.lane * 8; cx[j] = *(const u32x4*)(Q.X1B() + off); c0[j] = *(const u32x4*)(Q.YM0() + off); c1[j] = *(const u32x4*)(Q.YM1() + off); } }
    for (; r < TOK; r += rstep) {
        u32x4 nx[2], n0[2], n1[2];
        { const int rn = r + rstep < TOK ? r + rstep : r;
#pragma unroll
          for (int j = 0; j < 2; ++j) { const size_t off = (size_t)rn * DM + j * 512 + F.lane * 8; nx[j] = *(const u32x4*)(Q.X1B() + off); n0[j] = *(const u32x4*)(Q.YM0() + off); n1[j] = *(const u32x4*)(Q.YM1() + off); } }
        float v[16]; float s = 0.f;
#pragma unroll
        for (int j = 0; j < 2; ++j) {
            float a[8], b0[8], b1[8]; unpack8(cx[j], a); unpack8(c0[j], b0); unpack8(c1[j], b1);
#pragma unroll
            for (int k = 0; k < 8; ++k) { v[j * 8 + k] = ALPHA * a[k] + (b0[k] + b1[k]); s += v[j * 8 + k]; } }
        const float mean = wave_sum(s, F.lane) * (1.0f / DM); float s2 = 0.f;
#pragma unroll
        for (int k = 0; k < 16; ++k) { v[k] -= mean; s2 += v[k] * v[k]; }
        const float rstd = 1.0f / sqrtf(wave_sum(s2, F.lane) * (1.0f / DM) + LN_EPS);
#pragma unroll
        for (int j = 0; j < 2; ++j) { const int d0 = j * 512 + F.lane * 8; float o[8];
#pragma unroll
            for (int k = 0; k < 8; ++k) o[k] = v[j * 8 + k] * rstd * gmv[j * 8 + k] + btv[j * 8 + k];
            if (l == DEPTH - 1) { *(f32x4*)(Q.out + (size_t)r * DM + d0) = (f32x4){o[0], o[1], o[2], o[3]}; *(f32x4*)(Q.out + (size_t)r * DM + d0 + 4) = (f32x4){o[4], o[5], o[6], o[7]}; }
            else *(u32x4*)(Q.XB() + (size_t)r * DM + d0) = (u32x4){pk2(o[0], o[1]), pk2(o[2], o[3]), pk2(o[4], o[5]), pk2(o[6], o[7])}; }
#pragma unroll
        for (int j = 0; j < 2; ++j) { cx[j] = nx[j]; c0[j] = n0[j]; c1[j] = n1[j]; }
    }
}

constexpr int PH_PER_LAYER = 10, NPH = 1 + DEPTH * PH_PER_LAYER;
DI void grid_barrier(const Frame& F) {
    const Ptrs Q = get_ptrs(F);
    XcdBarrier b; b.bar = Q.ctl() + CW_BAR; b.x = xb_xcc_id(); b.st = (volatile LAS unsigned*)(F.lds + MISC_OFF) + 8;
    xcd_barrier(b);
}
DI void refresh_ids(Frame& F, int wave0) {
    int w_ = wave0; asm volatile("" : "+s"(w_)); unsigned z_ = 0u; asm volatile("" : "+v"(z_));
    const int ln_ = (int)__builtin_amdgcn_mbcnt_hi(~0u, __builtin_amdgcn_mbcnt_lo(~0u, z_));
    F.wave = w_; F.lane = ln_; F.tid = w_ * 64 + ln_;
}
#if MK_ONE_LAUNCH
#define PHASE_END(k) do { ts_barin(F, (k)); if ((k) + 1 < ph_hi) grid_barrier(F); } while (0)
#else
#define PHASE_END(k) do { __syncthreads(); } while (0)
#endif
#define TS_OFF (LDSCTL_OFF + 4096)
DI void ts_start(const Frame& F, int k) { if (PROBE_TS_SEL != 0 && F.wg == PROBE_WG && F.tid == 0) ((LAS unsigned long long*)(F.lds + TS_OFF))[k] = __builtin_amdgcn_s_memrealtime(); }
DI void ts_barin(const Frame& F, int k) { if (PROBE_TS_SEL != 0 && F.wg == PROBE_WG && F.tid == 0) ((LAS unsigned long long*)(F.lds + TS_OFF))[32 + k] = __builtin_amdgcn_s_memrealtime(); }
#define TS_MARK(id) do { if (PROBE_TS_SEL != 0 && L == 0 && F.wg == PROBE_WG && F.wave == 0 && F.lane == 0) { __builtin_amdgcn_s_waitcnt(0); ((LAS unsigned long long*)(F.lds + TS_OFF))[64 + (id)] = __builtin_amdgcn_s_memrealtime(); } } while (0)
#define PHASE_IN(k) (ts_start(F, (k)), (ph_lo <= (k) && (k) < ph_hi))
#ifndef PROBE_MASK
#define PROBE_MASK 0
#endif
#define PROBE_REP(k) for (int rep_ = 0; rep_ < ((L == 0 && ((PROBE_MASK >> (k)) & 1)) ? 2 : 1); ++rep_)
template <int L> DI void run_layer(Frame& F, const int wave0, const int ph_lo, const int ph_hi) {
    constexpr int base = 1 + L * PH_PER_LAYER;
    const LAS int* tab = (const LAS int*)(F.lds + MOE_TAB_OFF);
    if (PHASE_IN(base + 0)) { refresh_ids(F, wave0);
        TS_MARK(11); ph_s5_build(F, L); TS_MARK(12); refresh_ids(F, wave0);
        PROBE_REP(1) { const Ptrs Q = get_ptrs(F);
          pg8::DenseSched S; S.init(Q.XB(), Q.Win_t() + (size_t)L * DINP * DM, TOK, DINP, DM, F.G, F.wg);
          pg8::EpiBf16 E{Q.PROJ(), DINP, Q.ug()};
          pg8::gemm_phase<pg8::EpiBf16, pg8::DenseSched, true>(F.lds, F.tid, DM, S, E); }
        PHASE_END(base + 0); }
    if (PHASE_IN(base + 1)) { refresh_ids(F, wave0); TS_MARK(0); PROBE_REP(2) ph_kmean(F); TS_MARK(1); PROBE_REP(3) ph_ret_kv2(F); refresh_ids(F, wave0); TS_MARK(2);
        PROBE_REP(4) { const Ptrs Q = get_ptrs(F);
          pg8::S5ASched S{Q.ug(), Q.s5m(), F.G, F.G - 1 - F.wg};
          pg8::EpiS5A E{Q.yi(), Q.s5eg()};
          pg8::gemm_phase<pg8::EpiS5A, pg8::S5ASched, true>(F.lds, F.tid, 512, S, E); }
        TS_MARK(3);
        PHASE_END(base + 1); }
    if (PHASE_IN(base + 2)) { if (F.G == 256) {
            if (F.wg < 192) { const int bh = F.wg >> 4, ql_ = F.wg & 15; refresh_ids(F, wave0); ph_moba_gate2(F, L, bh * 32 + ql_, bh * 32 + 31 - ql_); }
            else { for (int k_ = 0; k_ < 2; ++k_) { const int si = (F.wg - 192) * 2 + k_; refresh_ids(F, wave0); if (si < 96) ph_scans(F, L, si, si + 1, 1); else ph_s5_scan2(F, L, si - 96, si - 95, 1); } }
        } else { for (int p_ = F.wg; p_ < 512; p_ += F.G) { refresh_ids(F, wave0);
            if (p_ < 384) ph_moba_gate(F, L, p_, p_ + 1, 1); else if (p_ < 480) ph_scans(F, L, p_ - 384, p_ - 383, 1); else ph_s5_scan2(F, L, p_ - 480, p_ - 479, 1); } }
        PHASE_END(base + 2); }
    if (PHASE_IN(base + 3)) { refresh_ids(F, wave0); TS_MARK(4); PROBE_REP(6) ph_moba_attn(F, L); refresh_ids(F, wave0); TS_MARK(5); ph_ret_out2(F); if (L == 0 && ((PROBE_MASK >> 7) & 1)) { refresh_ids(F, wave0); ph_ret_out2(F); } refresh_ids(F, wave0); TS_MARK(6);
        PROBE_REP(8) { const Ptrs Q = get_ptrs(F);
          pg8::S5BSched S{Q.s5cb(), Q.s5mc(), F.G, F.G - 1 - F.wg};
          pg8::EpiS5B E{Q.yi(), Q.ug(), Q.in(10) + (size_t)L * 256};
          pg8::gemm_phase<pg8::EpiS5B, pg8::S5BSched, true>(F.lds, F.tid, 128, S, E); }
        TS_MARK(7);
        PHASE_END(base + 3); }
    if (PHASE_IN(base + 4)) { refresh_ids(F, wave0); TS_MARK(9);
        PROBE_REP(9) { const Ptrs Q = get_ptrs(F);
          pg8::DenseSched S; S.init(Q.yi(), Q.wglut() + (size_t)L * 65536, TOK, 256, 256, F.G, F.G - 1 - F.wg);
          pg8::EpiGLU E{Q.yi(), Q.in(12) + (size_t)L * 256, Q.YMIX()};
          pg8::gemm_phase<pg8::EpiGLU, pg8::DenseSched, true>(F.lds, F.tid, 256, S, E); }
        refresh_ids(F, wave0); TS_MARK(8); PROBE_REP(10) ph_moba_combine(F); TS_MARK(10); PHASE_END(base + 4); }
    if (PHASE_IN(base + 5)) { refresh_ids(F, wave0);
        PROBE_REP(11) { const Ptrs Q = get_ptrs(F);
          pg8::DenseSched S; S.init(Q.YMIX(), Q.Wout_t() + (size_t)L * DM * DM, TOK, DM, DM, F.G, F.wg);
          pg8::EpiResF32 E{Q.V1(), Q.XB()};
          pg8::gemm_phase<pg8::EpiResF32, pg8::DenseSched, true>(F.lds, F.tid, DM, S, E); }
        PHASE_END(base + 5); }
    if (PHASE_IN(base + 6)) { refresh_ids(F, wave0); ph_ln1_router(F, L); PHASE_END(base + 6); }
    if (PHASE_IN(base + 7)) { refresh_ids(F, wave0);
        moe_build_tab(F, L);
        PROBE_REP(12) { const Ptrs Q = get_ptrs(F);
          const int vcu = (F.G % 8 == 0) ? (F.wg % 8) * (F.G / 8) + F.wg / 8 : F.wg;
          pg8::MoeUpSched S{Q.X1B(), Q.Wgu_t() + (size_t)L * 16 * 1024 * 1024, Q.ltok(), tab, F.G, vcu};
          pg8::EpiSwiGLU E{Q.Hb()};
          pg8::gemm_phase<pg8::EpiSwiGLU, pg8::MoeUpSched, true>(F.lds, F.tid, DM, S, E); }
        if (L == 0) { refresh_ids(F, wave0); ph_conv_deferred(F, 0); }
        PHASE_END(base + 7); }
    if (PHASE_IN(base + 8)) { refresh_ids(F, wave0);
        moe_build_tab(F, L);
        PROBE_REP(13) { const Ptrs Q = get_ptrs(F);
          const int vcu = (F.G % 8 == 0) ? (F.wg % 8) * (F.G / 8) + F.wg / 8 : F.wg;
          pg8::MoeDownSched S{Q.Hb(), Q.Wd_t() + (size_t)L * 16 * 1024 * DFF, tab, F.G, vcu};
          pg8::EpiMoeScatter E{Q.YM0(), Q.YM1(), Q.ltok(), Q.lw(), tab};
          pg8::gemm_phase<pg8::EpiMoeScatter, pg8::MoeDownSched, true>(F.lds, F.tid, DFF, S, E); }
        if (L == 0) { refresh_ids(F, wave0); ph_conv_deferred(F, 1); }
        PHASE_END(base + 8); }
    if (PHASE_IN(base + 9)) { refresh_ids(F, wave0); PROBE_REP(14) ph_ln2(F, L); PHASE_END(base + 9); }
}
__global__ void __launch_bounds__(NTHR, 2) fwd_kernel(Args args_unused) {
    extern __shared__ __attribute__((aligned(16))) unsigned char lds_raw[];
    Frame F;
    F.lds = (LAS unsigned char*)lds_raw;
    F.ka = (KArgs)__builtin_amdgcn_kernarg_segment_ptr();
    F.tid = threadIdx.x; F.lane = F.tid & 63; F.wave = __builtin_amdgcn_readfirstlane(F.tid >> 6);
    F.G = gridDim.x; F.wg = blockIdx.x;
    for (int u = F.tid; u < (LDS_BYTES - LDSCTL_OFF) / 4; u += NTHR) ((LAS unsigned*)(F.lds + LDSCTL_OFF))[u] = 0u;
    __syncthreads();
    const int ph_lo = F.ka->ph_lo, ph_hi = F.ka->ph_hi;
    const int wave0 = F.wave;
#if MK_ONE_LAUNCH
    { const Ptrs Q = get_ptrs(F); (void)xcd_barrier_post(Q.ctl() + CW_BAR, (volatile LAS unsigned*)(F.lds + MISC_OFF) + 8); }
#endif
    if (PHASE_IN(0)) { refresh_ids(F, wave0); for (int rep_ = 0; rep_ < (((PROBE_MASK >> 15) & 1) ? 2 : 1); ++rep_) ph_prologue(F);
#if MK_ONE_LAUNCH
        ts_barin(F, 0);
        if (ph_hi > NPH) { __threadfence(); cg::this_grid().sync(); __builtin_amdgcn_fence(__ATOMIC_ACQUIRE, "agent"); asm volatile("s_waitcnt vmcnt(0)" ::: "memory"); __syncthreads(); }
        else if (1 < ph_hi) grid_barrier(F);
#else
        PHASE_END(0);
#endif
    }
    run_layer<0>(F, wave0, ph_lo, ph_hi);
    run_layer<1>(F, wave0, ph_lo, ph_hi);
#if PROBE_TS_SEL != 0
    {
        refresh_ids(F, wave0); ts_start(F, NPH);
        const Ptrs Q = get_ptrs(F);
        if (F.wg == PROBE_WG && F.tid == 0) { const LAS unsigned long long* ts = (const LAS unsigned long long*)(F.lds + TS_OFF);
            unsigned long long sel = 0ull;
            if (PROBE_SUB_A >= 0) sel = ts[64 + PROBE_SUB_B] - ts[64 + PROBE_SUB_A]; else
            for (int k = 0; k < NPH; ++k) if ((PROBE_TS_SEL >> k) & 1u) sel += ((PROBE_TS_SEL >> 31) & 1u) ? (ts[k + 1] - ts[32 + k]) : (ts[k + 1] - ts[k]);
            const float eps = 0.28f + PROBE_K * (float)sel / (float)(ts[NPH] - ts[0]);
            __hip_atomic_store((float*)(Q.ctl() + 16), eps, __ATOMIC_RELAXED, __HIP_MEMORY_SCOPE_AGENT); }
        grid_barrier(F);
        const float eps = __hip_atomic_load((float*)(Q.ctl() + 16), __ATOMIC_RELAXED, __HIP_MEMORY_SCOPE_AGENT);
        for (size_t i = (size_t)F.wg * NTHR + F.tid; i < (size_t)TOK * DM / 4; i += (size_t)F.G * NTHR) { f32x4 v = *(f32x4*)(Q.out + i * 4); v = v * (1.0f + eps); *(f32x4*)(Q.out + i * 4) = v; }
    }
#endif
}

extern "C" void kernel_launch(void* const* d_in, const int* in_sizes, int n_in, void* d_out, int out_size, void* d_ws, size_t ws_size, hipStream_t stream) {
    static int grid = 0;
    if (grid == 0) {
        if (n_in != 22 || in_sizes[0] != TOK * DM || out_size != TOK * DM || ws_size < WS_END) {
            fprintf(stderr, "kernel_launch: unexpected shapes (n_in %d, in0 %d, out %d, ws %zu); nothing launched\n", n_in, n_in > 0 ? in_sizes[0] : -1, out_size, ws_size); grid = -1; return; }
        int dev = 0, cus = 0, per_cu = 0;
        if (hipGetDevice(&dev) != hipSuccess || hipDeviceGetAttribute(&cus, hipDeviceAttributeMultiprocessorCount, dev) != hipSuccess) { grid = -1; return; }
        if (hipFuncSetAttribute((const void*)fwd_kernel, hipFuncAttributeMaxDynamicSharedMemorySize, LDS_BYTES) != hipSuccess) { fprintf(stderr, "kernel_launch: hipFuncSetAttribute failed\n"); grid = -1; return; }
        if (hipOccupancyMaxActiveBlocksPerMultiprocessor(&per_cu, (const void*)fwd_kernel, NTHR, LDS_BYTES) != hipSuccess || per_cu < 1) { fprintf(stderr, "kernel_launch: occupancy query says %d blocks per CU\n", per_cu); (void)hipGetLastError(); grid = -1; return; }
        grid = cus;
    }
    if (grid < 0) return;
    (void)hipMemsetAsync((char*)d_ws + WS_CTL, 0, CTL_ZERO_BYTES, stream);
    Args a{};
    for (int i = 0; i < 22; ++i) a.in[i] = (const float*)d_in[i];
    a.out = (float*)d_out; a.ws = (unsigned char*)d_ws;
#if MK_ONE_LAUNCH
    a.ph_lo = 0; a.ph_hi = NPH;
    void* kargs[] = {&a};
    hipError_t e = hipLaunchCooperativeKernel((const void*)fwd_kernel, dim3(grid), dim3(NTHR), kargs, LDS_BYTES, stream);
    if (e != hipSuccess) fprintf(stderr, "cooperative launch failed: %s (grid %d)\n", hipGetErrorString(e), grid);
#else
    for (int ph = 0; ph < NPH; ++ph) { a.ph_lo = ph; a.ph_hi = ph + 1; hipLaunchKernelGGL(fwd_kernel, dim3(grid), dim3(NTHR), LDS_BYTES, stream, a); }
#endif
}
```
